# Optimizing an MI355X kernel written in HIP

```python
import math
import jax
import jax.numpy as jnp
from jax import lax
import numpy as np

D_MODEL = 2048
BATCH = 2
SEQ = 8192
DEPTH = 2

CTX_LEN = 256
GRID_W = 64
ROPE_BASE = 10000.0
NORM_EPS = 1e-6
BLOCK_Q = 128

DIFF_HEADS = 8
DIFF_HD = 64
DIFF_VD = 2 * DIFF_HD
MLSTM_HEADS = 8
MLSTM_QK = 64
MLSTM_V = 128
MLSTM_CHUNK = 128
MLA_HEADS = 8
MLA_NOPE = 128
MLA_ROPE = 64
MLA_V = 128
Q_LORA = 448
KV_LORA = 512
MLA_SCALE = (MLA_NOPE + MLA_ROPE) ** -0.5
SWA_HEADS = 8
SWA_KV_HEADS = 2
SWA_HD = 128
WINDOW = 128
N_EXPERTS = 64
TOP_K = 6
N_GROUPS = 8
TOPK_GROUPS = 4
EXPERT_FF = 512
SHARED_FF = 512
ROUTED_SCALE = 2.5
MOE_BLOCK = 128

AB_IN = DIFF_HEADS * (4 * DIFF_HD + DIFF_VD) + MLSTM_HEADS * (2 * MLSTM_QK + 2 * MLSTM_V) + 4 * MLSTM_HEADS
AB_OUT = DIFF_HEADS * DIFF_VD + MLSTM_HEADS * MLSTM_V
CD_IN = Q_LORA + KV_LORA + MLA_ROPE + (SWA_HEADS + 2 * SWA_KV_HEADS) * SWA_HD
CD_OUT = MLA_HEADS * MLA_V + SWA_HEADS * SWA_HD
N_EVEN = (DEPTH + 1) // 2
N_ODD = DEPTH // 2
F32 = jnp.float32

kernel_name = 'hybrid_diffusion_block'


def rms_norm(x, g):
    xf = x.astype(F32)
    y = xf * lax.rsqrt(jnp.mean(xf * xf, axis=-1, keepdims=True) + NORM_EPS)
    return (y * g.astype(F32)).astype(x.dtype)


def modulation(c, w, b):
    return jnp.split(jax.nn.silu(c) @ w + b, 6, axis=-1)


def modulate(h, shift, scale):
    return h * (1.0 + scale) + shift


def diff_lambda_init(layer):
    return 0.8 - 0.6 * math.exp(-0.3 * layer)


def axial_rope(row, col, dim):
    quarter = dim // 4
    inv = ROPE_BASE ** (-jnp.arange(quarter, dtype=F32) / quarter)
    ang = jnp.concatenate([row.astype(F32)[:, None] * inv, col.astype(F32)[:, None] * inv], axis=-1)
    return jnp.cos(ang), jnp.sin(ang)


def apply_rope(x, cs):
    cos, sin = cs
    shp = (1, x.shape[1]) + (1,) * (x.ndim - 3) + (cos.shape[-1],)
    cos, sin = cos.reshape(shp), sin.reshape(shp)
    xf = x.astype(F32).reshape(x.shape[:-1] + (-1, 2))
    x1, x2 = xf[..., 0], xf[..., 1]
    return jnp.stack([x1 * cos - x2 * sin, x1 * sin + x2 * cos], axis=-1).reshape(x.shape).astype(x.dtype)


def project(h, w_in, layout, names):
    offs, o = {}, 0
    for n, size in layout:
        offs[n] = (o, o + size)
        o += size
    if len(names) < len(layout):
        w_in = w_in[:, np.concatenate([np.arange(*offs[n]) for n in names])]
    p = h @ w_in
    cuts = [int(v) for v in np.cumsum([offs[n][1] - offs[n][0] for n in names])[:-1]]
    return dict(zip(names, jnp.split(p, cuts, axis=-1)))


def ab_layout():
    return [('dq', DIFF_HEADS * 2 * DIFF_HD), ('dk', DIFF_HEADS * 2 * DIFF_HD), ('dv', DIFF_HEADS * DIFF_VD),
            ('mq', MLSTM_HEADS * MLSTM_QK), ('mk', MLSTM_HEADS * MLSTM_QK), ('mv', MLSTM_HEADS * MLSTM_V),
            ('mo', MLSTM_HEADS * MLSTM_V), ('gates', 4 * MLSTM_HEADS)]


def cd_layout():
    return [('cq', Q_LORA), ('ckv', KV_LORA), ('kr', MLA_ROPE), ('sq', SWA_HEADS * SWA_HD),
            ('sk', SWA_KV_HEADS * SWA_HD), ('sv', SWA_KV_HEADS * SWA_HD)]


def sweep_blocks(f, q):
    b, s = q.shape[:2]
    nb = s // BLOCK_Q
    qb = jnp.moveaxis(q.reshape((b, nb, BLOCK_Q) + q.shape[2:]), 1, 0)
    out = lax.map(f, qb)
    return jnp.moveaxis(out, 0, 1).reshape((b, s) + out.shape[3:])


def diff_attend(q, k, v, lam):
    s = jnp.einsum('bqhmd,bkhmd->bhmqk', q, k, preferred_element_type=F32) * DIFF_HD ** -0.5
    p = jax.nn.softmax(s, axis=-1)
    a = p[:, :, 0] - lam * p[:, :, 1]
    return jnp.einsum('bhqk,bkhd->bqhd', a, v.astype(F32))


def softmax_attend(q, k, v, scale):
    s = jnp.einsum('bqhd,bkhd->bhqk', q, k, preferred_element_type=F32) * scale
    return jnp.einsum('bhqk,bkhd->bqhd', jax.nn.softmax(s, axis=-1), v.astype(F32))


def mlstm_chunked(q, k, v, i_pre, f_pre, state):
    b, t, nh, dk = k.shape
    nc = t // MLSTM_CHUNK
    causal = jnp.tril(jnp.ones((MLSTM_CHUNK, MLSTM_CHUNK), bool))[None, :, :, None]

    def chunks(a):
        return jnp.moveaxis(a.reshape((b, nc, MLSTM_CHUNK) + a.shape[2:]), 1, 0)

    def step(carry, xs):
        c_st, n_st, m_st = carry
        *qx, kb, vb, ib, fb = xs
        bcum = jnp.cumsum(jax.nn.log_sigmoid(fb), axis=1)
        btot = bcum[:, -1]
        w_end = btot[:, None] - bcum + ib
        m_new = jnp.maximum(btot + m_st, jnp.max(w_end, axis=1))
        decay = jnp.exp(btot + m_st - m_new)
        w_k = jnp.exp(w_end - m_new[:, None])
        c_new = decay[..., None, None] * c_st + jnp.einsum('blh,blhv,blhk->bhvk', w_k, vb, kb)
        n_new = decay[..., None] * n_st + jnp.einsum('blh,blhk->bhk', w_k, kb)
        if not qx:
            return (c_new, n_new, m_new), None
        qb = qx[0]
        log_d = bcum[:, :, None] - bcum[:, None] + ib[:, None]
        log_d = jnp.where(causal, log_d, -jnp.inf)
        log_inter = bcum + m_st[:, None]
        m_row = jnp.maximum(log_inter, jnp.max(log_d, axis=2))
        w_intra = jnp.exp(log_d - m_row[:, :, None])
        w_inter = jnp.exp(log_inter - m_row)
        qk = jnp.einsum('bqhd,bshd->bqsh', qb, kb) * w_intra
        num = w_inter[..., None] * jnp.einsum('bqhk,bhvk->bqhv', qb, c_st) + jnp.einsum('bqsh,bshv->bqhv', qk, vb)
        den = w_inter * jnp.einsum('bqhk,bhk->bqh', qb, n_st) + jnp.sum(qk, axis=2)
        h_out = num / jnp.maximum(jnp.abs(den), jnp.exp(-m_row))[..., None]
        return (c_new, n_new, m_new), h_out

    xs = tuple(chunks(a) for a in ((() if q is None else (q,)) + (k, v, i_pre, f_pre)))
    state, hs = lax.scan(step, state, xs)
    if q is None:
        return None, state
    return jnp.moveaxis(hs, 0, 1).reshape(b, t, nh, v.shape[-1]), state


def flip(a):
    return None if a is None else jnp.flip(a, axis=1)


def ab_mixer(hl, hc, w_in, w_out, lam_vec, d_norm, gate_b, m_norm, lam_init, rope, with_ctx):
    b, s, _ = hl.shape
    L = hc.shape[1]
    layout = ab_layout()
    names = [n for n, _ in layout]
    pl = project(hl, w_in, layout, names)
    pc = project(hc, w_in, layout, names if with_ctx else ['dk', 'dv', 'mk', 'mv', 'gates'])

    lv = lam_vec.astype(F32)
    lam = jnp.exp(jnp.sum(lv[0] * lv[1])) - jnp.exp(jnp.sum(lv[2] * lv[3])) + lam_init

    def qk(p, t, rot):
        a = p.reshape(b, t, DIFF_HEADS * 2, DIFF_HD)
        if rot:
            a = apply_rope(a, rope)
        return a.reshape(b, t, DIFF_HEADS, 2, DIFF_HD)

    k_all = jnp.concatenate([qk(pc['dk'], L, False), qk(pl['dk'], s, True)], axis=1)
    v_all = jnp.concatenate([pc['dv'].reshape(b, L, DIFF_HEADS, DIFF_VD),
                             pl['dv'].reshape(b, s, DIFF_HEADS, DIFF_VD)], axis=1)

    def diff_out(a):
        return (rms_norm(a, d_norm) * (1.0 - lam_init)).reshape(a.shape[0], a.shape[1], -1)

    a_l = diff_out(sweep_blocks(lambda qb: diff_attend(qb, k_all, v_all, lam), qk(pl['dq'], s, True)))

    def m_in(p, t):
        k = p['mk'].reshape(b, t, MLSTM_HEADS, MLSTM_QK).astype(F32) * MLSTM_QK ** -0.5
        v = p['mv'].reshape(b, t, MLSTM_HEADS, MLSTM_V).astype(F32)
        g = p['gates'].reshape(b, t, 4, MLSTM_HEADS).astype(F32) + gate_b.astype(F32)
        return k, v, g

    def m_q(p, t):
        return p['mq'].reshape(b, t, MLSTM_HEADS, MLSTM_QK).astype(F32)

    zero = (jnp.zeros((b, MLSTM_HEADS, MLSTM_V, MLSTM_QK), F32),
            jnp.zeros((b, MLSTM_HEADS, MLSTM_QK), F32), jnp.zeros((b, MLSTM_HEADS), F32))
    kc, vc, gc = m_in(pc, L)
    kl, vl, gl = m_in(pl, s)
    ql = m_q(pl, s)
    qc = m_q(pc, L) if with_ctx else None
    hcf, st_f = mlstm_chunked(qc, kc, vc, gc[:, :, 0], gc[:, :, 1], zero)
    hlf, _ = mlstm_chunked(ql, kl, vl, gl[:, :, 0], gl[:, :, 1], st_f)
    hcb, st_b = mlstm_chunked(flip(qc), flip(kc), flip(vc), flip(gc[:, :, 2]), flip(gc[:, :, 3]), zero)
    hlb, _ = mlstm_chunked(flip(ql), flip(kl), flip(vl), flip(gl[:, :, 2]), flip(gl[:, :, 3]), st_b)

    def m_out(hf, hb_rev, p, t):
        o = jax.nn.sigmoid(p['mo'].reshape(b, t, MLSTM_HEADS, MLSTM_V).astype(F32))
        return (rms_norm(hf + jnp.flip(hb_rev, axis=1), m_norm) * o).reshape(b, t, -1)

    dt = hl.dtype
    y_l = jnp.concatenate([a_l, m_out(hlf, hlb, pl, s)], axis=-1).astype(dt) @ w_out
    if not with_ctx:
        return y_l, None
    a_c = diff_out(diff_attend(qk(pc['dq'], L, False), k_all[:, :L], v_all[:, :L], lam))
    y_c = jnp.concatenate([a_c, m_out(hcf, hcb, pc, L)], axis=-1).astype(dt) @ w_out
    return y_l, y_c


def swa_latent(q, k, v, k_ctx, v_ctx, sink):
    b, s = q.shape[:2]
    nb = s // BLOCK_Q
    r = SWA_HEADS // SWA_KV_HEADS

    def band(a):
        ap = jnp.pad(a, ((0, 0), (BLOCK_Q, BLOCK_Q), (0, 0), (0, 0))).reshape(b, nb + 2, BLOCK_Q, SWA_KV_HEADS, SWA_HD)
        return jnp.concatenate([ap[:, :-2], ap[:, 1:-1], ap[:, 2:]], axis=2)

    kb, vb = band(k), band(v)
    qb = q.reshape(b, nb, BLOCK_Q, SWA_KV_HEADS, r, SWA_HD)
    scale = SWA_HD ** -0.5
    s_loc = jnp.einsum('bnqgrd,bnkgd->bngrqk', qb, kb, preferred_element_type=F32) * scale
    q_pos = jnp.arange(nb)[:, None, None] * BLOCK_Q + jnp.arange(BLOCK_Q)[None, :, None]
    k_pos = jnp.arange(nb)[:, None, None] * BLOCK_Q - BLOCK_Q + jnp.arange(3 * BLOCK_Q)[None, None, :]
    valid = (jnp.abs(k_pos - q_pos) <= WINDOW) & (k_pos >= 0) & (k_pos < s)
    s_loc = jnp.where(valid[None, :, None, None], s_loc, -jnp.inf)
    s_ctx = jnp.einsum('bnqgrd,bkgd->bngrqk', qb, k_ctx, preferred_element_type=F32) * scale
    sink_col = jnp.broadcast_to(sink.astype(F32).reshape(1, 1, SWA_KV_HEADS, r, 1, 1), s_loc.shape[:-1] + (1,))
    p = jax.nn.softmax(jnp.concatenate([s_loc, s_ctx, sink_col], axis=-1), axis=-1)
    n_loc = 3 * BLOCK_Q
    out = (jnp.einsum('bngrqk,bnkgd->bnqgrd', p[..., :n_loc], vb.astype(F32))
           + jnp.einsum('bngrqk,bkgd->bnqgrd', p[..., n_loc:-1], v_ctx.astype(F32)))
    return out.reshape(b, s, SWA_HEADS, SWA_HD)


def swa_context(q, k, v, sink):
    b, t = q.shape[:2]
    r = SWA_HEADS // SWA_KV_HEADS
    qg = q.reshape(b, t, SWA_KV_HEADS, r, SWA_HD)
    s = jnp.einsum('bqgrd,bkgd->bgrqk', qg, k, preferred_element_type=F32) * SWA_HD ** -0.5
    sink_col = jnp.broadcast_to(sink.astype(F32).reshape(1, SWA_KV_HEADS, r, 1, 1), s.shape[:-1] + (1,))
    p = jax.nn.softmax(jnp.concatenate([s, sink_col], axis=-1), axis=-1)[..., :-1]
    return jnp.einsum('bgrqk,bkgd->bqgrd', p, v.astype(F32)).reshape(b, t, SWA_HEADS, SWA_HD)


def cd_mixer(hl, hc, w_in, w_out, q_norm, w_uq, kv_norm, w_ukv, sink, rope64, rope128, with_ctx):
    b, s, _ = hl.shape
    L = hc.shape[1]
    layout = cd_layout()
    names = [n for n, _ in layout]
    pl = project(hl, w_in, layout, names)
    pc = project(hc, w_in, layout, names if with_ctx else ['ckv', 'kr', 'sk', 'sv'])

    def mla_q(p, t, rot):
        q = (rms_norm(p['cq'], q_norm) @ w_uq).reshape(b, t, MLA_HEADS, MLA_NOPE + MLA_ROPE)
        q_rope = q[..., MLA_NOPE:]
        if rot:
            q_rope = apply_rope(q_rope, rope64)
        return jnp.concatenate([q[..., :MLA_NOPE], q_rope], axis=-1)

    def mla_kv(p, t, rot):
        kv = (rms_norm(p['ckv'], kv_norm) @ w_ukv).reshape(b, t, MLA_HEADS, MLA_NOPE + MLA_V)
        k_rope = p['kr'].reshape(b, t, 1, MLA_ROPE)
        if rot:
            k_rope = apply_rope(k_rope, rope64)
        k = jnp.concatenate([kv[..., :MLA_NOPE], jnp.broadcast_to(k_rope, (b, t, MLA_HEADS, MLA_ROPE))], axis=-1)
        return k, kv[..., MLA_NOPE:]

    kc, vc = mla_kv(pc, L, False)
    kl, vl = mla_kv(pl, s, True)
    k_all = jnp.concatenate([kc, kl], axis=1)
    v_all = jnp.concatenate([vc, vl], axis=1)
    mla_l = sweep_blocks(lambda qb: softmax_attend(qb, k_all, v_all, MLA_SCALE), mla_q(pl, s, True))

    skc = pc['sk'].reshape(b, L, SWA_KV_HEADS, SWA_HD)
    svc = pc['sv'].reshape(b, L, SWA_KV_HEADS, SWA_HD)
    skl = apply_rope(pl['sk'].reshape(b, s, SWA_KV_HEADS, SWA_HD), rope128)
    svl = pl['sv'].reshape(b, s, SWA_KV_HEADS, SWA_HD)
    sql = apply_rope(pl['sq'].reshape(b, s, SWA_HEADS, SWA_HD), rope128)
    swa_l = swa_latent(sql, skl, svl, skc, svc, sink)

    dt = hl.dtype
    y_l = jnp.concatenate([mla_l.reshape(b, s, -1), swa_l.reshape(b, s, -1)], axis=-1).astype(dt) @ w_out
    if not with_ctx:
        return y_l, None
    mla_c = softmax_attend(mla_q(pc, L, False), kc, vc, MLA_SCALE)
    swa_c = swa_context(pc['sq'].reshape(b, L, SWA_HEADS, SWA_HD), skc, svc, sink)
    y_c = jnp.concatenate([mla_c.reshape(b, L, -1), swa_c.reshape(b, L, -1)], axis=-1).astype(dt) @ w_out
    return y_l, y_c


def swiglu(x, wg, wu, wd):
    return (jax.nn.silu(x @ wg) * (x @ wu)) @ wd


def moe_ffn(h, router_w, router_b, w_gate, w_up, w_down, s_gate, s_up, s_down):
    n, d = h.shape
    scores = jax.nn.sigmoid(jnp.dot(h, router_w, preferred_element_type=F32))
    choice = scores + router_b.astype(F32)
    per_group = N_EXPERTS // N_GROUPS
    group_score = lax.top_k(choice.reshape(n, N_GROUPS, per_group), 2)[0].sum(-1)
    top_groups = lax.top_k(group_score, TOPK_GROUPS)[1]
    group_ok = jnp.any(top_groups[:, :, None] == jnp.arange(N_GROUPS)[None, None, :], axis=1)
    expert_ok = jnp.repeat(group_ok, per_group, axis=1)
    top_e = lax.top_k(jnp.where(expert_ok, choice, -jnp.inf), TOP_K)[1]
    gate = jnp.take_along_axis(scores, top_e, axis=1)
    gate = gate / jnp.sum(gate, axis=-1, keepdims=True) * ROUTED_SCALE

    n_slots = n * TOP_K
    flat_e = top_e.reshape(-1)
    order = jnp.argsort(flat_e)
    e_sorted = flat_e[order]
    counts = jnp.bincount(flat_e, length=N_EXPERTS)
    blocks_per_e = (counts + MOE_BLOCK - 1) // MOE_BLOCK
    blocks_end = jnp.cumsum(blocks_per_e)
    rank = jnp.arange(n_slots) - (jnp.cumsum(counts) - counts)[e_sorted]
    dest = (blocks_end - blocks_per_e)[e_sorted] * MOE_BLOCK + rank
    n_blocks = n_slots // MOE_BLOCK + N_EXPERTS
    n_rows = n_blocks * MOE_BLOCK
    row_tok = jnp.zeros((n_rows,), jnp.int32).at[dest].set((order // TOP_K).astype(jnp.int32))
    row_gate = jnp.zeros((n_rows,), F32).at[dest].set(gate.reshape(-1)[order])
    block_e = jnp.minimum(jnp.searchsorted(blocks_end, jnp.arange(n_blocks), side='right'), N_EXPERTS - 1)

    def run_block(acc, xs):
        tok, g, e = xs
        y = swiglu(h[tok], w_gate[e], w_up[e], w_down[e])
        return acc.at[tok].add(y.astype(F32) * g[:, None]), None

    routed, _ = lax.scan(run_block, jnp.zeros((n, d), F32),
                         (row_tok.reshape(n_blocks, MOE_BLOCK), row_gate.reshape(n_blocks, MOE_BLOCK), block_e))
    shared = swiglu(h, s_gate, s_up, s_down).astype(F32)
    return (routed + shared).astype(h.dtype)


def setup_inputs(seed: int = 0) -> dict:
    key = jax.random.key(seed)
    ks = iter(jax.random.split(key, 40))
    D = D_MODEL

    def nrm(shape, scale):
        return jax.random.normal(next(ks), shape, F32) * scale

    def gain(shape):
        return 1.0 + nrm(shape, 0.02)

    gate_offset = jnp.array([0.0, 3.0, 0.0, 3.0], F32)[None, :, None]
    return {
        'x': nrm((BATCH, SEQ, D), 1.0),
        'c': nrm((BATCH, D), 1.0),
        'ctx': nrm((BATCH, CTX_LEN, D), 1.0),
        'c_ctx': nrm((D,), 1.0),
        'mod_w': nrm((DEPTH, D, 6 * D), 0.5 * D ** -0.5),
        'mod_b': nrm((DEPTH, 6 * D), 0.01),
        'norm_mix_pre': gain((DEPTH, D)),
        'norm_mix_post': gain((DEPTH, D)),
        'norm_ffn_pre': gain((DEPTH, D)),
        'norm_ffn_post': gain((DEPTH, D)),
        'ab_w_in': nrm((N_EVEN, D, AB_IN), D ** -0.5),
        'ab_w_out': nrm((N_EVEN, AB_OUT, D), AB_OUT ** -0.5),
        'diff_lambda': nrm((N_EVEN, 4, DIFF_HD), 0.1),
        'diff_norm': gain((N_EVEN, DIFF_VD)),
        'mlstm_gate_b': gate_offset + nrm((N_EVEN, 4, MLSTM_HEADS), 0.1),
        'mlstm_norm': gain((N_EVEN, MLSTM_V)),
        'cd_w_in': nrm((N_ODD, D, CD_IN), D ** -0.5),
        'cd_w_out': nrm((N_ODD, CD_OUT, D), CD_OUT ** -0.5),
        'mla_q_norm': gain((N_ODD, Q_LORA)),
        'mla_w_uq': nrm((N_ODD, Q_LORA, MLA_HEADS * (MLA_NOPE + MLA_ROPE)), Q_LORA ** -0.5),
        'mla_kv_norm': gain((N_ODD, KV_LORA)),
        'mla_w_ukv': nrm((N_ODD, KV_LORA, MLA_HEADS * (MLA_NOPE + MLA_V)), KV_LORA ** -0.5),
        'swa_sink': nrm((N_ODD, SWA_HEADS), 0.5),
        'router_w': nrm((DEPTH, D, N_EXPERTS), D ** -0.5),
        'router_b': nrm((DEPTH, N_EXPERTS), 0.01),
        'exp_w_gate': nrm((DEPTH, N_EXPERTS, D, EXPERT_FF), D ** -0.5),
        'exp_w_up': nrm((DEPTH, N_EXPERTS, D, EXPERT_FF), D ** -0.5),
        'exp_w_down': nrm((DEPTH, N_EXPERTS, EXPERT_FF, D), EXPERT_FF ** -0.5),
        'sh_w_gate': nrm((DEPTH, D, SHARED_FF), D ** -0.5),
        'sh_w_up': nrm((DEPTH, D, SHARED_FF), D ** -0.5),
        'sh_w_down': nrm((DEPTH, SHARED_FF, D), SHARED_FF ** -0.5),
    }


def reference(x, c, ctx, c_ctx, mod_w, mod_b, norm_mix_pre, norm_mix_post, norm_ffn_pre, norm_ffn_post,
              ab_w_in, ab_w_out, diff_lambda, diff_norm, mlstm_gate_b, mlstm_norm,
              cd_w_in, cd_w_out, mla_q_norm, mla_w_uq, mla_kv_norm, mla_w_ukv, swa_sink,
              router_w, router_b, exp_w_gate, exp_w_up, exp_w_down, sh_w_gate, sh_w_up, sh_w_down):
    b, s, d = x.shape
    ctx_len = ctx.shape[1]
    rows = s // GRID_W
    row = jnp.repeat(jnp.arange(rows), GRID_W)
    col = jnp.tile(jnp.arange(GRID_W), rows)
    rope64 = axial_rope(row, col, DIFF_HD)
    rope128 = axial_rope(row, col, SWA_HD)

    xl, xc = x, ctx
    for layer in range(DEPTH):
        with_ctx = layer < DEPTH - 1
        sh1, sc1, g1, sh2, sc2, g2 = [m[:, None, :] for m in modulation(c, mod_w[layer], mod_b[layer])]
        csh1, csc1, cg1, csh2, csc2, cg2 = modulation(c_ctx, mod_w[layer], mod_b[layer])
        hl = modulate(rms_norm(xl, norm_mix_pre[layer]), sh1, sc1)
        hc = modulate(rms_norm(xc, norm_mix_pre[layer]), csh1, csc1)
        j = layer // 2
        if layer % 2 == 0:
            y_l, y_c = ab_mixer(hl, hc, ab_w_in[j], ab_w_out[j], diff_lambda[j], diff_norm[j],
                                mlstm_gate_b[j], mlstm_norm[j], diff_lambda_init(layer), rope64, with_ctx)
        else:
            y_l, y_c = cd_mixer(hl, hc, cd_w_in[j], cd_w_out[j], mla_q_norm[j], mla_w_uq[j], mla_kv_norm[j],
                                mla_w_ukv[j], swa_sink[j], rope64, rope128, with_ctx)
        xl = xl + g1 * rms_norm(y_l, norm_mix_post[layer])
        f_in_l = modulate(rms_norm(xl, norm_ffn_pre[layer]), sh2, sc2)
        if with_ctx:
            xc = xc + cg1 * rms_norm(y_c, norm_mix_post[layer])
            f_in_c = modulate(rms_norm(xc, norm_ffn_pre[layer]), csh2, csc2)
            tokens = jnp.concatenate([f_in_c.reshape(-1, d), f_in_l.reshape(-1, d)], axis=0)
        else:
            tokens = f_in_l.reshape(-1, d)
        f = moe_ffn(tokens, router_w[layer], router_b[layer], exp_w_gate[layer], exp_w_up[layer],
                    exp_w_down[layer], sh_w_gate[layer], sh_w_up[layer], sh_w_down[layer])
        xl = xl + g2 * rms_norm(f[f.shape[0] - b * s:].reshape(b, s, d), norm_ffn_post[layer])
        if with_ctx:
            xc = xc + cg2 * rms_norm(f[:b * ctx_len].reshape(b, ctx_len, d), norm_ffn_post[layer])
    return xl
```

```cpp
#include <hip/hip_runtime.h>
#include <stdint.h>
#include <stdio.h>

#define LAS __attribute__((address_space(3)))
#define GAS __attribute__((address_space(1)))
#ifndef MK_N_LAUNCHES
#define MK_N_LAUNCHES 0
#endif

typedef unsigned short bf16_t;
typedef short bf16x8 __attribute__((ext_vector_type(8)));
typedef short s16x4 __attribute__((ext_vector_type(4)));
typedef float f32x2 __attribute__((ext_vector_type(2)));
typedef float f32x4 __attribute__((ext_vector_type(4)));
typedef float f32x16 __attribute__((ext_vector_type(16)));
typedef unsigned u32x4 __attribute__((ext_vector_type(4)));
typedef unsigned u32x2 __attribute__((ext_vector_type(2)));

constexpr int DM = 2048, NB = 2, SEQ = 8192, CTXL = 256, TPB = CTXL + SEQ  , MROWS = NB * TPB  ;
constexpr int NTILE_M = MROWS / 256;
constexpr int AB_IN = 6176, AB_INP = 6400, CD_IN = 2560;
constexpr int NEXP = 64, TOPK = 6, EFF = 512;
constexpr int NSLOT = MROWS * TOPK;
constexpr int NSLOT_ALL = NSLOT + MROWS;
constexpr float NORM_EPS = 1e-6f;
constexpr int C_DQ = 0, C_DK = 1024, C_DV = 2048, C_MQ = 3072, C_MK = 3584, C_MV = 4096, C_MO = 5120, C_GT = 6144;
constexpr int C_CQ = 0, C_CKV = 448, C_KR = 960, C_SQ = 1024, C_SK = 2048, C_SV = 2304;

constexpr size_t MiB = 1u << 20;
constexpr size_t WS_CTL = 0, CTL_ZERO_BYTES = 1 * MiB;
constexpr size_t WS_MODP = 1 * MiB;
constexpr size_t WS_MODF = 4 * MiB;
constexpr size_t WS_ROPE = 5 * MiB;
constexpr size_t WS_WABIN = 6 * MiB, WS_WABOUT = 31 * MiB, WS_WCDIN = 39 * MiB, WS_WCDOUT = 49 * MiB, WS_WUQ = 57 * MiB, WS_WUKV = 59 * MiB, WS_WRT = 61 * MiB;
constexpr size_t WS_WGU = 65 * MiB;
constexpr size_t WS_WDN = 585 * MiB;
constexpr size_t WS_XR = 845 * MiB;
constexpr size_t WS_HN = 977 * MiB;
constexpr size_t WS_Y2 = 1043 * MiB;
constexpr size_t WS_REG = 1109 * MiB;
constexpr size_t WS_P = WS_REG;
constexpr size_t WS_AO = WS_P + 207 * MiB;
constexpr size_t WS_CC = WS_AO + 66 * MiB;
constexpr size_t WS_MDC = WS_CC + 66 * MiB;
constexpr size_t WS_MCST = WS_MDC + 66 * MiB;
constexpr size_t WS_MSM = WS_MCST + 33 * MiB;
constexpr size_t WS_QB = WS_MSM + 2 * MiB;
constexpr size_t WS_KV = WS_QB + 50 * MiB;
constexpr size_t WS_CQN = WS_KV + 66 * MiB;
constexpr size_t WS_CKVN = WS_CQN + 17 * MiB;
constexpr size_t WS_KR = WS_CKVN + 17 * MiB;
constexpr size_t WS_A_END = WS_KR + 3 * MiB;
constexpr size_t WS_FN2 = WS_REG;
constexpr size_t WS_LOG4 = WS_FN2 + 132 * MiB;
constexpr size_t WS_LIST = WS_LOG4 + 66 * MiB;
constexpr size_t WS_GATE = WS_LIST + 5 * MiB;
constexpr size_t WS_H = WS_GATE + 1 * MiB;
constexpr size_t WS_YS = WS_H + 116 * MiB;
constexpr size_t WS_B_END = WS_YS + 462 * MiB;
constexpr size_t WS_END = (WS_A_END > WS_B_END ? WS_A_END : WS_B_END);
constexpr size_t MSM_DN = 0;
constexpr size_t MSM_NST = 32 * 66 * 64 * 4;
constexpr size_t MSM_MLOC = 2 * 32 * 66 * 64 * 4;
constexpr size_t MSM_BTOT = MSM_MLOC + 32 * 66 * 4;
constexpr size_t MSM_MST = MSM_BTOT + 32 * 66 * 4;

constexpr int CW_TMO = 0;
constexpr int CW_BAR = 4096;
constexpr int CW_CNT = 16384;

constexpr int LDS_SCR = 0;
constexpr int LDS_AUX = 131072;
constexpr int LDS_CTL = 155648;
constexpr int LDS_BYTES = 155904;

__device__ __forceinline__ unsigned cvt_pk_bf16(float lo, float hi) { unsigned r; asm volatile("v_cvt_pk_bf16_f32 %0, %1, %2" : "=v"(r) : "v"(lo), "v"(hi)); return r; }
__device__ __forceinline__ unsigned f2bf(float f) { unsigned u = __builtin_bit_cast(unsigned, f); return (u + 0x7fffu + ((u >> 16) & 1u)) >> 16; }
__device__ __forceinline__ float bf2f(unsigned b) { return __builtin_bit_cast(float, b << 16); }
__device__ __forceinline__ float bflo(unsigned w) { return __builtin_bit_cast(float, w << 16); }
__device__ __forceinline__ float bfhi(unsigned w) { return __builtin_bit_cast(float, w & 0xffff0000u); }
__device__ __forceinline__ float wave_sum(float v) {
#pragma unroll
    for (int o = 1; o < 64; o <<= 1) v += __shfl_xor(v, o);
    return v;
}
__device__ __forceinline__ float wave_max(float v) {
#pragma unroll
    for (int o = 1; o < 64; o <<= 1) v = fmaxf(v, __shfl_xor(v, o));
    return v;
}
__device__ __forceinline__ float sigmoidf_(float x) { return 1.f / (1.f + __expf(-x)); }
__device__ __forceinline__ float logsigmoidf_(float x) { return fminf(x, 0.f) - log1pf(__expf(-fabsf(x))); }
#define LDS_WAIT() asm volatile("s_waitcnt lgkmcnt(0)" ::: "memory")
#define VM_WAIT() asm volatile("s_waitcnt vmcnt(0)" ::: "memory")

#define XB_TMO      128
#define XB_XCNT(j)  (256  + 64 * (j))
#define XB_XSUB(j)  (1280 + 64 * (j))
#define XB_XGEN(j)  (2304 + 64 * (j))
#define XB_TOP      3328
#define XB_TOPGEN   3392
#define XCD_BAR_WORDS 3456
#define XB_SPIN_CAP (1u << 20)
__device__ __forceinline__ unsigned xb_ld(unsigned* p)              { return __hip_atomic_load(p, __ATOMIC_RELAXED, __HIP_MEMORY_SCOPE_AGENT); }
__device__ __forceinline__ unsigned xb_add(unsigned* p, unsigned v) { return __hip_atomic_fetch_add(p, v, __ATOMIC_RELAXED, __HIP_MEMORY_SCOPE_AGENT); }
__device__ __forceinline__ unsigned xb_xcc_id() { return (unsigned)__builtin_amdgcn_s_getreg((3 << 11) | 20) & 0xFu; }
#define XB_SPIN(cond, bar) do { unsigned _sp = 0; while (cond) { __builtin_amdgcn_s_sleep(1); \
    if ((++_sp & 255u) == 0u) { if (xb_ld(&(bar)[XB_TMO])) break; if (_sp > XB_SPIN_CAP) { atomicAdd(&(bar)[XB_TMO], 1u); break; } } } } while (0)
struct XcdBarrier { unsigned* bar; unsigned x; volatile LAS unsigned* st; };
__device__ __forceinline__ XcdBarrier xcd_barrier_post(unsigned* bar, volatile LAS unsigned* st) {
    XcdBarrier b; b.bar = bar; b.x = xb_xcc_id(); b.st = st;
    if (threadIdx.x == 0) (void)xb_add(&bar[XB_XCNT(b.x)], 1u);
    return b;
}
__device__ __forceinline__ void xcd_barrier_complete(unsigned* bar, unsigned x, unsigned& nloc, unsigned& nx) {
    const unsigned G = gridDim.x * gridDim.y * gridDim.z;
    unsigned sum, cnt, mine, sp = 0u;
    for (;;) {
        sum = 0u; cnt = 0u; mine = 0u;
#pragma unroll
        for (unsigned j = 0; j < 16; ++j) { const unsigned c = xb_ld(&bar[XB_XCNT(j)]); sum += c; cnt += (c > 0u) ? 1u : 0u; mine = (j == x) ? c : mine; }
        if (sum == G) break;
        __builtin_amdgcn_s_sleep(1);
        if ((++sp & 255u) == 0u) { if (xb_ld(&bar[XB_TMO])) break; if (sp > XB_SPIN_CAP) { atomicAdd(&bar[XB_TMO], 1u); break; } }
    }
    nloc = mine > 0u ? mine : 1u; nx = cnt > 0u ? cnt : 1u;
}
__device__ __forceinline__ void xcd_barrier(const XcdBarrier& b) {
    asm volatile("s_waitcnt vmcnt(0)" ::: "memory");
    __syncthreads();
    if (threadIdx.x == 0) {
        unsigned* bar = b.bar;
        __builtin_amdgcn_s_waitcnt(0);
        unsigned nloc = b.st[0], nx = b.st[1];
        if (nloc == 0u) { xcd_barrier_complete(bar, b.x, nloc, nx); b.st[0] = nloc; b.st[1] = nx; }
        const unsigned old = xb_add(&bar[XB_XSUB(b.x)], 1u);
        const unsigned gen = old / nloc;
        if (old + 1u == (gen + 1u) * nloc) {
            __builtin_amdgcn_fence(__ATOMIC_RELEASE, "agent");
            asm volatile("s_waitcnt vmcnt(0)" ::: "memory");
            const unsigned og = xb_add(&bar[XB_TOP], 1u);
            const unsigned tg = og / nx;
            if (og + 1u == (tg + 1u) * nx) xb_add(&bar[XB_TOPGEN], 1u);
            else XB_SPIN(xb_ld(&bar[XB_TOPGEN]) == tg, bar);
            __builtin_amdgcn_fence(__ATOMIC_ACQUIRE, "agent");
            xb_add(&bar[XB_XGEN(b.x)], 1u);
            asm volatile("s_waitcnt vmcnt(0)" ::: "memory");
        } else {
            XB_SPIN(xb_ld(&bar[XB_XGEN(b.x)]) == gen, bar);
            __builtin_amdgcn_fence(__ATOMIC_ACQUIRE, "agent");
            asm volatile("s_waitcnt vmcnt(0)" ::: "memory");
        }
    }
    __syncthreads();
}

namespace pg8 {
constexpr int BM = 256, BK = 64, HALF = 128, HTB = HALF * BK * 2, STAGE_BYTES = 8 * HTB;
__host__ __device__ __forceinline__ int lds_byte(int r, int c) { const int st = (r >> 4) * 2 + (c >> 5), rr = r & 15, cc = c & 31, ob = rr * 64 + cc * 2; return st * 1024 + (ob ^ (((ob >> 9) & 1) << 5)); }
__host__ __device__ __forceinline__ void stage_rc(int b, int& R, int& C) { const int st = b / 1024, sb = b % 1024, swz = sb ^ (((sb >> 9) & 1) << 5); R = (st >> 1) * 16 + swz / 64; C = (st & 1) * 32 + (swz % 64) / 2; }
__host__ __device__ __forceinline__ int perm32(int rho) { const int n = rho >> 4, i = rho & 15; return 8 * (i >> 2) + 4 * n + (i & 3); }

struct Unit { int pm, pn, ex, rows; };

template <class P>
__device__ __forceinline__ void gemm_phase(LAS unsigned char* lds, const P& pol) {
    int tid_ = threadIdx.x; asm volatile("" : "+v"(tid_));
    const int tid = tid_, wid = __builtin_amdgcn_readfirstlane(tid >> 6), lane = tid & 63, wr = wid >> 2, wc = wid & 3, fr = lane & 15, fq = lane >> 4;
    const int nt = pol.nt;
    int R0, C0, R1, C1; stage_rc(tid * 16, R0, C0); stage_rc(tid * 16 + 8192, R1, C1);
    unsigned voffB[2];
    { const int Rb0 = P::PERM ? ((R0 & ~31) + perm32(R0 & 31)) : R0, Rb1 = P::PERM ? ((R1 & ~31) + perm32(R1 & 31)) : R1;
      voffB[0] = (unsigned)Rb0 * pol.ldb + (unsigned)C0 * 2u; voffB[1] = (unsigned)Rb1 * pol.ldb + (unsigned)C1 * 2u; }
    const size_t kstep = (size_t)(BK * 2);
    const size_t hstepB = (size_t)HALF * pol.ldb;
    const unsigned ldsw = (unsigned)wid * 1024u;
    const int aoff = lds_byte(wr * 64 + fr, fq * 8), boff = lds_byte(wc * 32 + fr, fq * 8);
#define PG8_SA(b, h) (((b) * 2 + (h)) * HTB)
#define PG8_SB(b, h) ((4 + (b) * 2 + (h)) * HTB)
#define PG8_STAGEB(bufoff, gbase) do { _Pragma("unroll") for (int _i = 0; _i < 2; ++_i) \
        __builtin_amdgcn_global_load_lds((const unsigned*)((const char*)(gbase) + voffB[_i]), (LAS unsigned*)(lds + (bufoff) + ldsw + _i * 8192), 16, 0, 0); } while (0)
#define PG8_STAGEA(bufoff, gbase, o0, o1) do { \
        __builtin_amdgcn_global_load_lds((const unsigned*)((const char*)(gbase) + (o0)), (LAS unsigned*)(lds + (bufoff) + ldsw), 16, 0, 0); \
        __builtin_amdgcn_global_load_lds((const unsigned*)((const char*)(gbase) + (o1)), (LAS unsigned*)(lds + (bufoff) + ldsw + 8192), 16, 0, 0); } while (0)
#define PG8_LDA(dst, b, h) do { _Pragma("unroll") for (int m = 0; m < 4; ++m) _Pragma("unroll") for (int k = 0; k < 2; ++k) dst[m][k] = *(const LAS bf16x8*)(lds + PG8_SA(b, h) + aoff + m * 2048 + k * 1024); } while (0)
#define PG8_LDB(dst, b, h) do { _Pragma("unroll") for (int n = 0; n < 2; ++n) _Pragma("unroll") for (int k = 0; k < 2; ++k) dst[n][k] = *(const LAS bf16x8*)(lds + PG8_SB(b, h) + boff + n * 2048 + k * 1024); } while (0)
#define PG8_MMA(ai, bj, At, Bt) do { __builtin_amdgcn_s_setprio(1); _Pragma("unroll") for (int m = 0; m < 4; ++m) _Pragma("unroll") for (int n = 0; n < 2; ++n) _Pragma("unroll") for (int k = 0; k < 2; ++k) \
        acc[ai][bj][m][n] = __builtin_amdgcn_mfma_f32_16x16x32_bf16(Bt[n][k], At[m][k], acc[ai][bj][m][n], 0, 0, 0); __builtin_amdgcn_s_setprio(0); } while (0)
#define PG8_WAIT_V(n) asm volatile("s_waitcnt vmcnt(" #n ")" ::: "memory")
#define PG8_WAIT_L(n) asm volatile("s_waitcnt lgkmcnt(" #n ")" ::: "memory")
#define PG8_BAR __builtin_amdgcn_s_barrier()
#define PG8_SCHED __builtin_amdgcn_sched_barrier(0)
    Unit cur, nxt; int ui = 0;
    if (!pol.next(0, cur)) return;
    f32x4 acc[2][2][4][2];
#pragma unroll
    for (int a = 0; a < 2; ++a)
#pragma unroll
        for (int b = 0; b < 2; ++b)
#pragma unroll
            for (int m = 0; m < 4; ++m)
#pragma unroll
                for (int n = 0; n < 2; ++n) acc[a][b][m][n] = (f32x4){0.f, 0.f, 0.f, 0.f};
    bf16x8 At[4][2], B0[2][2], B1[2][2];
    unsigned oA[2][2], oN[2][2];
    pol.a_off(cur, R0, R1, C0, C1, oA);
    const char* cA = pol.a_base(cur); const char* cB = pol.b_base(cur);
    PG8_STAGEB(PG8_SB(0, 0), cB); PG8_STAGEA(PG8_SA(0, 0), cA, oA[0][0], oA[0][1]); PG8_STAGEB(PG8_SB(0, 1), cB + hstepB); PG8_STAGEA(PG8_SA(0, 1), cA, oA[1][0], oA[1][1]);
    if (wr == 1) PG8_BAR;
    PG8_WAIT_V(4); PG8_BAR;
    PG8_STAGEB(PG8_SB(1, 0), cB + kstep); PG8_STAGEA(PG8_SA(1, 0), cA + kstep, oA[0][0], oA[0][1]); PG8_STAGEB(PG8_SB(1, 1), cB + hstepB + kstep);
    PG8_WAIT_V(6); PG8_BAR;
    for (;;) {
        const bool has_next = pol.next(ui + 1, nxt);
        const char* nA; const char* nB;
        if (has_next) { pol.a_off(nxt, R0, R1, C0, C1, oN); nA = pol.a_base(nxt); nB = pol.b_base(nxt); }
        else { oN[0][0] = oA[0][0]; oN[0][1] = oA[0][1]; oN[1][0] = oA[1][0]; oN[1][1] = oA[1][1]; nA = cA; nB = cB; }
        for (int t = 0; t < nt; t += 2) {
            const bool last = (t == nt - 2);
            const char* a1 = cA + (size_t)(t + 1) * kstep;
            const char* a2 = last ? nA : cA + (size_t)(t + 2) * kstep; const char* b2 = last ? nB : cB + (size_t)(t + 2) * kstep;
            const char* a3 = a2 + kstep; const char* b3 = b2 + kstep;
            const unsigned s00 = last ? oN[0][0] : oA[0][0], s01 = last ? oN[0][1] : oA[0][1], s10 = last ? oN[1][0] : oA[1][0], s11 = last ? oN[1][1] : oA[1][1];
            PG8_LDB(B0, 0, 0); PG8_SCHED; PG8_LDA(At, 0, 0); PG8_STAGEA(PG8_SA(1, 1), a1, oA[1][0], oA[1][1]);
            PG8_WAIT_L(8); PG8_BAR; PG8_WAIT_L(0); PG8_MMA(0, 0, At, B0); PG8_BAR; PG8_SCHED;
            PG8_LDB(B1, 0, 1); PG8_STAGEB(PG8_SB(0, 0), b2);
            PG8_BAR; PG8_WAIT_L(0); PG8_MMA(0, 1, At, B1); PG8_BAR;
            PG8_LDA(At, 0, 1); PG8_STAGEA(PG8_SA(0, 0), a2, s00, s01);
            PG8_BAR; PG8_WAIT_L(0); PG8_MMA(1, 0, At, B0); PG8_BAR; PG8_SCHED;
            PG8_STAGEB(PG8_SB(0, 1), b2 + hstepB);
            PG8_WAIT_V(6); PG8_BAR; PG8_MMA(1, 1, At, B1); PG8_BAR;
            PG8_LDB(B0, 1, 0); PG8_SCHED; PG8_LDA(At, 1, 0); PG8_STAGEA(PG8_SA(0, 1), a2, s10, s11);
            PG8_WAIT_L(8); PG8_BAR; PG8_WAIT_L(0); PG8_MMA(0, 0, At, B0); PG8_BAR; PG8_SCHED;
            PG8_LDB(B1, 1, 1); PG8_STAGEB(PG8_SB(1, 0), b3);
            PG8_BAR; PG8_WAIT_L(0); PG8_MMA(0, 1, At, B1); PG8_BAR;
            PG8_LDA(At, 1, 1); PG8_STAGEA(PG8_SA(1, 0), a3, s00, s01);
            PG8_BAR; PG8_WAIT_L(0); PG8_MMA(1, 0, At, B0); PG8_BAR; PG8_SCHED;
            PG8_STAGEB(PG8_SB(1, 1), b3 + hstepB);
            PG8_WAIT_V(6); PG8_BAR; PG8_MMA(1, 1, At, B1); PG8_BAR;
        }
        pol.epi(acc, cur, wr, wc, fr, fq);
        if (!has_next) break;
#pragma unroll
        for (int a = 0; a < 2; ++a)
#pragma unroll
            for (int b = 0; b < 2; ++b)
#pragma unroll
                for (int m = 0; m < 4; ++m)
#pragma unroll
                    for (int n = 0; n < 2; ++n) acc[a][b][m][n] = (f32x4){0.f, 0.f, 0.f, 0.f};
        cur = nxt; cA = nA; cB = nB; ++ui;
        oA[0][0] = oN[0][0]; oA[0][1] = oN[0][1]; oA[1][0] = oN[1][0]; oA[1][1] = oN[1][1];
    }
    PG8_WAIT_V(0);
    if (wr == 0) PG8_BAR;
    PG8_BAR;
#undef PG8_SA
#undef PG8_SB
#undef PG8_STAGEA
#undef PG8_STAGEB
#undef PG8_LDA
#undef PG8_LDB
#undef PG8_MMA
#undef PG8_WAIT_V
#undef PG8_WAIT_L
#undef PG8_BAR
#undef PG8_SCHED
}

__device__ __forceinline__ bool static_order(int nM, int nN, int G, int c, int i, int& pm, int& pn) {
    const int nwg = nM * nN; const long L = (long)i * G + c; if (L >= nwg) return false;
    int wgid = (int)L; { const int q = nwg / 8, r = nwg % 8, xcd = wgid % 8, off = wgid / 8; wgid = (xcd < r ? xcd * (q + 1) : r * (q + 1) + (xcd - r) * q) + off; }
    const int nig = 8 * nN, gid = wgid / nig, fm = gid * 8, gsz = (nM - fm) < 8 ? (nM - fm) : 8;
    pm = fm + ((wgid % nig) % gsz); pn = (wgid % nig) / gsz; return true;
}

__device__ __forceinline__ void store_tile_bf16(const f32x4 (&acc)[2][2][4][2], bf16_t* base  , size_t ldc, int wr, int wc, int fr, int fq, int rows_valid) {
#pragma unroll
    for (int ai = 0; ai < 2; ++ai)
#pragma unroll
        for (int m = 0; m < 4; ++m) { const int r = ai * HALF + wr * 64 + m * 16 + fr; if (r < rows_valid) { bf16_t* rowp = base + (size_t)r * ldc + wc * 32 + 8 * fq;
#pragma unroll
            for (int bj = 0; bj < 2; ++bj) { const f32x4 v0 = acc[ai][bj][m][0], v1 = acc[ai][bj][m][1];
                u32x4 w; w.x = cvt_pk_bf16(v0[0], v0[1]); w.y = cvt_pk_bf16(v0[2], v0[3]); w.z = cvt_pk_bf16(v1[0], v1[1]); w.w = cvt_pk_bf16(v1[2], v1[3]);
                *(u32x4*)(rowp + bj * HALF) = w; } } }
}
}

namespace att {
constexpr int NW = 8, QBLK = 32, KVBLK = 64, DV = 128;
constexpr int SHM_V = KVBLK * DV * 2  , SHM_K = KVBLK * 128 * 2  , SHM_K2 = KVBLK * 64 * 2  ;
constexpr int OFF_V = 0, OFF_K = 2 * SHM_V, OFF_K2 = OFF_K + 2 * SHM_K, OFF_WS = OFF_K2 + 2 * SHM_K2, ATT_LDS = OFF_WS + NW * 64 * 4  , OFF_QR = ATT_LDS  ;
constexpr float THR = 8.f;
#define KSWZ(row, colB) ((row) * 256 + ((colB) ^ (((row) & 7) << 4)))
#define KSWZ64(row, colB) ((row) * 128 + ((colB) ^ ((((row) >> 1) & 7) << 4)))
#define SBAR() __builtin_amdgcn_sched_barrier(0)
__device__ __forceinline__ int crow(int r, int hi) { return (r & 3) + 8 * (r >> 2) + 4 * hi; }
__device__ __forceinline__ int v_st(int k, int c) { const int kk = (k & ~0xC) | ((k & 4) << 1) | ((k & 8) >> 1); return ((kk >> 3) * 4 + (c >> 5)) * 512 + ((kk & 7) * 32 + (c & 31)) * 2; }
__device__ __forceinline__ int v_rd_base(int lane) { return ((lane & 3) << 3) | (((lane >> 2) & 3) << 6) | (((lane >> 4) & 1) << 5) | (((lane >> 5) & 1) << 8); }
constexpr int v_rd_off(int d0, int ks, int half) { return d0 * 512 + ks * 4096 + half * 2048; }
template <int OFF> __device__ __forceinline__ s16x4 tr_read(int vb) {
    s16x4 r; asm volatile("ds_read_b64_tr_b16 %0, %1 offset:%2" : "=&v"(r) : "v"(vb), "i"(OFF) : "memory"); return r;
}
template <int D0> __device__ __forceinline__ void pv_one(f32x16& od, int vb, bf16x8 pa0, bf16x8 pa1, bf16x8 pa2, bf16x8 pa3) {
    const s16x4 l0 = tr_read<v_rd_off(D0, 0, 0)>(vb), h0 = tr_read<v_rd_off(D0, 0, 1)>(vb), l1 = tr_read<v_rd_off(D0, 1, 0)>(vb), h1 = tr_read<v_rd_off(D0, 1, 1)>(vb);
    const s16x4 l2 = tr_read<v_rd_off(D0, 2, 0)>(vb), h2 = tr_read<v_rd_off(D0, 2, 1)>(vb), l3 = tr_read<v_rd_off(D0, 3, 0)>(vb), h3 = tr_read<v_rd_off(D0, 3, 1)>(vb);
    asm volatile("s_waitcnt lgkmcnt(0)" ::: "memory"); SBAR();
#define PK(L, H) (bf16x8){L[0], L[1], L[2], L[3], H[0], H[1], H[2], H[3]}
    od = __builtin_amdgcn_mfma_f32_32x32x16_bf16(pa0, PK(l0, h0), od, 0, 0, 0);
    od = __builtin_amdgcn_mfma_f32_32x32x16_bf16(pa1, PK(l1, h1), od, 0, 0, 0);
    od = __builtin_amdgcn_mfma_f32_32x32x16_bf16(pa2, PK(l2, h2), od, 0, 0, 0);
    od = __builtin_amdgcn_mfma_f32_32x32x16_bf16(pa3, PK(l3, h3), od, 0, 0, 0);
#undef PK
}
__device__ __forceinline__ void pv_d0(f32x16* o, int vb, bf16x8 pa0, bf16x8 pa1, bf16x8 pa2, bf16x8 pa3) {
    pv_one<0>(o[0], vb, pa0, pa1, pa2, pa3); pv_one<1>(o[1], vb, pa0, pa1, pa2, pa3); pv_one<2>(o[2], vb, pa0, pa1, pa2, pa3); pv_one<3>(o[3], vb, pa0, pa1, pa2, pa3);
}
__device__ __forceinline__ void partialSM(f32x16& p0, f32x16& p1, float& m_reg, float& mn, float& alpha, float C, float thr_raw) {
    float pmax = p0[0];
#pragma unroll
    for (int r = 1; r < 16; ++r) pmax = fmaxf(pmax, p0[r]);
#pragma unroll
    for (int r = 0; r < 16; ++r) pmax = fmaxf(pmax, p1[r]);
    { auto rr = __builtin_amdgcn_permlane32_swap(__builtin_bit_cast(unsigned, pmax), __builtin_bit_cast(unsigned, pmax), false, false);
      pmax = fmaxf(__builtin_bit_cast(float, rr[0]), __builtin_bit_cast(float, rr[1])); }
    if (__builtin_expect(__all(pmax - m_reg <= thr_raw), 1)) { mn = m_reg; alpha = 1.f; }
    else { mn = fmaxf(m_reg, pmax); alpha = __builtin_amdgcn_exp2f((m_reg - mn) * C); m_reg = mn; }
    const float mnC = -mn * C;
#pragma unroll
    for (int r = 0; r < 16; ++r) p0[r] = fmaf(p0[r], C, mnC);
#pragma unroll
    for (int r = 0; r < 16; ++r) p1[r] = fmaf(p1[r], C, mnC);
#pragma unroll
    for (int r = 0; r < 16; ++r) p0[r] = __builtin_amdgcn_exp2f(p0[r]);
}
__device__ __forceinline__ void finishSM(f32x16& p0, f32x16& p1, float alpha, float& l_reg, bf16x8& pa0, bf16x8& pa1, bf16x8& pa2, bf16x8& pa3) {
#pragma unroll
    for (int r = 0; r < 16; ++r) p1[r] = __builtin_amdgcn_exp2f(p1[r]);
    float ps = 0;
#pragma unroll
    for (int r = 0; r < 16; ++r) ps += p0[r];
#pragma unroll
    for (int r = 0; r < 16; ++r) ps += p1[r];
    { auto rr = __builtin_amdgcn_permlane32_swap(__builtin_bit_cast(unsigned, ps), __builtin_bit_cast(unsigned, ps), false, false);
      ps = __builtin_bit_cast(float, rr[0]) + __builtin_bit_cast(float, rr[1]); }
    l_reg = l_reg * alpha + ps;
#define PK4(P, BASE, OUT) do { unsigned a0 = cvt_pk_bf16(P[BASE + 0], P[BASE + 1]), a1 = cvt_pk_bf16(P[BASE + 2], P[BASE + 3]);   \
    unsigned b0 = cvt_pk_bf16(P[BASE + 4], P[BASE + 5]), b1 = cvt_pk_bf16(P[BASE + 6], P[BASE + 7]);                              \
    auto r0 = __builtin_amdgcn_permlane32_swap(a0, b0, false, false); auto r1 = __builtin_amdgcn_permlane32_swap(a1, b1, false, false); \
    u32x4 w = {r0[0], r1[0], r0[1], r1[1]}; OUT = __builtin_bit_cast(bf16x8, w); } while (0)
    PK4(p0, 0, pa0); PK4(p0, 8, pa1); PK4(p1, 0, pa2); PK4(p1, 8, pa3);
#undef PK4
}
__device__ __forceinline__ bf16x8 rope8(bf16x8 v, const char* tabc, unsigned off) {
    const f32x4 c01 = *(const f32x4*)(tabc + off), c23 = *(const f32x4*)(tabc + off + 16);
    const u32x4 w = __builtin_bit_cast(u32x4, v); u32x4 o;
    { const float x1 = bflo(w[0]), x2 = bfhi(w[0]); o[0] = cvt_pk_bf16(x1 * c01[0] - x2 * c01[1], x1 * c01[1] + x2 * c01[0]); }
    { const float x1 = bflo(w[1]), x2 = bfhi(w[1]); o[1] = cvt_pk_bf16(x1 * c01[2] - x2 * c01[3], x1 * c01[3] + x2 * c01[2]); }
    { const float x1 = bflo(w[2]), x2 = bfhi(w[2]); o[2] = cvt_pk_bf16(x1 * c23[0] - x2 * c23[1], x1 * c23[1] + x2 * c23[0]); }
    { const float x1 = bflo(w[3]), x2 = bfhi(w[3]); o[3] = cvt_pk_bf16(x1 * c23[2] - x2 * c23[3], x1 * c23[3] + x2 * c23[2]); }
    return __builtin_bit_cast(bf16x8, o);
}

struct UnitDesc {
    const bf16_t* Q; int ldq;
    const bf16_t* K; int ldk;
    const bf16_t* K2; int ldk2;
    const bf16_t* V; int ldv;
    bf16_t* O; int ldo;
    int NT;
    float C;
    const f32x2* rope; int qtok0;
    int seg_tiles, seg2_row0;
    int ktok0;
    float sink_l2;
};
template <int MODE>
__device__ __forceinline__ void attn_unit(const UnitDesc& U, char* lds) {
    constexpr int DQK = MODE == 0 ? 64 : (MODE == 1 ? 192 : 128), NQ = DQK / 16, NQR = (MODE == 1) ? 4 : NQ;
    int tid_ = threadIdx.x; asm volatile("" : "+v"(tid_));
    const int tid = tid_, wid = tid >> 6, lane = tid & 63, r32 = lane & 31, hi = lane >> 5;
    char* V_lds = lds + OFF_V; char* K_lds = lds + OFF_K; char* K2_lds = lds + OFF_K2;
    float* ws = (float*)(lds + OFF_WS) + wid * 64; float* li_l = ws; float* al_l = ws + 32;
    float m_reg = -1e30f, l_reg = 0; f32x16 o[4] = {}; bf16x8 qr[NQR];
    bf16x8* QRl = (bf16x8*)(lds + OFF_QR) + wid * 512 + lane;
    {   const bf16_t* Qw = U.Q + (size_t)(wid * QBLK + r32) * U.ldq + hi * 8;
        const int qt = U.qtok0 + wid * QBLK + r32, prow = qt >> 6, pcol = qt & 63;
        constexpr int RQ = (MODE == 2) ? 32 : 16;
        const unsigned orow = (unsigned)prow * RQ * 8 + hi * 32, ocol = (unsigned)pcol * RQ * 8 + hi * 32; const char* tabc = (const char*)U.rope;
#pragma unroll
        for (int d0 = 0; d0 < NQ; ++d0) { bf16x8 v = *reinterpret_cast<const bf16x8*>(Qw + d0 * 16);
            const int pi = (MODE == 1) ? (d0 - 8) * 8 : d0 * 8;
            if (MODE != 1 || d0 >= 8) { if (MODE != 0 || U.rope) v = rope8(v, tabc, (pi < RQ ? orow : ocol) + (unsigned)((pi < RQ ? pi : pi - RQ) * 8)); }
            if (MODE == 1 && d0 >= NQR) QRl[(d0 - NQR) * 64] = v; else qr[d0 < NQR ? d0 : 0] = v; }
    }
    const float thr_raw = THR * 1.4426950408889634f / U.C;
    const int sr = tid >> 4, sc = (tid & 15) * 8;
    const int vst0 = v_st(sr, sc), vst1 = v_st(32 + sr, sc);
    const int k64r = tid >> 3, k64c = (tid & 7) * 8;
    const int vb0 = (int)(uintptr_t)V_lds + v_rd_base(lane);
    constexpr int DEPTH = (MODE == 0) ? 2 : 1, SE = 0, SO = DEPTH - 1;
    bf16x8 sv0[DEPTH], sv1[DEPTH], sk0[DEPTH], sk1[DEPTH], sk2[DEPTH];
    auto krow = [&](int t) -> int { if (MODE == 2) return t < U.seg_tiles ? t * 64 : U.seg2_row0 + (t - U.seg_tiles) * 64; return t * 64; };
#define SLOAD(i, t) do { const int _r = krow(t); \
    sv0[i] = *reinterpret_cast<const bf16x8*>(U.V + (size_t)(_r + sr) * U.ldv + sc); sv1[i] = *reinterpret_cast<const bf16x8*>(U.V + (size_t)(_r + 32 + sr) * U.ldv + sc); \
    if (MODE == 0) { sk0[i] = *reinterpret_cast<const bf16x8*>(U.K + (size_t)(_r + k64r) * U.ldk + k64c); } \
    else { sk0[i] = *reinterpret_cast<const bf16x8*>(U.K + (size_t)(_r + sr) * U.ldk + sc); sk1[i] = *reinterpret_cast<const bf16x8*>(U.K + (size_t)(_r + 32 + sr) * U.ldk + sc); } \
    if (MODE == 1) { sk2[i] = *reinterpret_cast<const bf16x8*>(U.K2 + (size_t)(_r + k64r) * U.ldk2 + k64c); } } while (0)
#define SWRITE(b, i) do { *(bf16x8*)(V_lds + (b) * SHM_V + vst0) = sv0[i]; *(bf16x8*)(V_lds + (b) * SHM_V + vst1) = sv1[i]; \
    if (MODE == 0) { *(bf16x8*)(K_lds + (b) * SHM_K + KSWZ64(k64r, k64c * 2)) = sk0[i]; } \
    else { *(bf16x8*)(K_lds + (b) * SHM_K + KSWZ(sr, sc * 2)) = sk0[i]; *(bf16x8*)(K_lds + (b) * SHM_K + KSWZ(32 + sr, sc * 2)) = sk1[i]; } \
    if (MODE == 1) { *(bf16x8*)(K2_lds + (b) * SHM_K2 + KSWZ64(k64r, k64c * 2)) = sk2[i]; } } while (0)
#define SWAIT() do { if (MODE == 0) asm volatile("s_waitcnt vmcnt(3)" ::: "memory"); else asm volatile("s_waitcnt vmcnt(0)" ::: "memory"); } while (0)
#define RESC(a) do { if (__any((a) < 1.f)) { if (hi == 0) al_l[r32] = (a); asm volatile("s_waitcnt lgkmcnt(0)" ::: "memory"); \
    _Pragma("unroll") for (int d = 0; d < 4; ++d) _Pragma("unroll") for (int r = 0; r < 16; ++r) o[d][r] *= al_l[crow(r, hi)]; } } while (0)
#define QKT(p0, p1, b) do { p0 = f32x16{}; p1 = f32x16{}; \
    if (MODE == 0) { _Pragma("unroll") for (int d0 = 0; d0 < 4; ++d0) { const int cb = (d0 * 16 + hi * 8) * 2; \
        const bf16x8 b0 = *reinterpret_cast<const bf16x8*>(K_lds + (b) * SHM_K + KSWZ64(r32, cb)); const bf16x8 b1 = *reinterpret_cast<const bf16x8*>(K_lds + (b) * SHM_K + KSWZ64(32 + r32, cb)); \
        p0 = __builtin_amdgcn_mfma_f32_32x32x16_bf16(b0, qr[d0], p0, 0, 0, 0); p1 = __builtin_amdgcn_mfma_f32_32x32x16_bf16(b1, qr[d0], p1, 0, 0, 0); } } \
    else { _Pragma("unroll") for (int d0 = 0; d0 < 8; ++d0) { const int cb = (d0 * 16 + hi * 8) * 2; \
        const bf16x8 b0 = *reinterpret_cast<const bf16x8*>(K_lds + (b) * SHM_K + KSWZ(r32, cb)); const bf16x8 b1 = *reinterpret_cast<const bf16x8*>(K_lds + (b) * SHM_K + KSWZ(32 + r32, cb)); \
        const bf16x8 qf = (MODE == 1 && d0 >= NQR) ? QRl[(d0 >= NQR ? d0 - NQR : 0) * 64] : qr[d0 < NQR ? d0 : 0]; \
        p0 = __builtin_amdgcn_mfma_f32_32x32x16_bf16(b0, qf, p0, 0, 0, 0); p1 = __builtin_amdgcn_mfma_f32_32x32x16_bf16(b1, qf, p1, 0, 0, 0); } \
      if (MODE == 1) { _Pragma("unroll") for (int d0 = 0; d0 < 4; ++d0) { const int cb = (d0 * 16 + hi * 8) * 2; \
        const bf16x8 b0 = *reinterpret_cast<const bf16x8*>(K2_lds + (b) * SHM_K2 + KSWZ64(r32, cb)); const bf16x8 b1 = *reinterpret_cast<const bf16x8*>(K2_lds + (b) * SHM_K2 + KSWZ64(32 + r32, cb)); \
        const bf16x8 qf = QRl[(8 - NQR + d0) * 64]; p0 = __builtin_amdgcn_mfma_f32_32x32x16_bf16(b0, qf, p0, 0, 0, 0); p1 = __builtin_amdgcn_mfma_f32_32x32x16_bf16(b1, qf, p1, 0, 0, 0); } } } } while (0)
#define MASK(p0, p1, t) do { if (MODE == 2) { if ((t) >= U.seg_tiles) { const int _d0 = U.ktok0 + ((t) - U.seg_tiles) * 64 - (U.qtok0 + wid * QBLK + r32); \
    _Pragma("unroll") for (int r = 0; r < 16; ++r) { const int _dk = _d0 + crow(r, hi); \
        if (_dk > 128 || _dk < -128) p0[r] = -1e30f; if (_dk + 32 > 128 || _dk + 32 < -128) p1[r] = -1e30f; } } } } while (0)
    f32x16 pA0, pA1, pB0, pB1; float mnA, mnB, alA, alB; bf16x8 pa0, pa1, pa2, pa3; const int NT = U.NT;
    SLOAD(SE, 0); asm volatile("s_waitcnt vmcnt(0)" ::: "memory"); SWRITE(0, SE); __syncthreads();
    QKT(pA0, pA1, 0); MASK(pA0, pA1, 0); partialSM(pA0, pA1, m_reg, mnA, alA, U.C, thr_raw);
    SLOAD(SO, 1); if (DEPTH == 2) { if (2 < NT) SLOAD(SE, 2); }
    if (DEPTH == 2 && 2 < NT) SWAIT(); else asm volatile("s_waitcnt vmcnt(0)" ::: "memory");
    SWRITE(1, SO); __syncthreads();
    for (int j = 1; j + 1 < NT; j += 2) {
        SBAR(); QKT(pB0, pB1, 1); MASK(pB0, pB1, j);
        finishSM(pA0, pA1, alA, l_reg, pa0, pa1, pa2, pa3); SBAR();
        SLOAD(SO, j + DEPTH); SBAR();
        pv_d0(o, vb0, pa0, pa1, pa2, pa3); partialSM(pB0, pB1, m_reg, mnB, alB, U.C, thr_raw);
        __syncthreads(); SWAIT(); SWRITE(0, SE);
        RESC(alB); __syncthreads();
        SBAR(); QKT(pA0, pA1, 0); MASK(pA0, pA1, j + 1);
        finishSM(pB0, pB1, alB, l_reg, pa0, pa1, pa2, pa3); SBAR();
        if (DEPTH == 1 || j + 3 < NT) SLOAD(SE, j + 1 + DEPTH); SBAR();
        pv_d0(o, vb0 + SHM_V, pa0, pa1, pa2, pa3); partialSM(pA0, pA1, m_reg, mnA, alA, U.C, thr_raw);
        __syncthreads(); if (DEPTH == 1 || j + 3 < NT) SWAIT(); else asm volatile("s_waitcnt vmcnt(0)" ::: "memory");
        SWRITE(1, SO);
        RESC(alA); __syncthreads();
    }
    SBAR(); QKT(pB0, pB1, 1); MASK(pB0, pB1, NT - 1);
    finishSM(pA0, pA1, alA, l_reg, pa0, pa1, pa2, pa3); SBAR();
    pv_d0(o, vb0, pa0, pa1, pa2, pa3); partialSM(pB0, pB1, m_reg, mnB, alB, U.C, thr_raw);
    __syncthreads(); RESC(alB);
    finishSM(pB0, pB1, alB, l_reg, pa0, pa1, pa2, pa3); SBAR();
    pv_d0(o, vb0 + SHM_V, pa0, pa1, pa2, pa3);
    if (MODE == 2) l_reg += __builtin_amdgcn_exp2f(U.sink_l2 - m_reg * U.C);
    if (hi == 0) li_l[r32] = l_reg; asm volatile("s_waitcnt lgkmcnt(0)" ::: "memory");
    float rli[16];
#pragma unroll
    for (int r = 0; r < 16; ++r) rli[r] = __builtin_amdgcn_rcpf(li_l[crow(r, hi)]);
    int hio = hi, r32o = r32; asm volatile("" : "+v"(hio), "+v"(r32o));
    bf16_t* Ow = U.O + (size_t)(wid * QBLK + 4 * hio) * U.ldo + r32o;
#pragma unroll
    for (int r = 0; r < 16; ++r) { const int orow = (r & 3) + 8 * (r >> 2);
#pragma unroll
        for (int d0 = 0; d0 < 4; ++d0) Ow[(size_t)orow * U.ldo + d0 * 32] = (bf16_t)f2bf(o[d0][r] * rli[r]); }
    __syncthreads();
#undef SLOAD
#undef SWRITE
#undef SWAIT
#undef RESC
#undef QKT
#undef MASK
}
}

struct Args { const float* in[31]; float* out; unsigned char* ws; int ph_lo, ph_hi; };
enum { I_X = 0, I_C, I_CTX, I_CCTX, I_MODW, I_MODB, I_NMPRE, I_NMPOST, I_NFPRE, I_NFPOST, I_ABIN, I_ABOUT, I_DLAM, I_DNORM, I_MGB, I_MNORM, I_CDIN, I_CDOUT,
       I_QNORM, I_WUQ, I_KVNORM, I_WUKV, I_SINK, I_RW, I_RB, I_EG, I_EU, I_ED, I_SG, I_SU, I_SD };
struct Frame {
    LAS unsigned char* lds; char* ldsg;
    unsigned char* ws; const float* const* in; float* out;
    int tid, lane, wave, G, bid, gw, NGW;
};
__device__ __forceinline__ int row_batch(int r) { return r >= TPB ? 1 : 0; }
__device__ __forceinline__ const float* src_row(const Frame& F, int r) {
    const int b = row_batch(r), pos = r - b * TPB;
    return pos < CTXL ? F.in[I_CTX] + ((size_t)b * CTXL + pos) * DM : F.in[I_X] + ((size_t)b * SEQ + (pos - CTXL)) * DM;
}
__device__ __forceinline__ int row_variant(int r) { const int b = row_batch(r), pos = r - b * TPB; return pos < CTXL ? 2 : b; }

__device__ __forceinline__ void tr_item(const float* __restrict__ src, size_t ldsrc, bf16_t* __restrict__ dst, size_t ldd, LAS float* scr, int lane) {
    const int kk = lane >> 3, n4 = (lane & 7) * 4;
    f32x4 v[8];
#pragma unroll
    for (int i = 0; i < 8; ++i) v[i] = *(const f32x4*)(src + (size_t)(8 * i + kk) * ldsrc + n4);
#pragma unroll
    for (int i = 0; i < 8; ++i) { LAS float* s = scr + (8 * i + kk) * 33 + n4; s[0] = v[i].x; s[1] = v[i].y; s[2] = v[i].z; s[3] = v[i].w; }
    LDS_WAIT(); asm volatile("" ::: "memory");
    const int c = lane & 7;
#pragma unroll
    for (int j = 0; j < 4; ++j) { const int n = (lane >> 3) + 8 * j; const LAS float* s = scr + (8 * c) * 33 + n;
        u32x4 o; o.x = cvt_pk_bf16(s[0 * 33], s[1 * 33]); o.y = cvt_pk_bf16(s[2 * 33], s[3 * 33]); o.z = cvt_pk_bf16(s[4 * 33], s[5 * 33]); o.w = cvt_pk_bf16(s[6 * 33], s[7 * 33]);
        *(u32x4*)(dst + (size_t)n * ldd + 8 * c) = o; }
    LDS_WAIT(); asm volatile("" ::: "memory");
}
__device__ __forceinline__ void p0_prologue(Frame& F) {
    unsigned char* ws = F.ws;
    LAS float* sil = (LAS float*)(F.lds + LDS_AUX);
    for (int i = F.tid; i < 3 * DM; i += 512) { const int v = i / DM, k = i % DM; const float c = v < 2 ? F.in[I_C][v * DM + k] : F.in[I_CCTX][k]; sil[i] = c / (1.f + __expf(-c)); }
    __syncthreads();
    if (F.gw < 2 * 8 * 48) {
        const int l = F.gw / 384, r = F.gw % 384, ks = r / 48, cg = r % 48;
        const float* W = F.in[I_MODW] + ((size_t)l * DM + ks * 256) * 12288 + cg * 256 + F.lane * 4;
        f32x4 a0 = {0, 0, 0, 0}, a1 = a0, a2 = a0;
#pragma unroll 8
        for (int k = 0; k < 256; ++k) { const f32x4 w = *(const f32x4*)(W + (size_t)k * 12288); const float s0 = sil[ks * 256 + k], s1 = sil[DM + ks * 256 + k], s2 = sil[2 * DM + ks * 256 + k];
            a0 += w * s0; a1 += w * s1; a2 += w * s2; }
        float* o = (float*)(ws + WS_MODP) + ((size_t)(l * 8 + ks) * 3) * 12288 + cg * 256 + F.lane * 4;
        *(f32x4*)(o) = a0; *(f32x4*)(o + 12288) = a1; *(f32x4*)(o + 2 * 12288) = a2;
    }
    if (F.bid == 0) {
        f32x2* t64 = (f32x2*)(ws + WS_ROPE); f32x2* t128 = (f32x2*)(ws + WS_ROPE + 65536);
        for (int i = F.tid; i < 128 * 16; i += 512) { const int pos = i >> 4, j = i & 15; const float inv = exp2f(-(float)j * (13.287712379549449f / 16.f)); const float a = (float)pos * inv * 0.15915494309189535f; t64[i] = (f32x2){__builtin_amdgcn_cosf(a), __builtin_amdgcn_sinf(a)}; }
        for (int i = F.tid; i < 128 * 32; i += 512) { const int pos = i >> 5, j = i & 31; const float inv = exp2f(-(float)j * (13.287712379549449f / 32.f)); const float a = (float)pos * inv * 0.15915494309189535f; t128[i] = (f32x2){__builtin_amdgcn_cosf(a), __builtin_amdgcn_sinf(a)}; }
    }
    for (int i = F.bid * 512 + F.tid; i < 2 * 256 * 512; i += F.G * 512) {
        const int k8 = i & 511, r = (i >> 9) & 255, l = i >> 17; const int k0 = k8 * 8;
        unsigned o[8];
#pragma unroll
        for (int j = 0; j < 8; ++j) { const int k = k0 + j; float val = 0.f;
            if (r < 128 && (r < 64 || k < 2048)) { const float w = F.in[I_RW][((size_t)l * DM + (k & 2047)) * 64 + (r & 63)]; const float h = bf2f(f2bf(w)); val = r < 64 ? h : (w - h); }
            o[j] = f2bf(val); }
        u32x4 w4 = {o[0] | (o[1] << 16), o[2] | (o[3] << 16), o[4] | (o[5] << 16), o[6] | (o[7] << 16)};
        *(u32x4*)((bf16_t*)(ws + WS_WRT) + ((size_t)(l * 256 + r) * 4096 + k0)) = w4;
    }
    for (int i = F.bid * 512 + F.tid; i < 224 * 256; i += F.G * 512) *(u32x4*)((bf16_t*)(ws + WS_WABIN) + (size_t)AB_IN * DM + (size_t)i * 8) = (u32x4){0, 0, 0, 0};
    for (int i = F.bid * 512 + F.tid; i < 1536 * 8; i += F.G * 512) *(u32x4*)((bf16_t*)(ws + WS_WUQ) + (size_t)(i >> 3) * 512 + 448 + (i & 7) * 8) = (u32x4){0, 0, 0, 0};
    LAS float* scr = (LAS float*)(F.lds + LDS_SCR + F.wave * 16384);
    constexpr int J1 = 32 * 193, J2 = 32 * 64, J3 = 32 * 80, J4 = 32 * 64, J5 = 7 * 48, J6 = 8 * 64, JE = 2 * 64 * 512, JS = 2 * 512;
    constexpr int NITEMS = J1 + J2 + J3 + J4 + J5 + J6 + 3 * JE + 3 * JS;
    for (int it = F.gw; it < NITEMS; it += F.NGW) {
        int r = it;
        if (r < J1) { const int kb = r / 193, nb = r % 193; tr_item(F.in[I_ABIN] + (size_t)kb * 64 * AB_IN + nb * 32, AB_IN, (bf16_t*)(ws + WS_WABIN) + (size_t)nb * 32 * DM + kb * 64, DM, scr, F.lane); continue; } r -= J1;
        if (r < J2) { const int kb = r / 64, nb = r % 64; tr_item(F.in[I_ABOUT] + (size_t)kb * 64 * DM + nb * 32, DM, (bf16_t*)(ws + WS_WABOUT) + (size_t)nb * 32 * DM + kb * 64, DM, scr, F.lane); continue; } r -= J2;
        if (r < J3) { const int kb = r / 80, nb = r % 80; tr_item(F.in[I_CDIN] + (size_t)kb * 64 * CD_IN + nb * 32, CD_IN, (bf16_t*)(ws + WS_WCDIN) + (size_t)nb * 32 * DM + kb * 64, DM, scr, F.lane); continue; } r -= J3;
        if (r < J4) { const int kb = r / 64, nb = r % 64; tr_item(F.in[I_CDOUT] + (size_t)kb * 64 * DM + nb * 32, DM, (bf16_t*)(ws + WS_WCDOUT) + (size_t)nb * 32 * DM + kb * 64, DM, scr, F.lane); continue; } r -= J4;
        if (r < J5) { const int kb = r / 48, nb = r % 48; tr_item(F.in[I_WUQ] + (size_t)kb * 64 * 1536 + nb * 32, 1536, (bf16_t*)(ws + WS_WUQ) + (size_t)nb * 32 * 512 + kb * 64, 512, scr, F.lane); continue; } r -= J5;
        if (r < J6) { const int kb = r / 64, nb = r % 64; tr_item(F.in[I_WUKV] + (size_t)kb * 64 * 2048 + nb * 32, 2048, (bf16_t*)(ws + WS_WUKV) + (size_t)nb * 32 * 512 + kb * 64, 512, scr, F.lane); continue; } r -= J6;
        if (r < 2 * JE) {
            const int up = r >= JE; if (up) r -= JE; const int le = r / 512, q = r % 512, kb = q / 16, nb = q % 16, l = le >> 6, e = le & 63; const int n0 = nb * 32;
            tr_item((up ? F.in[I_EU] : F.in[I_EG]) + ((size_t)le * DM + kb * 64) * EFF + n0, EFF, (bf16_t*)(ws + WS_WGU) + ((size_t)(l * 65 + e) * 1024 + (n0 >> 7) * 256 + up * 128 + (n0 & 127)) * DM + kb * 64, DM, scr, F.lane); continue; } r -= 2 * JE;
        if (r < JE) {
            const int le = r / 512, q = r % 512, kb = q / 64, nb = q % 64, l = le >> 6, e = le & 63;
            tr_item(F.in[I_ED] + ((size_t)le * EFF + kb * 64) * DM + nb * 32, DM, (bf16_t*)(ws + WS_WDN) + ((size_t)(l * 65 + e) * 2048 + nb * 32) * EFF + kb * 64, EFF, scr, F.lane); continue; } r -= JE;
        if (r < 2 * JS) {
            const int up = r >= JS; if (up) r -= JS; const int l = r / 512, q = r % 512, kb = q / 16, nb = q % 16; const int n0 = nb * 32;
            tr_item((up ? F.in[I_SU] : F.in[I_SG]) + ((size_t)l * DM + kb * 64) * EFF + n0, EFF, (bf16_t*)(ws + WS_WGU) + ((size_t)(l * 65 + 64) * 1024 + (n0 >> 7) * 256 + up * 128 + (n0 & 127)) * DM + kb * 64, DM, scr, F.lane); continue; } r -= 2 * JS;
        {   const int l = r / 512, q = r % 512, kb = q / 64, nb = q % 64;
            tr_item(F.in[I_SD] + ((size_t)l * EFF + kb * 64) * DM + nb * 32, DM, (bf16_t*)(ws + WS_WDN) + ((size_t)(l * 65 + 64) * 2048 + nb * 32) * EFF + kb * 64, EFF, scr, F.lane); }
    }
}

__device__ __forceinline__ void load_row_f32(const float* p, int lane, f32x4 (&v)[8]) {
#pragma unroll
    for (int j = 0; j < 8; ++j) v[j] = *(const f32x4*)(p + 4 * lane + 256 * j);
}
__device__ __forceinline__ void load_row_bf16(const bf16_t* p, int lane, f32x4 (&v)[8]) {
#pragma unroll
    for (int j = 0; j < 8; ++j) { const u32x2 w = *(const u32x2*)(p + 4 * lane + 256 * j); v[j] = (f32x4){bflo(w.x), bfhi(w.x), bflo(w.y), bfhi(w.y)}; }
}
__device__ __forceinline__ float row_rstd(const f32x4 (&v)[8]) {
    float s = 0.f;
#pragma unroll
    for (int j = 0; j < 8; ++j) s += (v[j].x * v[j].x + v[j].y * v[j].y) + (v[j].z * v[j].z + v[j].w * v[j].w);
    return rsqrtf(wave_sum(s) * (1.f / DM) + NORM_EPS);
}
__device__ __forceinline__ void store_row_bf16(bf16_t* p, int lane, const f32x4 (&v)[8]) {
#pragma unroll
    for (int j = 0; j < 8; ++j) { u32x2 w; w.x = cvt_pk_bf16(v[j].x, v[j].y); w.y = cvt_pk_bf16(v[j].z, v[j].w); *(u32x2*)(p + 4 * lane + 256 * j) = w; }
}
#define LV4(tab, idx) (*(const LAS f32x4*)((tab) + (idx)))
__device__ __forceinline__ void lds_load_vec(Frame& F, LAS float* dst, const float* src) { for (int i = F.tid; i < DM / 4; i += 512) *(LAS f32x4*)(dst + 4 * i) = *(const f32x4*)(src + 4 * i); }

__device__ __forceinline__ void p1_norm0(Frame& F) {
    unsigned char* ws = F.ws;
    const float* modp = (const float*)(ws + WS_MODP); float* modf = (float*)(ws + WS_MODF);
    LAS float* T = (LAS float*)(F.lds + LDS_SCR);
    for (int i = F.tid; i < 6 * DM; i += 512) { const int t = i / DM, k = i % DM, ch = t / 3, v = t % 3; const int idx = ch * DM + k;
        float s = F.in[I_MODB][idx];
#pragma unroll
        for (int ks = 0; ks < 8; ++ks) s += modp[((size_t)(0 * 8 + ks) * 3 + v) * 12288 + idx];
        T[i] = s; }
    for (int i = F.tid; i < DM; i += 512) T[6 * DM + i] = F.in[I_NMPRE][i];
    if (F.bid < 36) { const int base = F.bid * 2048;
        for (int i = F.tid; i < 2048; i += 512) { const int g = base + i, l = g / 36864, rem = g % 36864, v = rem / 12288, idx = rem % 12288;
            float s = F.in[I_MODB][l * 12288 + idx];
#pragma unroll
            for (int ks = 0; ks < 8; ++ks) s += modp[((size_t)(l * 8 + ks) * 3 + v) * 12288 + idx];
            modf[g] = s; } }
    __syncthreads();
    bf16_t* HN = (bf16_t*)(ws + WS_HN);
    for (int r = F.gw; r < MROWS; r += F.NGW) {
        f32x4 v[8]; load_row_f32(src_row(F, r), F.lane, v); const float rs = row_rstd(v); const int var = row_variant(r);
#pragma unroll
        for (int j = 0; j < 8; ++j) { const int c = 4 * F.lane + 256 * j; const f32x4 g = LV4(T + 6 * DM, c), sh = LV4(T + var * DM, c), sc = LV4(T + (3 + var) * DM, c);
            v[j] = v[j] * rs * g * (sc + 1.f) + sh; }
        store_row_bf16(HN + (size_t)r * DM, F.lane, v);
    }
}

struct PolPlain {
    static constexpr bool PERM = true;
    const bf16_t* A; const bf16_t* Bt; bf16_t* C; unsigned lda, ldb; size_t ldc; int nt, nM, nN, G, c; bool lat;
    __device__ __forceinline__ bool next(int i, pg8::Unit& u) const { int pm, pn; if (!pg8::static_order(nM, nN, G, c, i, pm, pn)) return false; u.pm = lat ? pm + 1 + (pm >= 32) : pm; u.pn = pn; u.ex = 0; u.rows = 256; return true; }
    __device__ __forceinline__ const char* a_base(const pg8::Unit& u) const { return (const char*)A + (size_t)u.pm * 256 * lda; }
    __device__ __forceinline__ void a_off(const pg8::Unit&, int R0, int R1, int C0, int C1, unsigned (&o)[2][2]) const {
        o[0][0] = (unsigned)R0 * lda + C0 * 2; o[0][1] = (unsigned)R1 * lda + C1 * 2; o[1][0] = (unsigned)(R0 + 128) * lda + C0 * 2; o[1][1] = (unsigned)(R1 + 128) * lda + C1 * 2; }
    __device__ __forceinline__ const char* b_base(const pg8::Unit& u) const { return (const char*)Bt + (size_t)u.pn * 256 * ldb; }
    __device__ __forceinline__ void epi(const f32x4 (&acc)[2][2][4][2], const pg8::Unit& u, int wr, int wc, int fr, int fq) const {
        pg8::store_tile_bf16(acc, C + (size_t)u.pm * 256 * ldc + (size_t)u.pn * 256, ldc, wr, wc, fr, fq, 256); }
};
struct PolUqUkv {
    static constexpr bool PERM = true;
    const bf16_t *CKVN, *CQN, *Wukv, *Wuq; bf16_t *KV, *QB; unsigned ldb; int nt, G, c;
    __device__ __forceinline__ bool next(int i, pg8::Unit& u) const { const long L = (long)i * G + c; if (L >= 528 + 384) return false;
        if (L < 528) { u.ex = 0; u.pm = (int)L / 8; u.pn = (int)L % 8; } else { const int q = (int)L - 528; u.ex = 1; const int pm = q / 6; u.pm = pm + 1 + (pm >= 32); u.pn = q % 6; } u.rows = 256; return true; }
    __device__ __forceinline__ const char* a_base(const pg8::Unit& u) const { return (const char*)(u.ex ? CQN : CKVN) + (size_t)u.pm * 256 * 1024; }
    __device__ __forceinline__ void a_off(const pg8::Unit&, int R0, int R1, int C0, int C1, unsigned (&o)[2][2]) const {
        o[0][0] = (unsigned)R0 * 1024u + C0 * 2; o[0][1] = (unsigned)R1 * 1024u + C1 * 2; o[1][0] = (unsigned)(R0 + 128) * 1024u + C0 * 2; o[1][1] = (unsigned)(R1 + 128) * 1024u + C1 * 2; }
    __device__ __forceinline__ const char* b_base(const pg8::Unit& u) const { return (const char*)(u.ex ? Wuq : Wukv) + (size_t)u.pn * 256 * 1024; }
    __device__ __forceinline__ void epi(const f32x4 (&acc)[2][2][4][2], const pg8::Unit& u, int wr, int wc, int fr, int fq) const {
        if (u.ex) pg8::store_tile_bf16(acc, QB + (size_t)u.pm * 256 * 1536 + (size_t)u.pn * 256, 1536, wr, wc, fr, fq, 256);
        else pg8::store_tile_bf16(acc, KV + (size_t)u.pm * 256 * 2048 + (size_t)u.pn * 256, 2048, wr, wc, fr, fq, 256); }
};
struct PolRouter {
    static constexpr bool PERM = false;
    const bf16_t* A; const bf16_t* Bt; float* C; unsigned ldb; int nt, nM, G, c; bool lat;
    __device__ __forceinline__ bool next(int i, pg8::Unit& u) const { int pm, pn; if (!pg8::static_order(nM, 4, G, c, i, pm, pn)) return false; u.pm = lat ? pm + 1 + (pm >= 32) : pm; u.pn = 0; u.ex = pn; u.rows = 256; return true; }
    __device__ __forceinline__ const char* a_base(const pg8::Unit& u) const { return (const char*)A + (size_t)u.pm * 256 * 8192 + (size_t)u.ex * 2048; }
    __device__ __forceinline__ void a_off(const pg8::Unit&, int R0, int R1, int C0, int C1, unsigned (&o)[2][2]) const {
        o[0][0] = (unsigned)R0 * 8192u + C0 * 2; o[0][1] = (unsigned)R1 * 8192u + C1 * 2; o[1][0] = (unsigned)(R0 + 128) * 8192u + C0 * 2; o[1][1] = (unsigned)(R1 + 128) * 8192u + C1 * 2; }
    __device__ __forceinline__ const char* b_base(const pg8::Unit& u) const { return (const char*)Bt + (size_t)u.ex * 2048; }
    __device__ __forceinline__ void epi(const f32x4 (&acc)[2][2][4][2], const pg8::Unit& u, int wr, int wc, int fr, int fq) const {
        float* base = C + ((size_t)u.ex * MROWS + (size_t)u.pm * 256) * 256;
#pragma unroll
        for (int ai = 0; ai < 2; ++ai)
#pragma unroll
            for (int m = 0; m < 4; ++m) { float* rowp = base + (size_t)(ai * 128 + wr * 64 + m * 16 + fr) * 256 + wc * 32 + 4 * fq;
#pragma unroll
                for (int n = 0; n < 2; ++n) *(f32x4*)(rowp + n * 16) = acc[ai][0][m][n]; }
    }
};
template <int NT_N>
__device__ __forceinline__ bool grouped_next(const LAS int* tab, int G, int c, int i, pg8::Unit& u) {
    const long L = (long)i * G + c; const int total = tab[65] * NT_N; if (L >= total) return false;
    const int tile = (int)L / NT_N; u.pn = (int)L % NT_N;
    int lo = 0, hi = 65;
    while (hi - lo > 1) { const int mid = (lo + hi) >> 1; if (tab[mid] <= tile) lo = mid; else hi = mid; }
    u.ex = lo; u.pm = tile - tab[lo]; const int rem = tab[128 + lo] - u.pm * 256; u.rows = rem < 256 ? rem : 256; return true;
}
__device__ __forceinline__ int slot_token(int slot) { return slot < NSLOT ? slot / TOPK : slot - NSLOT; }
struct PolGU {
    static constexpr bool PERM = true;
    const bf16_t* FN2; const bf16_t* W; bf16_t* H; const int* list; const LAS int* tab; unsigned ldb; int nt, G, c;
    __device__ __forceinline__ bool next(int i, pg8::Unit& u) const { return grouped_next<4>(tab, G, c, i, u); }
    __device__ __forceinline__ const char* a_base(const pg8::Unit&) const { return (const char*)FN2; }
    __device__ __forceinline__ void a_off(const pg8::Unit& u, int R0, int R1, int C0, int C1, unsigned (&o)[2][2]) const {
        const int* lp = list + (size_t)u.ex * MROWS + u.pm * 256; const int last = u.rows - 1;
        const int r00 = R0 < last ? R0 : last, r01 = R1 < last ? R1 : last, r10 = R0 + 128 < last ? R0 + 128 : last, r11 = R1 + 128 < last ? R1 + 128 : last;
        const int s00 = lp[r00], s01 = lp[r01], s10 = lp[r10], s11 = lp[r11];
        o[0][0] = (unsigned)slot_token(s00) * 8192u + C0 * 2; o[0][1] = (unsigned)slot_token(s01) * 8192u + C1 * 2; o[1][0] = (unsigned)slot_token(s10) * 8192u + C0 * 2; o[1][1] = (unsigned)slot_token(s11) * 8192u + C1 * 2; }
    __device__ __forceinline__ const char* b_base(const pg8::Unit& u) const { return (const char*)W + ((size_t)u.ex * 1024 + (size_t)u.pn * 256) * 4096; }
    __device__ __forceinline__ void epi(const f32x4 (&acc)[2][2][4][2], const pg8::Unit& u, int wr, int wc, int fr, int fq) const {
        const int* lp = list + (size_t)u.ex * MROWS + u.pm * 256;
#pragma unroll
        for (int ai = 0; ai < 2; ++ai)
#pragma unroll
            for (int m = 0; m < 4; ++m) { const int r = ai * 128 + wr * 64 + m * 16 + fr; if (r < u.rows) { const int slot = lp[r];
                const f32x4 g0 = acc[ai][0][m][0], g1 = acc[ai][0][m][1], u0 = acc[ai][1][m][0], u1 = acc[ai][1][m][1]; float h[8];
#pragma unroll
                for (int j = 0; j < 4; ++j) { h[j] = g0[j] / (1.f + __expf(-g0[j])) * u0[j]; h[4 + j] = g1[j] / (1.f + __expf(-g1[j])) * u1[j]; }
                u32x4 w; w.x = cvt_pk_bf16(h[0], h[1]); w.y = cvt_pk_bf16(h[2], h[3]); w.z = cvt_pk_bf16(h[4], h[5]); w.w = cvt_pk_bf16(h[6], h[7]);
                *(u32x4*)(H + (size_t)slot * EFF + u.pn * 128 + wc * 32 + 8 * fq) = w; } }
    }
};
struct PolDN {
    static constexpr bool PERM = true;
    const bf16_t* H; const bf16_t* W; bf16_t* YS; const int* list; const LAS int* tab; unsigned ldb; int nt, G, c;
    __device__ __forceinline__ bool next(int i, pg8::Unit& u) const { return grouped_next<8>(tab, G, c, i, u); }
    __device__ __forceinline__ const char* a_base(const pg8::Unit&) const { return (const char*)H; }
    __device__ __forceinline__ void a_off(const pg8::Unit& u, int R0, int R1, int C0, int C1, unsigned (&o)[2][2]) const {
        const int* lp = list + (size_t)u.ex * MROWS + u.pm * 256; const int last = u.rows - 1;
        const int r00 = R0 < last ? R0 : last, r01 = R1 < last ? R1 : last, r10 = R0 + 128 < last ? R0 + 128 : last, r11 = R1 + 128 < last ? R1 + 128 : last;
        o[0][0] = (unsigned)lp[r00] * 1024u + C0 * 2; o[0][1] = (unsigned)lp[r01] * 1024u + C1 * 2; o[1][0] = (unsigned)lp[r10] * 1024u + C0 * 2; o[1][1] = (unsigned)lp[r11] * 1024u + C1 * 2; }
    __device__ __forceinline__ const char* b_base(const pg8::Unit& u) const { return (const char*)W + ((size_t)u.ex * 2048 + (size_t)u.pn * 256) * 1024; }
    __device__ __forceinline__ void epi(const f32x4 (&acc)[2][2][4][2], const pg8::Unit& u, int wr, int wc, int fr, int fq) const {
        const int* lp = list + (size_t)u.ex * MROWS + u.pm * 256;
#pragma unroll
        for (int ai = 0; ai < 2; ++ai)
#pragma unroll
            for (int m = 0; m < 4; ++m) { const int r = ai * 128 + wr * 64 + m * 16 + fr; if (r < u.rows) { const int slot = lp[r]; bf16_t* rowp = YS + (size_t)slot * DM + u.pn * 256 + wc * 32 + 8 * fq;
#pragma unroll
                for (int bj = 0; bj < 2; ++bj) { const f32x4 v0 = acc[ai][bj][m][0], v1 = acc[ai][bj][m][1];
                    u32x4 w; w.x = cvt_pk_bf16(v0[0], v0[1]); w.y = cvt_pk_bf16(v0[2], v0[3]); w.z = cvt_pk_bf16(v1[0], v1[1]); w.w = cvt_pk_bf16(v1[2], v1[3]);
                    *(u32x4*)(rowp + bj * 128) = w; } } }
    }
};
__device__ __forceinline__ void build_group_table(Frame& F, const unsigned* cnt) {
    LAS int* tab = (LAS int*)(F.lds + LDS_AUX);
    if (F.tid < 65) tab[128 + F.tid] = (int)cnt[F.tid];
    __syncthreads();
    if (F.tid == 0) { int acc = 0; for (int e = 0; e < 65; ++e) { tab[e] = acc; acc += (tab[128 + e] + 255) >> 8; } tab[65] = acc; }
    __syncthreads();
}

__device__ __forceinline__ f32x16 mma32(f32x16 acc, const LAS unsigned char* A, int pa, const LAS unsigned char* B, int pb, int ksteps, int r32, int hi) {
    const LAS unsigned char* ap = A + r32 * pa + hi * 16; const LAS unsigned char* bp = B + r32 * pb + hi * 16;
    for (int ks = 0; ks < ksteps; ++ks) { const bf16x8 a = *(const LAS bf16x8*)(ap + ks * 32), b = *(const LAS bf16x8*)(bp + ks * 32);
        acc = __builtin_amdgcn_mfma_f32_32x32x16_bf16(a, b, acc, 0, 0, 0); }
    return acc;
}
constexpr int ML_VT = 0, ML_QS = 34816, ML_KS = 53248, ML_PM = 71680, ML_QD = 106496, ML_HS = 53248;
constexpr int P64 = 144, P128 = 272;
constexpr int AX_IF = 0, AX_LF = 128, AX_IB = 256, AX_LB = 384, AX_WF = 512, AX_WB = 640, AX_AF = 768, AX_MF = 896, AX_WIF = 1024, AX_EMF = 1152, AX_AB = 1280, AX_MB = 1408, AX_WIB = 1536, AX_EMB = 1664,
              AX_DEN = 1792, AX_NST = 1920  , AX_SC = 2048  ;

__device__ __forceinline__ void ml_load_gates(Frame& F, const bf16_t* Prow0, int h, LAS float* ax) {
    const int t = F.tid & 127, ty = F.tid >> 7;
    const float v = bf2f(Prow0[(size_t)t * AB_INP + C_GT + ty * 8 + h]) + F.in[I_MGB][ty * 8 + h];
    ax[ty * 128 + t] = (ty & 1) ? logsigmoidf_(v) : v;
}
__device__ __forceinline__ void ml_load_vt(Frame& F, const bf16_t* Prow0, int h) {
    const int t = F.tid >> 2, vq = F.tid & 3; const bf16_t* src = Prow0 + (size_t)t * AB_INP + C_MV + h * 128 + vq * 32;
    LAS bf16_t* VT = (LAS bf16_t*)(F.lds + ML_VT);
#pragma unroll
    for (int i = 0; i < 4; ++i) { const bf16x8 x = *(const bf16x8*)(src + i * 8);
#pragma unroll
        for (int j = 0; j < 8; ++j) VT[(vq * 32 + i * 8 + j) * (P128 / 2) + t] = (bf16_t)x[j]; }
}
__device__ __forceinline__ void mlstm_a_item(Frame& F, int b, int h, int g) {
    unsigned char* ws = F.ws; const bf16_t* Prow0 = (const bf16_t*)(ws + WS_P) + (size_t)(b * TPB + g * 128) * AB_INP;
    LAS float* ax = (LAS float*)(F.lds + LDS_AUX);
    const int r32 = F.lane & 31, hi = F.lane >> 5;
    ml_load_gates(F, Prow0, h, ax);
    ml_load_vt(F, Prow0, h);
    __syncthreads();
    if (F.tid == 0) { float s = 0.f, mx = -1e30f; for (int t = 127; t >= 0; --t) { const float w = s + ax[AX_IF + t]; ax[AX_WF + t] = w; mx = fmaxf(mx, w); s += ax[AX_LF + t]; }
        ax[AX_SC + 0] = s; ax[AX_SC + 1] = mx; for (int t = 0; t < 128; ++t) ax[AX_WF + t] = __expf(ax[AX_WF + t] - mx); }
    if (F.tid == 64) { float s = 0.f, mx = -1e30f; for (int t = 0; t < 128; ++t) { const float w = s + ax[AX_IB + t]; ax[AX_WB + t] = w; mx = fmaxf(mx, w); s += ax[AX_LB + t]; }
        ax[AX_SC + 2] = s; ax[AX_SC + 3] = mx; for (int t = 0; t < 128; ++t) ax[AX_WB + t] = __expf(ax[AX_WB + t] - mx); }
    __syncthreads();
    {
        const int t = F.tid >> 2, dq = F.tid & 3; const bf16_t* src = Prow0 + (size_t)t * AB_INP + C_MK + h * 64 + dq * 16;
        LAS bf16_t* KTf = (LAS bf16_t*)(F.lds + ML_QS); LAS bf16_t* KTb = (LAS bf16_t*)(F.lds + ML_KS);
        const float wf = ax[AX_WF + t] * 0.125f, wb = ax[AX_WB + t] * 0.125f;
#pragma unroll
        for (int i = 0; i < 2; ++i) { const bf16x8 x = *(const bf16x8*)(src + i * 8);
#pragma unroll
            for (int j = 0; j < 8; ++j) { const float k = bf2f((unsigned short)x[j]); const int d = dq * 16 + i * 8 + j;
                KTf[d * (P128 / 2) + t] = (bf16_t)f2bf(k * wf); KTb[d * (P128 / 2) + t] = (bf16_t)f2bf(k * wb); } }
    }
    __syncthreads();
    const int vb = F.wave >> 1, db = F.wave & 1;
    f32x16 cf = {}, cb = {};
    cf = mma32(cf, F.lds + ML_VT + vb * 32 * P128, P128, F.lds + ML_QS + db * 32 * P128, P128, 8, r32, hi);
    cb = mma32(cb, F.lds + ML_VT + vb * 32 * P128, P128, F.lds + ML_KS + db * 32 * P128, P128, 8, r32, hi);
    const int chf = (b * 8 + h) * 2, chb = chf + 1;
    float* dCf = (float*)(ws + WS_MDC) + ((size_t)chf * 66 + g) * 8192; float* dCb = (float*)(ws + WS_MDC) + ((size_t)chb * 66 + g) * 8192;
#pragma unroll
    for (int r = 0; r < 16; ++r) { const int v = vb * 32 + att::crow(r, hi), d = db * 32 + r32; dCf[v * 64 + d] = cf[r]; dCb[v * 64 + d] = cb[r]; }
    if (F.tid < 128) { const int dir = F.tid >> 6, d = F.tid & 63; const LAS bf16_t* kt = (const LAS bf16_t*)(F.lds + (dir ? ML_KS : ML_QS)) + d * (P128 / 2);
        float s = 0.f; for (int t = 0; t < 128; ++t) s += bf2f(kt[t]);
        ((float*)(ws + WS_MSM + MSM_DN))[((size_t)(chf + dir) * 66 + g) * 64 + d] = s; }
    if (F.tid < 2) { ((float*)(ws + WS_MSM + MSM_BTOT))[(chf + F.tid) * 66 + g] = ax[AX_SC + 2 * F.tid]; ((float*)(ws + WS_MSM + MSM_MLOC))[(chf + F.tid) * 66 + g] = ax[AX_SC + 2 * F.tid + 1]; }
    __syncthreads();
}
__device__ __forceinline__ int chain_chunk(int dir, int j) { return dir == 0 ? j : (j == 0 ? 1 : (j == 1 ? 0 : 67 - j)); }
__device__ __forceinline__ void mlstm_scan_item(Frame& F, int chain, int slice) {
    unsigned char* ws = F.ws; const int dir = chain & 1;
    const float* dC = (const float*)(ws + WS_MDC) + (size_t)chain * 66 * 8192 + slice * 1024 + F.tid * 2;
    bf16_t* cst = (bf16_t*)(ws + WS_MCST) + (size_t)chain * 66 * 8192 + slice * 1024 + F.tid * 2;
    const float* btot = (const float*)(ws + WS_MSM + MSM_BTOT) + chain * 66; const float* mloc = (const float*)(ws + WS_MSM + MSM_MLOC) + chain * 66;
    const float* dn = (const float*)(ws + WS_MSM + MSM_DN) + (size_t)chain * 66 * 64; float* nst = (float*)(ws + WS_MSM + MSM_NST) + (size_t)chain * 66 * 64; float* mst = (float*)(ws + WS_MSM + MSM_MST) + chain * 66;
    float c0 = 0.f, c1 = 0.f, n = 0.f, m = 0.f; const bool don = (slice == 0 && F.tid < 64);
#pragma unroll 6
    for (int j = 0; j < 66; ++j) { const int g = chain_chunk(dir, j);
        const f32x2 d = *(const f32x2*)(dC + (size_t)g * 8192); const float bt = btot[g], ml = mloc[g];
        *(unsigned*)(cst + (size_t)g * 8192) = cvt_pk_bf16(c0, c1);
        if (don) { nst[g * 64 + F.tid] = n; if (F.tid == 0) mst[g] = m; }
        const float mn = fmaxf(bt + m, ml), dec = __expf(bt + m - mn), sc = __expf(ml - mn);
        c0 = dec * c0 + sc * d.x; c1 = dec * c1 + sc * d.y;
        if (don) n = dec * n + sc * dn[g * 64 + F.tid];
        m = mn; }
}
__device__ __forceinline__ void mlstm_c_item(Frame& F, int b, int h, int g) {
    unsigned char* ws = F.ws; const int row0 = b * TPB + g * 128; const bf16_t* Prow0 = (const bf16_t*)(ws + WS_P) + (size_t)row0 * AB_INP;
    LAS float* ax = (LAS float*)(F.lds + LDS_AUX);
    const int r32 = F.lane & 31, hi = F.lane >> 5; const int chf = (b * 8 + h) * 2;
    ml_load_gates(F, Prow0, h, ax);
    ml_load_vt(F, Prow0, h);
    {
        const int t = F.tid >> 2, dq = F.tid & 3;
        const bf16_t* qs = Prow0 + (size_t)t * AB_INP + C_MQ + h * 64 + dq * 16; const bf16_t* ks = Prow0 + (size_t)t * AB_INP + C_MK + h * 64 + dq * 16;
#pragma unroll
        for (int i = 0; i < 2; ++i) { *(LAS bf16x8*)(F.lds + ML_QS + t * P64 + (dq * 16 + i * 8) * 2) = *(const bf16x8*)(qs + i * 8);
            const bf16x8 x = *(const bf16x8*)(ks + i * 8); u32x4 o;
#pragma unroll
            for (int j = 0; j < 4; ++j) o[j] = cvt_pk_bf16(bf2f((unsigned short)x[2 * j]) * 0.125f, bf2f((unsigned short)x[2 * j + 1]) * 0.125f);
            *(LAS u32x4*)(F.lds + ML_KS + t * P64 + (dq * 16 + i * 8) * 2) = o; }
    }
    if (F.tid < 128) ax[AX_NST + F.tid] = ((const float*)(ws + WS_MSM + MSM_NST))[((size_t)(chf + (F.tid >> 6)) * 66 + g) * 64 + (F.tid & 63)];
    __syncthreads();
    if (F.tid == 0) { const float mst = ((const float*)(ws + WS_MSM + MSM_MST))[chf * 66 + g]; float c = 0.f, amax = -1e30f;
        for (int t = 0; t < 128; ++t) { c += ax[AX_LF + t]; const float a = ax[AX_IF + t] - c; amax = fmaxf(amax, a); const float M = fmaxf(mst, amax);
            ax[AX_AF + t] = a; ax[AX_MF + t] = M; ax[AX_WIF + t] = __expf(mst - M); ax[AX_EMF + t] = __expf(-(c + M)); } }
    if (F.tid == 64) { const float mst = ((const float*)(ws + WS_MSM + MSM_MST))[(chf + 1) * 66 + g]; float c = 0.f, amax = -1e30f;
        for (int t = 127; t >= 0; --t) { c += ax[AX_LB + t]; const float a = ax[AX_IB + t] - c; amax = fmaxf(amax, a); const float M = fmaxf(mst, amax);
            ax[AX_AB + t] = a; ax[AX_MB + t] = M; ax[AX_WIB + t] = __expf(mst - M); ax[AX_EMB + t] = __expf(-(c + M)); } }
    const int qb = F.wave >> 1, sb0 = (F.wave & 1) * 2;
    f32x16 S0 = {}, S1 = {};
    S0 = mma32(S0, F.lds + ML_KS + (sb0 * 32) * P64, P64, F.lds + ML_QS + qb * 32 * P64, P64, 4, r32, hi);
    S1 = mma32(S1, F.lds + ML_KS + (sb0 * 32 + 32) * P64, P64, F.lds + ML_QS + qb * 32 * P64, P64, 4, r32, hi);
    __syncthreads();
    f32x16 H0 = {}, H1 = {};
    const int qb2 = F.wave >> 1, vb0 = (F.wave & 1) * 2;
#pragma unroll 1
    for (int dir = 0; dir < 2; ++dir) {
        const LAS float* A_ = ax + (dir ? AX_AB : AX_AF); const LAS float* M_ = ax + (dir ? AX_MB : AX_MF); const LAS float* WI_ = ax + (dir ? AX_WIB : AX_WIF); const LAS float* EM_ = ax + (dir ? AX_EMB : AX_EMF);
        {
            const int q = qb * 32 + r32; const float Mq = M_[q];
#pragma unroll
            for (int i = 0; i < 2; ++i) { const f32x16& S = i ? S1 : S0; const int sbase = (sb0 + i) * 32;
#pragma unroll
                for (int gq = 0; gq < 4; ++gq) { float p[4];
#pragma unroll
                    for (int j = 0; j < 4; ++j) { const int s = sbase + 8 * gq + 4 * hi + j; const bool keep = dir ? (s >= q) : (s <= q); p[j] = keep ? S[gq * 4 + j] * __expf(A_[s] - Mq) : 0.f; }
                    u32x2 w; w.x = cvt_pk_bf16(p[0], p[1]); w.y = cvt_pk_bf16(p[2], p[3]);
                    *(LAS u32x2*)(F.lds + ML_PM + q * P128 + (sbase + 8 * gq + 4 * hi) * 2) = w; } }
        }
        {
            const int t = F.tid >> 2, dq = F.tid & 3; const float wi = WI_[t];
            const bf16_t* cs = (const bf16_t*)(ws + WS_MCST) + ((size_t)(chf + dir) * 66 + g) * 8192 + t * 64 + dq * 16;
#pragma unroll
            for (int i = 0; i < 2; ++i) { const bf16x8 x = *(const LAS bf16x8*)(F.lds + ML_QS + t * P64 + (dq * 16 + i * 8) * 2); u32x4 o;
#pragma unroll
                for (int j = 0; j < 4; ++j) o[j] = cvt_pk_bf16(bf2f((unsigned short)x[2 * j]) * wi, bf2f((unsigned short)x[2 * j + 1]) * wi);
                *(LAS u32x4*)(F.lds + ML_QD + t * P64 + (dq * 16 + i * 8) * 2) = o;
                *(LAS bf16x8*)(F.lds + ML_KS + t * P64 + (dq * 16 + i * 8) * 2) = *(const bf16x8*)(cs + i * 8); }
        }
        __syncthreads();
        {
            const int q = F.tid >> 2, part = F.tid & 3; float s = 0.f;
            const LAS bf16_t* pr = (const LAS bf16_t*)(F.lds + ML_PM + q * P128) + part * 32;
#pragma unroll
            for (int j = 0; j < 32; ++j) s += bf2f(pr[j]);
            const LAS bf16_t* qd = (const LAS bf16_t*)(F.lds + ML_QD + q * P64) + part * 16; const LAS float* nn = ax + AX_NST + dir * 64 + part * 16;
#pragma unroll
            for (int j = 0; j < 16; ++j) s += bf2f(qd[j]) * nn[j];
            s += __shfl_xor(s, 1); s += __shfl_xor(s, 2);
            if (part == 0) ax[AX_DEN + q] = fmaxf(fabsf(s), EM_[q]);
        }
        f32x16 N0 = {}, N1 = {};
        N0 = mma32(N0, F.lds + ML_PM + qb2 * 32 * P128, P128, F.lds + ML_VT + (vb0 * 32) * P128, P128, 8, r32, hi);
        N0 = mma32(N0, F.lds + ML_QD + qb2 * 32 * P64, P64, F.lds + ML_KS + (vb0 * 32) * P64, P64, 4, r32, hi);
        N1 = mma32(N1, F.lds + ML_PM + qb2 * 32 * P128, P128, F.lds + ML_VT + (vb0 * 32 + 32) * P128, P128, 8, r32, hi);
        N1 = mma32(N1, F.lds + ML_QD + qb2 * 32 * P64, P64, F.lds + ML_KS + (vb0 * 32 + 32) * P64, P64, 4, r32, hi);
        __syncthreads();
#pragma unroll
        for (int r = 0; r < 16; ++r) { const float inv = 1.f / ax[AX_DEN + qb2 * 32 + att::crow(r, hi)]; H0[r] += N0[r] * inv; H1[r] += N1[r] * inv; }
        __syncthreads();
    }
    {   LAS float* HS = (LAS float*)(F.lds + ML_HS);
#pragma unroll
        for (int r = 0; r < 16; ++r) { const int q = qb2 * 32 + att::crow(r, hi); HS[q * 128 + vb0 * 32 + r32] = H0[r]; HS[q * 128 + vb0 * 32 + 32 + r32] = H1[r]; } }
    __syncthreads();
    {   const LAS float* HS = (const LAS float*)(F.lds + ML_HS); bf16_t* CC = (bf16_t*)(ws + WS_CC);
        const float g0 = F.in[I_MNORM][2 * F.lane], g1 = F.in[I_MNORM][2 * F.lane + 1];
        for (int i = 0; i < 16; ++i) { const int q = F.wave * 16 + i; const float x0 = HS[q * 128 + 2 * F.lane], x1 = HS[q * 128 + 2 * F.lane + 1];
            const float rs = rsqrtf(wave_sum(x0 * x0 + x1 * x1) * (1.f / 128.f) + NORM_EPS);
            const unsigned mo = *(const unsigned*)(Prow0 + (size_t)q * AB_INP + C_MO + h * 128 + 2 * F.lane);
            *(unsigned*)(CC + (size_t)(row0 + q) * DM + 1024 + h * 128 + 2 * F.lane) = cvt_pk_bf16(x0 * rs * g0 * sigmoidf_(bflo(mo)), x1 * rs * g1 * sigmoidf_(bfhi(mo))); }
    }
    __syncthreads();
}
__device__ __forceinline__ void diff_combine_row(Frame& F, int r, float lam, float oml) {
    const bf16_t* AO = (const bf16_t*)(F.ws + WS_AO) + (size_t)r * DM; bf16_t* CC = (bf16_t*)(F.ws + WS_CC) + (size_t)r * DM;
    const int h = F.lane >> 3, v0 = (F.lane & 7) * 16; float a[16]; float ss = 0.f;
#pragma unroll
    for (int i = 0; i < 2; ++i) { const u32x4 x1 = *(const u32x4*)(AO + (2 * h) * 128 + v0 + i * 8), x2 = *(const u32x4*)(AO + (2 * h + 1) * 128 + v0 + i * 8);
#pragma unroll
        for (int j = 0; j < 4; ++j) { a[i * 8 + 2 * j] = bflo(x1[j]) - lam * bflo(x2[j]); a[i * 8 + 2 * j + 1] = bfhi(x1[j]) - lam * bfhi(x2[j]); } }
#pragma unroll
    for (int j = 0; j < 16; ++j) ss += a[j] * a[j];
    ss += __shfl_xor(ss, 1); ss += __shfl_xor(ss, 2); ss += __shfl_xor(ss, 4);
    const float rs = rsqrtf(ss * (1.f / 128.f) + NORM_EPS) * oml;
#pragma unroll
    for (int i = 0; i < 2; ++i) { u32x4 o;
#pragma unroll
        for (int j = 0; j < 4; ++j) o[j] = cvt_pk_bf16(a[i * 8 + 2 * j] * rs * F.in[I_DNORM][v0 + i * 8 + 2 * j], a[i * 8 + 2 * j + 1] * rs * F.in[I_DNORM][v0 + i * 8 + 2 * j + 1]);
        *(u32x4*)(CC + h * 128 + v0 + i * 8) = o; }
}

template <int Q> __device__ __forceinline__ u32x4 rope_w4(u32x4 w, const f32x2* __restrict__ tab, int prow, int pcol, int i0) {
    u32x4 o;
#pragma unroll
    for (int q = 0; q < 4; ++q) { const int i = i0 + q; const f32x2 cs = (i < Q) ? tab[prow * Q + i] : tab[pcol * Q + (i - Q)];
        const float x1 = bflo(w[q]), x2 = bfhi(w[q]); o[q] = cvt_pk_bf16(x1 * cs.x - x2 * cs.y, x1 * cs.y + x2 * cs.x); }
    return o;
}
__device__ __forceinline__ void rope_dk_row(Frame& F, int r) {
    const int b = row_batch(r), pos = r - b * TPB; if (pos < CTXL) return; const int tok = pos - CTXL, prow = tok >> 6, pcol = tok & 63;
    bf16_t* p = (bf16_t*)(F.ws + WS_P) + (size_t)r * AB_INP + C_DK; const f32x2* tab = (const f32x2*)(F.ws + WS_ROPE);
#pragma unroll
    for (int j = 0; j < 2; ++j) { const int e = (F.lane + 64 * j) * 8; u32x4 w = *(const u32x4*)(p + e); w = rope_w4<16>(w, tab, prow, pcol, (e & 63) >> 1); *(u32x4*)(p + e) = w; }
}
__device__ __forceinline__ void post1_row(Frame& F, int r) {
    unsigned char* ws = F.ws; const bf16_t* p = (const bf16_t*)(ws + WS_P) + (size_t)r * CD_IN;
    const int b = row_batch(r), pos = r - b * TPB; const bool lat = pos >= CTXL; const int tok = pos - CTXL, prow = tok >> 6, pcol = tok & 63;
    {   float x[8]; float ss = 0.f; const bool act = F.lane < 56;
        if (act) { const u32x4 w = *(const u32x4*)(p + C_CQ + F.lane * 8);
#pragma unroll
            for (int j = 0; j < 4; ++j) { x[2 * j] = bflo(w[j]); x[2 * j + 1] = bfhi(w[j]); ss += x[2 * j] * x[2 * j] + x[2 * j + 1] * x[2 * j + 1]; } }
        const float rs = rsqrtf(wave_sum(ss) * (1.f / 448.f) + NORM_EPS); u32x4 o = {0, 0, 0, 0};
        if (act) {
#pragma unroll
            for (int j = 0; j < 4; ++j) o[j] = cvt_pk_bf16(x[2 * j] * rs * F.in[I_QNORM][F.lane * 8 + 2 * j], x[2 * j + 1] * rs * F.in[I_QNORM][F.lane * 8 + 2 * j + 1]); }
        *(u32x4*)((bf16_t*)(ws + WS_CQN) + (size_t)r * 512 + F.lane * 8) = o;
    }
    {   float x[8]; float ss = 0.f; const u32x4 w = *(const u32x4*)(p + C_CKV + F.lane * 8);
#pragma unroll
        for (int j = 0; j < 4; ++j) { x[2 * j] = bflo(w[j]); x[2 * j + 1] = bfhi(w[j]); ss += x[2 * j] * x[2 * j] + x[2 * j + 1] * x[2 * j + 1]; }
        const float rs = rsqrtf(wave_sum(ss) * (1.f / 512.f) + NORM_EPS); u32x4 o;
#pragma unroll
        for (int j = 0; j < 4; ++j) o[j] = cvt_pk_bf16(x[2 * j] * rs * F.in[I_KVNORM][F.lane * 8 + 2 * j], x[2 * j + 1] * rs * F.in[I_KVNORM][F.lane * 8 + 2 * j + 1]);
        *(u32x4*)((bf16_t*)(ws + WS_CKVN) + (size_t)r * 512 + F.lane * 8) = o;
    }
    if (F.lane < 8) { u32x4 w = *(const u32x4*)(p + C_KR + F.lane * 8); if (lat) w = rope_w4<16>(w, (const f32x2*)(ws + WS_ROPE), prow, pcol, F.lane * 4);
        *(u32x4*)((bf16_t*)(ws + WS_KR) + (size_t)r * 64 + F.lane * 8) = w; }
    if (lat && F.lane >= 32) { const int l2 = F.lane - 32; bf16_t* sk = (bf16_t*)(ws + WS_P) + (size_t)r * CD_IN + C_SK + l2 * 8;
        u32x4 w = *(const u32x4*)sk; w = rope_w4<32>(w, (const f32x2*)(ws + WS_ROPE + 65536), prow, pcol, ((l2 * 8) & 127) >> 1); *(u32x4*)sk = w; }
}
constexpr int TB = DM;
__device__ __forceinline__ const float* modf_vec(const Frame& F, int l, int v, int ch) { return (const float*)(F.ws + WS_MODF) + ((size_t)l * 3 + v) * 12288 + ch * DM; }
__device__ __forceinline__ void row_phase(Frame& F, int l) {
    LAS float* T = (LAS float*)(F.lds + LDS_SCR);
    lds_load_vec(F, T + 0 * TB, F.in[I_NMPOST] + l * DM); lds_load_vec(F, T + 1 * TB, F.in[I_NFPRE] + l * DM);
    for (int v = 0; v < 3; ++v) { lds_load_vec(F, T + (2 + v) * TB, modf_vec(F, l, v, 2)); lds_load_vec(F, T + (5 + v) * TB, modf_vec(F, l, v, 3)); lds_load_vec(F, T + (8 + v) * TB, modf_vec(F, l, v, 4)); }
    __syncthreads();
    const bf16_t* Y2 = (const bf16_t*)(F.ws + WS_Y2); float* XR = (float*)(F.ws + WS_XR); bf16_t* FN2 = (bf16_t*)(F.ws + WS_FN2);
    for (int r = F.gw; r < MROWS; r += F.NGW) {
        const int var = row_variant(r); if (l == 1 && var == 2) continue;
        f32x4 y[8], x[8]; load_row_bf16(Y2 + (size_t)r * DM, F.lane, y); load_row_f32(l == 0 ? src_row(F, r) : XR + (size_t)r * DM, F.lane, x);
        const float rs = row_rstd(y);
#pragma unroll
        for (int j = 0; j < 8; ++j) { const int c = 4 * F.lane + 256 * j; x[j] = x[j] + LV4(T + (2 + var) * TB, c) * (y[j] * rs * LV4(T, c)); *(f32x4*)(XR + (size_t)r * DM + c) = x[j]; }
        const float rs2 = row_rstd(x);
#pragma unroll
        for (int j = 0; j < 8; ++j) { const int c = 4 * F.lane + 256 * j; const f32x4 f = x[j] * rs2 * LV4(T + TB, c) * (LV4(T + (8 + var) * TB, c) + 1.f) + LV4(T + (5 + var) * TB, c);
            u32x2 hw; hw.x = cvt_pk_bf16(f.x, f.y); hw.y = cvt_pk_bf16(f.z, f.w);
            u32x2 lw; lw.x = cvt_pk_bf16(f.x - bflo(hw.x), f.y - bfhi(hw.x)); lw.y = cvt_pk_bf16(f.z - bflo(hw.y), f.w - bfhi(hw.y));
            *(u32x2*)(FN2 + (size_t)r * 4096 + c) = hw; *(u32x2*)(FN2 + (size_t)r * 4096 + 2048 + c) = lw; }
    }
}
__device__ __forceinline__ void routing_phase(Frame& F, int l) {
    unsigned char* ws = F.ws; const float* LOG4 = (const float*)(ws + WS_LOG4); int* list = (int*)(ws + WS_LIST); float* GATE = (float*)(ws + WS_GATE);
    unsigned* cnt = (unsigned*)(ws + WS_CTL) + CW_CNT + l * 128;
    LAS int* L = (LAS int*)(F.lds + LDS_SCR);
    const int chunk = (MROWS + F.G - 1) / F.G; const int r0 = F.bid * chunk, r1 = (r0 + chunk < MROWS) ? r0 + chunk : MROWS;
    LAS int* sel_e = L + 128; LAS int* sel_r = L + 128 + chunk * 6;
    if (F.tid < 128) L[F.tid] = 0;
    __syncthreads();
    const float rb = F.in[I_RB][l * 64 + F.lane];
    for (int r = r0 + F.wave; r < r1; r += 8) {
        const int var = row_variant(r); const int tl = r - r0;
        if (l == 1 && var == 2) { if (F.lane < 6) sel_e[tl * 6 + F.lane] = -1; continue; }
        float lg = 0.f;
#pragma unroll
        for (int s = 0; s < 4; ++s) { const float* p = LOG4 + ((size_t)s * MROWS + r) * 256; lg += p[F.lane] + p[64 + F.lane]; }
        const float score = 1.f / (1.f + __expf(-lg)); const float choice = score + rb;
        float m1 = choice; m1 = fmaxf(m1, __shfl_xor(m1, 1)); m1 = fmaxf(m1, __shfl_xor(m1, 2)); m1 = fmaxf(m1, __shfl_xor(m1, 4));
        const unsigned long long bm = __ballot(choice == m1); const int grp = F.lane >> 3; const unsigned gb = (unsigned)(bm >> (grp * 8)) & 0xffu; const int first = __builtin_ctz(gb);
        float c2 = ((F.lane & 7) == first) ? -1e30f : choice; c2 = fmaxf(c2, __shfl_xor(c2, 1)); c2 = fmaxf(c2, __shfl_xor(c2, 2)); c2 = fmaxf(c2, __shfl_xor(c2, 4));
        const float gs = m1 + c2; int rank = 0;
#pragma unroll
        for (int j = 0; j < 8; ++j) { const float gj = __shfl(gs, j * 8); rank += (gj > gs || (gj == gs && j < grp)) ? 1 : 0; }
        float masked = rank < 4 ? choice : -1e30f;
        int myk = -1; float ssum = 0.f; float sk_[6]; int ek_[6];
#pragma unroll
        for (int k = 0; k < 6; ++k) { const float mx = wave_max(masked); const unsigned long long bb = __ballot(masked == mx); const int e = __builtin_ctzll(bb);
            if (F.lane == e) masked = -1e30f; const float sc = __shfl(score, e); sk_[k] = sc; ek_[k] = e; ssum += sc; }
        (void)myk;
        if (F.lane < 6) { float gsel = 0.f; int esel = 0;
#pragma unroll
            for (int k = 0; k < 6; ++k) if (F.lane == k) { gsel = sk_[k]; esel = ek_[k]; }
            GATE[(size_t)r * 6 + F.lane] = gsel / ssum * 2.5f;
            const int rk = atomicAdd((int*)&L[esel], 1); sel_e[tl * 6 + F.lane] = esel; sel_r[tl * 6 + F.lane] = rk; }
    }
    __syncthreads();
    if (F.tid < 64) L[64 + F.tid] = (int)atomicAdd(&cnt[F.tid], (unsigned)L[F.tid]);
    if (F.bid == 0 && F.tid == 64) cnt[64] = (l == 0) ? MROWS : NB * SEQ;
    __syncthreads();
    for (int i = F.tid; i < (r1 - r0) * 6; i += 512) { const int e = sel_e[i]; if (e >= 0) list[(size_t)e * MROWS + L[64 + e] + sel_r[i]] = (r0 + i / 6) * 6 + (i % 6); }
    for (int r = r0 + F.tid; r < r1; r += 512) { const int b = row_batch(r), pos = r - b * TPB;
        if (l == 0) list[(size_t)64 * MROWS + r] = NSLOT + r; else if (pos >= CTXL) list[(size_t)64 * MROWS + b * SEQ + (pos - CTXL)] = NSLOT + r; }
}
__device__ __forceinline__ void combine_phase(Frame& F, int l) {
    LAS float* T = (LAS float*)(F.lds + LDS_SCR);
    lds_load_vec(F, T, F.in[I_NFPOST] + l * DM);
    for (int v = 0; v < 3; ++v) lds_load_vec(F, T + (1 + v) * TB, modf_vec(F, l, v, 5));
    if (l == 0) { lds_load_vec(F, T + 4 * TB, F.in[I_NMPRE] + DM); for (int v = 0; v < 3; ++v) { lds_load_vec(F, T + (5 + v) * TB, modf_vec(F, 1, v, 0)); lds_load_vec(F, T + (8 + v) * TB, modf_vec(F, 1, v, 1)); } }
    __syncthreads();
    const bf16_t* YS = (const bf16_t*)(F.ws + WS_YS); const float* GATE = (const float*)(F.ws + WS_GATE); float* XR = (float*)(F.ws + WS_XR); bf16_t* HN = (bf16_t*)(F.ws + WS_HN);
    for (int r = F.gw; r < MROWS; r += F.NGW) {
        const int var = row_variant(r); if (l == 1 && var == 2) continue;
        f32x4 f[8], t[8]; load_row_bf16(YS + (size_t)(NSLOT + r) * DM, F.lane, f);
#pragma unroll 1
        for (int k = 0; k < 6; ++k) { const float gk = GATE[(size_t)r * 6 + k]; load_row_bf16(YS + ((size_t)r * 6 + k) * DM, F.lane, t);
#pragma unroll
            for (int j = 0; j < 8; ++j) f[j] += t[j] * gk; }
        const float rs = row_rstd(f); load_row_f32(XR + (size_t)r * DM, F.lane, t);
#pragma unroll
        for (int j = 0; j < 8; ++j) { const int c = 4 * F.lane + 256 * j; t[j] = t[j] + LV4(T + (1 + var) * TB, c) * (f[j] * rs * LV4(T, c)); }
        if (l == 0) {
#pragma unroll
            for (int j = 0; j < 8; ++j) *(f32x4*)(XR + (size_t)r * DM + 4 * F.lane + 256 * j) = t[j];
            const float rs2 = row_rstd(t);
#pragma unroll
            for (int j = 0; j < 8; ++j) { const int c = 4 * F.lane + 256 * j; t[j] = t[j] * rs2 * LV4(T + 4 * TB, c) * (LV4(T + (8 + var) * TB, c) + 1.f) + LV4(T + (5 + var) * TB, c); }
            store_row_bf16(HN + (size_t)r * DM, F.lane, t);
        } else {
            const int b = row_batch(r), pos = r - b * TPB; float* o = F.out + ((size_t)b * SEQ + (pos - CTXL)) * DM;
#pragma unroll
            for (int j = 0; j < 8; ++j) *(f32x4*)(o + 4 * F.lane + 256 * j) = t[j];
        }
    }
}

constexpr float LOG2E = 1.4426950408889634f;
__device__ __forceinline__ void diff_attn_units(Frame& F) {
    const bf16_t* P = (const bf16_t*)(F.ws + WS_P); bf16_t* AO = (bf16_t*)(F.ws + WS_AO); const f32x2* tab = (const f32x2*)(F.ws + WS_ROPE);
    for (long L = F.bid; L < 1024 + 32; L += F.G) {
        att::UnitDesc U{}; int hh, u; const bool ctxq = L >= 1024;
        if (!ctxq) { hh = (int)(L / 256) * 8 + (int)(L % 8); u = (int)(L % 256) / 8; } else { hh = (int)L - 1024; u = 0; }
        const int b = hh >> 4, vh = hh & 15; const size_t krow0 = (size_t)b * TPB, qrow0 = ctxq ? krow0 : krow0 + CTXL + 256 * u;
        U.Q = P + qrow0 * AB_INP + C_DQ + vh * 64; U.ldq = AB_INP; U.K = P + krow0 * AB_INP + C_DK + vh * 64; U.ldk = AB_INP; U.K2 = nullptr; U.ldk2 = 0;
        U.V = P + krow0 * AB_INP + C_DV + (vh >> 1) * 128; U.ldv = AB_INP; U.O = AO + qrow0 * DM + vh * 128; U.ldo = DM;
        U.NT = ctxq ? 4 : 132; U.C = 0.125f * LOG2E; U.rope = ctxq ? nullptr : tab; U.qtok0 = 256 * u; U.seg_tiles = 0; U.seg2_row0 = 0; U.ktok0 = 0; U.sink_l2 = 0.f;
        att::attn_unit<0>(U, F.ldsg + LDS_SCR);
    }
}
__device__ __forceinline__ void mla_units(Frame& F) {
    const bf16_t* QB = (const bf16_t*)(F.ws + WS_QB); const bf16_t* KV = (const bf16_t*)(F.ws + WS_KV); const bf16_t* KR = (const bf16_t*)(F.ws + WS_KR); bf16_t* CC = (bf16_t*)(F.ws + WS_CC);
    const f32x2* tab = (const f32x2*)(F.ws + WS_ROPE);
    for (long L = F.bid; L < 512; L += F.G) {
        att::UnitDesc U{}; const int hh = (int)(L / 256) * 8 + (int)(L % 8), u = (int)(L % 256) / 8; const int b = hh >> 3, h = hh & 7;
        const size_t krow0 = (size_t)b * TPB, qrow0 = krow0 + CTXL + 256 * u;
        U.Q = QB + qrow0 * 1536 + h * 192; U.ldq = 1536; U.K = KV + krow0 * 2048 + h * 256; U.ldk = 2048; U.K2 = KR + krow0 * 64; U.ldk2 = 64;
        U.V = KV + krow0 * 2048 + h * 256 + 128; U.ldv = 2048; U.O = CC + qrow0 * DM + h * 128; U.ldo = DM;
        U.NT = 132; U.C = 0.07216878364870322f * LOG2E; U.rope = tab; U.qtok0 = 256 * u; U.seg_tiles = 0; U.seg2_row0 = 0; U.ktok0 = 0; U.sink_l2 = 0.f;
        att::attn_unit<1>(U, F.ldsg + LDS_SCR);
    }
}
__device__ __forceinline__ void swa_units(Frame& F) {
    const bf16_t* P1 = (const bf16_t*)(F.ws + WS_P); bf16_t* CC = (bf16_t*)(F.ws + WS_CC); const f32x2* tab = (const f32x2*)(F.ws + WS_ROPE + 65536);
    for (long L = F.bid; L < 512; L += F.G) {
        att::UnitDesc U{}; const int hh = (int)(L / 256) * 8 + (int)(L % 8), u = (int)(L % 256) / 8; const int b = hh >> 3, h = hh & 7, g = h >> 2;
        const size_t krow0 = (size_t)b * TPB, qrow0 = krow0 + CTXL + 256 * u;
        const int tok0 = (256 * u - 128) > 0 ? (256 * u - 128) : 0, tok1 = (256 * u + 384) < SEQ ? (256 * u + 384) : SEQ;
        U.Q = P1 + qrow0 * CD_IN + C_SQ + h * 128; U.ldq = CD_IN; U.K = P1 + krow0 * CD_IN + C_SK + g * 128; U.ldk = CD_IN; U.K2 = nullptr; U.ldk2 = 0;
        U.V = P1 + krow0 * CD_IN + C_SV + g * 128; U.ldv = CD_IN; U.O = CC + qrow0 * DM + 1024 + h * 128; U.ldo = DM;
        U.NT = 4 + (tok1 - tok0) / 64; U.C = 0.08838834764831845f * LOG2E; U.rope = tab; U.qtok0 = 256 * u; U.seg_tiles = 4; U.seg2_row0 = CTXL + tok0; U.ktok0 = tok0; U.sink_l2 = F.in[I_SINK][h] * LOG2E;
        att::attn_unit<2>(U, F.ldsg + LDS_SCR);
    }
}

constexpr int N_PHASES = 24;
__global__ void __launch_bounds__(512, 2) mk_fwd(Args args) {
    extern __shared__ __attribute__((aligned(16))) unsigned char lds_raw[];
    Frame F;
    F.lds = (LAS unsigned char*)lds_raw; F.ldsg = (char*)lds_raw; F.ws = args.ws; F.in = (const float* const*)__builtin_amdgcn_kernarg_segment_ptr()  ; F.out = args.out;
    F.tid = threadIdx.x; F.lane = F.tid & 63; F.wave = __builtin_amdgcn_readfirstlane(F.tid >> 6); F.G = gridDim.x; F.bid = blockIdx.x; F.gw = F.bid * 8 + F.wave; F.NGW = F.G * 8;
    unsigned* ctl = (unsigned*)(F.ws + WS_CTL);
    for (int u = F.tid; u < (LDS_BYTES - LDS_CTL) / 4; u += 512) ((LAS unsigned*)(F.lds + LDS_CTL))[u] = 0u;
    __syncthreads();
    XcdBarrier bar; bar.bar = ctl + CW_BAR; bar.x = 0; bar.st = nullptr;
    const bool one = (args.ph_hi - args.ph_lo) > 1;
    if (one) bar = xcd_barrier_post(ctl + CW_BAR, (volatile LAS unsigned*)(F.lds + LDS_CTL));
    const int lo = args.ph_lo, hi = args.ph_hi;
#ifndef ONLY
#define ONLY -1
#endif
#define IN(k) ((ONLY < 0 || ONLY == (k)) && lo <= (k) && (k) < hi)
#define INM(j) ((ONLY < 0 || ONLY == 7 + (j)) && lo <= (pb + (j)) && (pb + (j)) < hi)
#define FREF() do { int t_ = threadIdx.x; asm volatile("" : "+v"(t_)); F.tid = t_; F.lane = t_ & 63; F.wave = __builtin_amdgcn_readfirstlane(t_ >> 6); F.gw = F.bid * 8 + F.wave; } while (0)
#define SEAM(k) do { if (lo <= (k) && (k) + 1 < hi) xcd_barrier(bar); } while (0)
    unsigned char* ws = F.ws;
    if (IN(0)) { asm volatile("; PHASE_MARK 0"); FREF(); p0_prologue(F); } SEAM(0);
    if (IN(1)) { asm volatile("; PHASE_MARK 1"); FREF(); p1_norm0(F); } SEAM(1);
#define MOE_LAYER(l, pb) do { \
        if (INM(0)) { asm volatile("; PHASE_MARK M0"); FREF(); row_phase(F, l); } SEAM(pb); \
        if (INM(1)) { asm volatile("; PHASE_MARK M1"); FREF(); PolRouter p{(const bf16_t*)(ws + WS_FN2), (const bf16_t*)(ws + WS_WRT) + (size_t)(l) * 256 * 4096, (float*)(ws + WS_LOG4), 8192, 16, (l) == 0 ? NTILE_M : 64, F.G, F.bid, (l) == 1}; \
            pg8::gemm_phase(F.lds + LDS_SCR, p); } SEAM(pb + 1); \
        if (INM(2)) { asm volatile("; PHASE_MARK M2"); FREF(); routing_phase(F, l); } SEAM(pb + 2); \
        if (INM(3)) { asm volatile("; PHASE_MARK M3"); FREF(); build_group_table(F, ctl + CW_CNT + (l) * 128); \
            PolGU p{(const bf16_t*)(ws + WS_FN2), (const bf16_t*)(ws + WS_WGU) + (size_t)(l) * 65 * 1024 * 2048, (bf16_t*)(ws + WS_H), (const int*)(ws + WS_LIST), (const LAS int*)(F.lds + LDS_AUX), 4096, 32, F.G, F.bid}; \
            pg8::gemm_phase(F.lds + LDS_SCR, p); } SEAM(pb + 3); \
        if (INM(4)) { asm volatile("; PHASE_MARK M4"); FREF(); build_group_table(F, ctl + CW_CNT + (l) * 128); \
            PolDN p{(const bf16_t*)(ws + WS_H), (const bf16_t*)(ws + WS_WDN) + (size_t)(l) * 65 * 2048 * 512, (bf16_t*)(ws + WS_YS), (const int*)(ws + WS_LIST), (const LAS int*)(F.lds + LDS_AUX), 1024, 8, F.G, F.bid}; \
            pg8::gemm_phase(F.lds + LDS_SCR, p); } SEAM(pb + 4); \
        if (INM(5)) { asm volatile("; PHASE_MARK M5"); FREF(); combine_phase(F, l); } } while (0)
    if (IN(2)) { asm volatile("; PHASE_MARK 2"); FREF(); PolPlain p{(const bf16_t*)(ws + WS_HN), (const bf16_t*)(ws + WS_WABIN), (bf16_t*)(ws + WS_P), DM * 2, DM * 2, AB_INP, DM / 64, NTILE_M, AB_INP / 256, F.G, F.bid, false};
        pg8::gemm_phase(F.lds + LDS_SCR, p); } SEAM(2);
    if (IN(3)) { asm volatile("; PHASE_MARK 3"); FREF(); for (int r = F.gw; r < MROWS; r += F.NGW) rope_dk_row(F, r);
        for (int it = F.bid; it < NB * 8 * 66; it += F.G) { const int g = it % 66, bh = it / 66; mlstm_a_item(F, bh >> 3, bh & 7, g); } } SEAM(3);
    if (IN(4)) { asm volatile("; PHASE_MARK 4"); FREF(); for (int it = F.bid; it < 32 * 8; it += F.G) mlstm_scan_item(F, it >> 3, it & 7);
        diff_attn_units(F); } SEAM(4);
    if (IN(5)) { asm volatile("; PHASE_MARK 5"); FREF(); const float* lv = F.in[I_DLAM]; float s01 = 0.f, s23 = 0.f; for (int i = 0; i < 64; ++i) { s01 += lv[i] * lv[64 + i]; s23 += lv[128 + i] * lv[192 + i]; }
        const float lam_init = 0.2f, lam = __expf(s01) - __expf(s23) + lam_init;
        for (int r = F.gw; r < MROWS; r += F.NGW) diff_combine_row(F, r, lam, 1.f - lam_init);
        for (int it = F.bid; it < NB * 8 * 66; it += F.G) { const int g = it % 66, bh = it / 66; mlstm_c_item(F, bh >> 3, bh & 7, g); } } SEAM(5);
    if (IN(6)) { asm volatile("; PHASE_MARK 6"); FREF(); PolPlain p{(const bf16_t*)(ws + WS_CC), (const bf16_t*)(ws + WS_WABOUT), (bf16_t*)(ws + WS_Y2), DM * 2, DM * 2, DM, DM / 64, NTILE_M, DM / 256, F.G, F.bid, false};
        pg8::gemm_phase(F.lds + LDS_SCR, p); } SEAM(6);
    { constexpr int pb = 7; MOE_LAYER(0, pb); } SEAM(12);
    if (IN(13)) { asm volatile("; PHASE_MARK 13"); FREF(); PolPlain p{(const bf16_t*)(ws + WS_HN), (const bf16_t*)(ws + WS_WCDIN), (bf16_t*)(ws + WS_P), DM * 2, DM * 2, CD_IN, DM / 64, NTILE_M, CD_IN / 256, F.G, F.bid, false};
        pg8::gemm_phase(F.lds + LDS_SCR, p); } SEAM(13);
    if (IN(14)) { asm volatile("; PHASE_MARK 14"); FREF(); for (int r = F.gw; r < MROWS; r += F.NGW) post1_row(F, r); } SEAM(14);
    if (IN(15)) { asm volatile("; PHASE_MARK 15"); FREF(); PolUqUkv p{(const bf16_t*)(ws + WS_CKVN), (const bf16_t*)(ws + WS_CQN), (const bf16_t*)(ws + WS_WUKV), (const bf16_t*)(ws + WS_WUQ), (bf16_t*)(ws + WS_KV), (bf16_t*)(ws + WS_QB), 1024, 8, F.G, F.bid};
        pg8::gemm_phase(F.lds + LDS_SCR, p); } SEAM(15);
    if (IN(16)) { asm volatile("; PHASE_MARK 16"); FREF();
#ifndef NO_MLA
        mla_units(F);
#endif
#ifndef NO_SWA
        swa_units(F);
#endif
    } SEAM(16);
    if (IN(17)) { asm volatile("; PHASE_MARK 17"); FREF(); PolPlain p{(const bf16_t*)(ws + WS_CC), (const bf16_t*)(ws + WS_WCDOUT), (bf16_t*)(ws + WS_Y2), DM * 2, DM * 2, DM, DM / 64, 64, DM / 256, F.G, F.bid, true};
        pg8::gemm_phase(F.lds + LDS_SCR, p); } SEAM(17);
    { constexpr int pb = 18; MOE_LAYER(1, pb); }
#undef IN
#undef INM
#undef SEAM
#undef MOE_LAYER
#undef FREF
}

extern "C" void kernel_launch(void* const* d_in, const int* in_sizes, int n_in, void* d_out, int out_size, void* d_ws, size_t ws_size, hipStream_t stream) {
    static int grid = 0;
    if (grid == 0) {
        if (n_in != 31 || ws_size < WS_END) { fprintf(stderr, "kernel_launch: unexpected n_in %d or ws_size %zu (< %zu)\n", n_in, ws_size, (size_t)WS_END); grid = -1; return; }
        int dev = 0, cus = 0, per_cu = 0;
        if (hipGetDevice(&dev) != hipSuccess || hipDeviceGetAttribute(&cus, hipDeviceAttributeMultiprocessorCount, dev) != hipSuccess) { grid = -1; return; }
        if (hipFuncSetAttribute((const void*)mk_fwd, hipFuncAttributeMaxDynamicSharedMemorySize, LDS_BYTES) != hipSuccess) { fprintf(stderr, "kernel_launch: hipFuncSetAttribute failed\n"); grid = -1; return; }
        if (hipOccupancyMaxActiveBlocksPerMultiprocessor(&per_cu, (const void*)mk_fwd, 512, LDS_BYTES) != hipSuccess || per_cu < 1) { fprintf(stderr, "kernel_launch: occupancy query says %d\n", per_cu); }
        (void)hipGetLastError();
        grid = cus;
    }
    if (grid < 0) return;
    (void)hipMemsetAsync((char*)d_ws + WS_CTL, 0, CTL_ZERO_BYTES, stream);
    Args a{};
    for (int i = 0; i < 31; ++i) a.in[i] = (const float*)d_in[i];
    a.out = (float*)d_out; a.ws = (unsigned char*)d_ws;
#if MK_N_LAUNCHES == 1
    a.ph_lo = 0; a.ph_hi = N_PHASES;
    hipLaunchKernelGGL(mk_fwd, dim3(grid), dim3(512), LDS_BYTES, stream, a);
#else
    for (int k = 0; k < N_PHASES; ++k) { a.ph_lo = k; a.ph_hi = k + 1; hipLaunchKernelGGL(mk_fwd, dim3(grid), dim3(512), LDS_BYTES, stream, a); }
#endif
    const hipError_t le = hipPeekAtLastError();
    if (le != hipSuccess) fprintf(stderr, "kernel_launch: launch failed: %s\n", hipGetErrorName(le));
}
```

```cpp
#include <hip/hip_runtime.h>
#include <stdint.h>
#include <stdio.h>

#define LAS __attribute__((address_space(3)))
#define GAS __attribute__((address_space(1)))
#ifndef MK_N_LAUNCHES
#define MK_N_LAUNCHES 1
#endif

typedef unsigned short bf16_t;
typedef short bf16x8 __attribute__((ext_vector_type(8)));
typedef short s16x4 __attribute__((ext_vector_type(4)));
typedef float f32x2 __attribute__((ext_vector_type(2)));
typedef float f32x4 __attribute__((ext_vector_type(4)));
typedef float f32x16 __attribute__((ext_vector_type(16)));
typedef unsigned u32x4 __attribute__((ext_vector_type(4)));
typedef unsigned u32x2 __attribute__((ext_vector_type(2)));

constexpr int DM = 2048, NB = 2, SEQ = 8192, CTXL = 256, TPB = CTXL + SEQ  , MROWS = NB * TPB  ;
constexpr int NTILE_M = MROWS / 256;
constexpr int AB_IN = 6176, AB_INP = 6400, CD_IN = 2560;
constexpr int NEXP = 64, TOPK = 6, EFF = 512;
constexpr int NSLOT = MROWS * TOPK;
constexpr int NSLOT_ALL = NSLOT + MROWS;
constexpr float NORM_EPS = 1e-6f;
constexpr int C_DQ = 0, C_DK = 1024, C_DV = 2048, C_MQ = 3072, C_MK = 3584, C_MV = 4096, C_MO = 5120, C_GT = 6144;
constexpr int C_CQ = 0, C_CKV = 448, C_KR = 960, C_SQ = 1024, C_SK = 2048, C_SV = 2304;

constexpr size_t MiB = 1u << 20;
constexpr size_t WS_CTL = 0, CTL_ZERO_BYTES = 1 * MiB;
constexpr size_t WS_MODP = 1 * MiB;
constexpr size_t WS_MODF = 4 * MiB;
constexpr size_t WS_ROPE = 5 * MiB;
constexpr size_t WS_WABIN = 6 * MiB, WS_WABOUT = 31 * MiB, WS_WCDIN = 39 * MiB, WS_WCDOUT = 49 * MiB, WS_WUQ = 57 * MiB, WS_WUKV = 59 * MiB, WS_WRT = 61 * MiB;
constexpr size_t WS_WGU = 65 * MiB;
constexpr size_t WS_WDN = 585 * MiB;
constexpr size_t WS_XR = 845 * MiB;
constexpr size_t WS_HN = 977 * MiB;
constexpr size_t WS_Y2 = 1043 * MiB;
constexpr size_t WS_REG = 1109 * MiB;
constexpr size_t WS_P = WS_REG;
constexpr size_t WS_AO = WS_P + 207 * MiB;
constexpr size_t WS_CC = WS_AO + 66 * MiB;
constexpr size_t WS_MDC = WS_CC + 66 * MiB;
constexpr size_t WS_MCST = WS_MDC + 66 * MiB;
constexpr size_t WS_MSM = WS_MCST + 33 * MiB;
constexpr size_t WS_QB = WS_MSM + 2 * MiB;
constexpr size_t WS_KV = WS_QB + 50 * MiB;
constexpr size_t WS_CQN = WS_KV + 66 * MiB;
constexpr size_t WS_CKVN = WS_CQN + 17 * MiB;
constexpr size_t WS_KR = WS_CKVN + 17 * MiB;
constexpr size_t WS_A_END = WS_KR + 3 * MiB;
constexpr size_t WS_FN2 = WS_REG;
constexpr size_t WS_LOG4 = WS_FN2 + 132 * MiB;
constexpr size_t WS_LIST = WS_LOG4 + 66 * MiB;
constexpr size_t WS_GATE = WS_LIST + 5 * MiB;
constexpr size_t WS_H = WS_GATE + 1 * MiB;
constexpr size_t WS_YS = WS_H + 116 * MiB;
constexpr size_t WS_B_END = WS_YS + 462 * MiB;
constexpr size_t WS_END = (WS_A_END > WS_B_END ? WS_A_END : WS_B_END);
constexpr size_t MSM_DN = 0;
constexpr size_t MSM_NST = 32 * 66 * 64 * 4;
constexpr size_t MSM_MLOC = 2 * 32 * 66 * 64 * 4;
constexpr size_t MSM_BTOT = MSM_MLOC + 32 * 66 * 4;
constexpr size_t MSM_MST = MSM_BTOT + 32 * 66 * 4;

constexpr int CW_TMO = 0;
constexpr int CW_BAR = 4096;
constexpr int CW_CNT = 16384;

constexpr int LDS_SCR = 0;
constexpr int LDS_AUX = 131072;
constexpr int LDS_CTL = 155648;
constexpr int LDS_BYTES = 155904;

__device__ __forceinline__ unsigned cvt_pk_bf16(float lo, float hi) { unsigned r; asm volatile("v_cvt_pk_bf16_f32 %0, %1, %2" : "=v"(r) : "v"(lo), "v"(hi)); return r; }
__device__ __forceinline__ unsigned f2bf(float f) { unsigned u = __builtin_bit_cast(unsigned, f); return (u + 0x7fffu + ((u >> 16) & 1u)) >> 16; }
__device__ __forceinline__ float bf2f(unsigned b) { return __builtin_bit_cast(float, b << 16); }
__device__ __forceinline__ float bflo(unsigned w) { return __builtin_bit_cast(float, w << 16); }
__device__ __forceinline__ float bfhi(unsigned w) { return __builtin_bit_cast(float, w & 0xffff0000u); }
__device__ __forceinline__ float wave_sum(float v) {
#pragma unroll
    for (int o = 1; o < 64; o <<= 1) v += __shfl_xor(v, o);
    return v;
}
__device__ __forceinline__ float wave_max(float v) {
#pragma unroll
    for (int o = 1; o < 64; o <<= 1) v = fmaxf(v, __shfl_xor(v, o));
    return v;
}
__device__ __forceinline__ float sigmoidf_(float x) { return 1.f / (1.f + __expf(-x)); }
__device__ __forceinline__ float logsigmoidf_(float x) { return fminf(x, 0.f) - log1pf(__expf(-fabsf(x))); }
#define LDS_WAIT() asm volatile("s_waitcnt lgkmcnt(0)" ::: "memory")
#define VM_WAIT() asm volatile("s_waitcnt vmcnt(0)" ::: "memory")

#define XB_TMO      128
#define XB_XCNT(j)  (256  + 64 * (j))
#define XB_XSUB(j)  (1280 + 64 * (j))
#define XB_XGEN(j)  (2304 + 64 * (j))
#define XB_TOP      3328
#define XB_TOPGEN   3392
#define XCD_BAR_WORDS 3456
#define XB_SPIN_CAP (1u << 20)
__device__ __forceinline__ unsigned xb_ld(unsigned* p)              { return __hip_atomic_load(p, __ATOMIC_RELAXED, __HIP_MEMORY_SCOPE_AGENT); }
__device__ __forceinline__ unsigned xb_add(unsigned* p, unsigned v) { return __hip_atomic_fetch_add(p, v, __ATOMIC_RELAXED, __HIP_MEMORY_SCOPE_AGENT); }
__device__ __forceinline__ unsigned xb_xcc_id() { return (unsigned)__builtin_amdgcn_s_getreg((3 << 11) | 20) & 0xFu; }
#define XB_SPIN(cond, bar) do { unsigned _sp = 0; while (cond) { __builtin_amdgcn_s_sleep(1); \
    if ((++_sp & 255u) == 0u) { if (xb_ld(&(bar)[XB_TMO])) break; if (_sp > XB_SPIN_CAP) { atomicAdd(&(bar)[XB_TMO], 1u); break; } } } } while (0)
struct XcdBarrier { unsigned* bar; unsigned x; volatile LAS unsigned* st; };
__device__ __forceinline__ XcdBarrier xcd_barrier_post(unsigned* bar, volatile LAS unsigned* st) {
    XcdBarrier b; b.bar = bar; b.x = xb_xcc_id(); b.st = st;
    if (threadIdx.x == 0) (void)xb_add(&bar[XB_XCNT(b.x)], 1u);
    return b;
}
__device__ __forceinline__ void xcd_barrier_complete(unsigned* bar, unsigned x, unsigned& nloc, unsigned& nx) {
    const unsigned G = gridDim.x * gridDim.y * gridDim.z;
    unsigned sum, cnt, mine, sp = 0u;
    for (;;) {
        sum = 0u; cnt = 0u; mine = 0u;
#pragma unroll
        for (unsigned j = 0; j < 16; ++j) { const unsigned c = xb_ld(&bar[XB_XCNT(j)]); sum += c; cnt += (c > 0u) ? 1u : 0u; mine = (j == x) ? c : mine; }
        if (sum == G) break;
        __builtin_amdgcn_s_sleep(1);
        if ((++sp & 255u) == 0u) { if (xb_ld(&bar[XB_TMO])) break; if (sp > XB_SPIN_CAP) { atomicAdd(&bar[XB_TMO], 1u); break; } }
    }
    nloc = mine > 0u ? mine : 1u; nx = cnt > 0u ? cnt : 1u;
}
__device__ __forceinline__ void xcd_barrier(const XcdBarrier& b) {
    asm volatile("s_waitcnt vmcnt(0)" ::: "memory");
    __syncthreads();
    if (threadIdx.x == 0) {
        unsigned* bar = b.bar;
        __builtin_amdgcn_s_waitcnt(0);
        unsigned nloc = b.st[0], nx = b.st[1];
        if (nloc == 0u) { xcd_barrier_complete(bar, b.x, nloc, nx); b.st[0] = nloc; b.st[1] = nx; }
        const unsigned old = xb_add(&bar[XB_XSUB(b.x)], 1u);
        const unsigned gen = old / nloc;
        if (old + 1u == (gen + 1u) * nloc) {
            __builtin_amdgcn_fence(__ATOMIC_RELEASE, "agent");
            asm volatile("s_waitcnt vmcnt(0)" ::: "memory");
            const unsigned og = xb_add(&bar[XB_TOP], 1u);
            const unsigned tg = og / nx;
            if (og + 1u == (tg + 1u) * nx) xb_add(&bar[XB_TOPGEN], 1u);
            else XB_SPIN(xb_ld(&bar[XB_TOPGEN]) == tg, bar);
            __builtin_amdgcn_fence(__ATOMIC_ACQUIRE, "agent");
            xb_add(&bar[XB_XGEN(b.x)], 1u);
            asm volatile("s_waitcnt vmcnt(0)" ::: "memory");
        } else {
            XB_SPIN(xb_ld(&bar[XB_XGEN(b.x)]) == gen, bar);
            __builtin_amdgcn_fence(__ATOMIC_ACQUIRE, "agent");
            asm volatile("s_waitcnt vmcnt(0)" ::: "memory");
        }
    }
    __syncthreads();
}

namespace pg8 {
constexpr int BM = 256, BK = 64, HALF = 128, HTB = HALF * BK * 2, STAGE_BYTES = 8 * HTB;
__host__ __device__ __forceinline__ int lds_byte(int r, int c) { const int st = (r >> 4) * 2 + (c >> 5), rr = r & 15, cc = c & 31, ob = rr * 64 + cc * 2; return st * 1024 + (ob ^ (((ob >> 9) & 1) << 5)); }
__host__ __device__ __forceinline__ void stage_rc(int b, int& R, int& C) { const int st = b / 1024, sb = b % 1024, swz = sb ^ (((sb >> 9) & 1) << 5); R = (st >> 1) * 16 + swz / 64; C = (st & 1) * 32 + (swz % 64) / 2; }
__host__ __device__ __forceinline__ int perm32(int rho) { const int n = rho >> 4, i = rho & 15; return 8 * (i >> 2) + 4 * n + (i & 3); }

struct Unit { int pm, pn, ex, rows; };

template <class P>
__device__ __forceinline__ void gemm_phase(LAS unsigned char* lds, const P& pol) {
    int tid_ = threadIdx.x; asm volatile("" : "+v"(tid_));
    const int tid = tid_, wid = __builtin_amdgcn_readfirstlane(tid >> 6), lane = tid & 63, wr = wid >> 2, wc = wid & 3, fr = lane & 15, fq = lane >> 4;
    const int nt = pol.nt;
    int R0, C0, R1, C1; stage_rc(tid * 16, R0, C0); stage_rc(tid * 16 + 8192, R1, C1);
    unsigned voffB[2];
    { const int Rb0 = P::PERM ? ((R0 & ~31) + perm32(R0 & 31)) : R0, Rb1 = P::PERM ? ((R1 & ~31) + perm32(R1 & 31)) : R1;
      voffB[0] = (unsigned)Rb0 * pol.ldb + (unsigned)C0 * 2u; voffB[1] = (unsigned)Rb1 * pol.ldb + (unsigned)C1 * 2u; }
    const size_t kstep = (size_t)(BK * 2);
    const size_t hstepB = (size_t)HALF * pol.ldb;
    const unsigned ldsw = (unsigned)wid * 1024u;
    const int aoff = lds_byte(wr * 64 + fr, fq * 8), boff = lds_byte(wc * 32 + fr, fq * 8);
#define PG8_SA(b, h) (((b) * 2 + (h)) * HTB)
#define PG8_SB(b, h) ((4 + (b) * 2 + (h)) * HTB)
#define PG8_STAGEB(bufoff, gbase) do { _Pragma("unroll") for (int _i = 0; _i < 2; ++_i) \
        __builtin_amdgcn_global_load_lds((const unsigned*)((const char*)(gbase) + voffB[_i]), (LAS unsigned*)(lds + (bufoff) + ldsw + _i * 8192), 16, 0, 0); } while (0)
#define PG8_STAGEA(bufoff, gbase, o0, o1) do { \
        __builtin_amdgcn_global_load_lds((const unsigned*)((const char*)(gbase) + (o0)), (LAS unsigned*)(lds + (bufoff) + ldsw), 16, 0, 0); \
        __builtin_amdgcn_global_load_lds((const unsigned*)((const char*)(gbase) + (o1)), (LAS unsigned*)(lds + (bufoff) + ldsw + 8192), 16, 0, 0); } while (0)
#define PG8_LDA(dst, b, h) do { _Pragma("unroll") for (int m = 0; m < 4; ++m) _Pragma("unroll") for (int k = 0; k < 2; ++k) dst[m][k] = *(const LAS bf16x8*)(lds + PG8_SA(b, h) + aoff + m * 2048 + k * 1024); } while (0)
#define PG8_LDB(dst, b, h) do { _Pragma("unroll") for (int n = 0; n < 2; ++n) _Pragma("unroll") for (int k = 0; k < 2; ++k) dst[n][k] = *(const LAS bf16x8*)(lds + PG8_SB(b, h) + boff + n * 2048 + k * 1024); } while (0)
#define PG8_MMA(ai, bj, At, Bt) do { __builtin_amdgcn_s_setprio(1); _Pragma("unroll") for (int m = 0; m < 4; ++m) _Pragma("unroll") for (int n = 0; n < 2; ++n) _Pragma("unroll") for (int k = 0; k < 2; ++k) \
        acc[ai][bj][m][n] = __builtin_amdgcn_mfma_f32_16x16x32_bf16(Bt[n][k], At[m][k], acc[ai][bj][m][n], 0, 0, 0); __builtin_amdgcn_s_setprio(0); } while (0)
#define PG8_WAIT_V(n) asm volatile("s_waitcnt vmcnt(" #n ")" ::: "memory")
#define PG8_WAIT_L(n) asm volatile("s_waitcnt lgkmcnt(" #n ")" ::: "memory")
#define PG8_BAR __builtin_amdgcn_s_barrier()
#define PG8_SCHED __builtin_amdgcn_sched_barrier(0)
    Unit cur, nxt; int ui = 0;
    if (!pol.next(0, cur)) return;
    f32x4 acc[2][2][4][2];
#pragma unroll
    for (int a = 0; a < 2; ++a)
#pragma unroll
        for (int b = 0; b < 2; ++b)
#pragma unroll
            for (int m = 0; m < 4; ++m)
#pragma unroll
                for (int n = 0; n < 2; ++n) acc[a][b][m][n] = (f32x4){0.f, 0.f, 0.f, 0.f};
    bf16x8 At[4][2], B0[2][2], B1[2][2];
    unsigned oA[2][2], oN[2][2];
    pol.a_off(cur, R0, R1, C0, C1, oA);
    const char* cA = pol.a_base(cur); const char* cB = pol.b_base(cur);
    PG8_STAGEB(PG8_SB(0, 0), cB); PG8_STAGEA(PG8_SA(0, 0), cA, oA[0][0], oA[0][1]); PG8_STAGEB(PG8_SB(0, 1), cB + hstepB); PG8_STAGEA(PG8_SA(0, 1), cA, oA[1][0], oA[1][1]);
    if (wr == 1) PG8_BAR;
    PG8_WAIT_V(4); PG8_BAR;
    PG8_STAGEB(PG8_SB(1, 0), cB + kstep); PG8_STAGEA(PG8_SA(1, 0), cA + kstep, oA[0][0], oA[0][1]); PG8_STAGEB(PG8_SB(1, 1), cB + hstepB + kstep);
    PG8_WAIT_V(6); PG8_BAR;
    for (;;) {
        const bool has_next = pol.next(ui + 1, nxt);
        const char* nA; const char* nB;
        if (has_next) { pol.a_off(nxt, R0, R1, C0, C1, oN); nA = pol.a_base(nxt); nB = pol.b_base(nxt); }
        else { oN[0][0] = oA[0][0]; oN[0][1] = oA[0][1]; oN[1][0] = oA[1][0]; oN[1][1] = oA[1][1]; nA = cA; nB = cB; }
        for (int t = 0; t < nt; t += 2) {
            const bool last = (t == nt - 2);
            const char* a1 = cA + (size_t)(t + 1) * kstep;
            const char* a2 = last ? nA : cA + (size_t)(t + 2) * kstep; const char* b2 = last ? nB : cB + (size_t)(t + 2) * kstep;
            const char* a3 = a2 + kstep; const char* b3 = b2 + kstep;
            const unsigned s00 = last ? oN[0][0] : oA[0][0], s01 = last ? oN[0][1] : oA[0][1], s10 = last ? oN[1][0] : oA[1][0], s11 = last ? oN[1][1] : oA[1][1];
            PG8_LDB(B0, 0, 0); PG8_SCHED; PG8_LDA(At, 0, 0); PG8_STAGEA(PG8_SA(1, 1), a1, oA[1][0], oA[1][1]);
            PG8_WAIT_L(8); PG8_BAR; PG8_WAIT_L(0); PG8_MMA(0, 0, At, B0); PG8_BAR; PG8_SCHED;
            PG8_LDB(B1, 0, 1); PG8_STAGEB(PG8_SB(0, 0), b2);
            PG8_BAR; PG8_WAIT_L(0); PG8_MMA(0, 1, At, B1); PG8_BAR;
            PG8_LDA(At, 0, 1); PG8_STAGEA(PG8_SA(0, 0), a2, s00, s01);
            PG8_BAR; PG8_WAIT_L(0); PG8_MMA(1, 0, At, B0); PG8_BAR; PG8_SCHED;
            PG8_STAGEB(PG8_SB(0, 1), b2 + hstepB);
            PG8_WAIT_V(6); PG8_BAR; PG8_MMA(1, 1, At, B1); PG8_BAR;
            PG8_LDB(B0, 1, 0); PG8_SCHED; PG8_LDA(At, 1, 0); PG8_STAGEA(PG8_SA(0, 1), a2, s10, s11);
            PG8_WAIT_L(8); PG8_BAR; PG8_WAIT_L(0); PG8_MMA(0, 0, At, B0); PG8_BAR; PG8_SCHED;
            PG8_LDB(B1, 1, 1); PG8_STAGEB(PG8_SB(1, 0), b3);
            PG8_BAR; PG8_WAIT_L(0); PG8_MMA(0, 1, At, B1); PG8_BAR;
            PG8_LDA(At, 1, 1); PG8_STAGEA(PG8_SA(1, 0), a3, s00, s01);
            PG8_BAR; PG8_WAIT_L(0); PG8_MMA(1, 0, At, B0); PG8_BAR; PG8_SCHED;
            PG8_STAGEB(PG8_SB(1, 1), b3 + hstepB);
            PG8_WAIT_V(6); PG8_BAR; PG8_MMA(1, 1, At, B1); PG8_BAR;
        }
        pol.epi(acc, cur, wr, wc, fr, fq);
        if (!has_next) break;
#pragma unroll
        for (int a = 0; a < 2; ++a)
#pragma unroll
            for (int b = 0; b < 2; ++b)
#pragma unroll
                for (int m = 0; m < 4; ++m)
#pragma unroll
                    for (int n = 0; n < 2; ++n) acc[a][b][m][n] = (f32x4){0.f, 0.f, 0.f, 0.f};
        cur = nxt; cA = nA; cB = nB; ++ui;
        oA[0][0] = oN[0][0]; oA[0][1] = oN[0][1]; oA[1][0] = oN[1][0]; oA[1][1] = oN[1][1];
    }
    PG8_WAIT_V(0);
    if (wr == 0) PG8_BAR;
    PG8_BAR;
#undef PG8_SA
#undef PG8_SB
#undef PG8_STAGEA
#undef PG8_STAGEB
#undef PG8_LDA
#undef PG8_LDB
#undef PG8_MMA
#undef PG8_WAIT_V
#undef PG8_WAIT_L
#undef PG8_BAR
#undef PG8_SCHED
}

__device__ __forceinline__ bool static_order(int nM, int nN, int G, int c, int i, int& pm, int& pn) {
    const int nwg = nM * nN; const long L = (long)i * G + c; if (L >= nwg) return false;
    int wgid = (int)L; { const int q = nwg / 8, r = nwg % 8, xcd = wgid % 8, off = wgid / 8; wgid = (xcd < r ? xcd * (q + 1) : r * (q + 1) + (xcd - r) * q) + off; }
    const int nig = 8 * nN, gid = wgid / nig, fm = gid * 8, gsz = (nM - fm) < 8 ? (nM - fm) : 8;
    pm = fm + ((wgid % nig) % gsz); pn = (wgid % nig) / gsz; return true;
}

__device__ __forceinline__ void store_tile_bf16(const f32x4 (&acc)[2][2][4][2], bf16_t* base  , size_t ldc, int wr, int wc, int fr, int fq, int rows_valid) {
#pragma unroll
    for (int ai = 0; ai < 2; ++ai)
#pragma unroll
        for (int m = 0; m < 4; ++m) { const int r = ai * HALF + wr * 64 + m * 16 + fr; if (r < rows_valid) { bf16_t* rowp = base + (size_t)r * ldc + wc * 32 + 8 * fq;
#pragma unroll
            for (int bj = 0; bj < 2; ++bj) { const f32x4 v0 = acc[ai][bj][m][0], v1 = acc[ai][bj][m][1];
                u32x4 w; w.x = cvt_pk_bf16(v0[0], v0[1]); w.y = cvt_pk_bf16(v0[2], v0[3]); w.z = cvt_pk_bf16(v1[0], v1[1]); w.w = cvt_pk_bf16(v1[2], v1[3]);
                *(u32x4*)(rowp + bj * HALF) = w; } } }
}
}

namespace att {
constexpr int NW = 8, QBLK = 32, KVBLK = 64, DV = 128;
constexpr int SHM_V = KVBLK * DV * 2  , SHM_K = KVBLK * 128 * 2  , SHM_K2 = KVBLK * 64 * 2  ;
constexpr int OFF_V = 0, OFF_K = 2 * SHM_V, OFF_K2 = OFF_K + 2 * SHM_K, OFF_WS = OFF_K2 + 2 * SHM_K2, ATT_LDS = OFF_WS + NW * 64 * 4  , OFF_QR = ATT_LDS  ;
constexpr float THR = 8.f;
#define KSWZ(row, colB) ((row) * 256 + ((colB) ^ (((row) & 7) << 4)))
#define KSWZ64(row, colB) ((row) * 128 + ((colB) ^ ((((row) >> 1) & 7) << 4)))
#define SBAR() __builtin_amdgcn_sched_barrier(0)
__device__ __forceinline__ int crow(int r, int hi) { return (r & 3) + 8 * (r >> 2) + 4 * hi; }
__device__ __forceinline__ int v_st(int k, int c) { const int kk = (k & ~0xC) | ((k & 4) << 1) | ((k & 8) >> 1); return ((kk >> 3) * 4 + (c >> 5)) * 512 + ((kk & 7) * 32 + (c & 31)) * 2; }
__device__ __forceinline__ int v_rd_base(int lane) { return ((lane & 3) << 3) | (((lane >> 2) & 3) << 6) | (((lane >> 4) & 1) << 5) | (((lane >> 5) & 1) << 8); }
constexpr int v_rd_off(int d0, int ks, int half) { return d0 * 512 + ks * 4096 + half * 2048; }
template <int OFF> __device__ __forceinline__ s16x4 tr_read(int vb) {
    s16x4 r; asm volatile("ds_read_b64_tr_b16 %0, %1 offset:%2" : "=&v"(r) : "v"(vb), "i"(OFF) : "memory"); return r;
}
template <int D0> __device__ __forceinline__ void pv_one(f32x16& od, int vb, bf16x8 pa0, bf16x8 pa1, bf16x8 pa2, bf16x8 pa3) {
    const s16x4 l0 = tr_read<v_rd_off(D0, 0, 0)>(vb), h0 = tr_read<v_rd_off(D0, 0, 1)>(vb), l1 = tr_read<v_rd_off(D0, 1, 0)>(vb), h1 = tr_read<v_rd_off(D0, 1, 1)>(vb);
    const s16x4 l2 = tr_read<v_rd_off(D0, 2, 0)>(vb), h2 = tr_read<v_rd_off(D0, 2, 1)>(vb), l3 = tr_read<v_rd_off(D0, 3, 0)>(vb), h3 = tr_read<v_rd_off(D0, 3, 1)>(vb);
    asm volatile("s_waitcnt lgkmcnt(0)" ::: "memory"); SBAR();
#define PK(L, H) (bf16x8){L[0], L[1], L[2], L[3], H[0], H[1], H[2], H[3]}
    od = __builtin_amdgcn_mfma_f32_32x32x16_bf16(pa0, PK(l0, h0), od, 0, 0, 0);
    od = __builtin_amdgcn_mfma_f32_32x32x16_bf16(pa1, PK(l1, h1), od, 0, 0, 0);
    od = __builtin_amdgcn_mfma_f32_32x32x16_bf16(pa2, PK(l2, h2), od, 0, 0, 0);
    od = __builtin_amdgcn_mfma_f32_32x32x16_bf16(pa3, PK(l3, h3), od, 0, 0, 0);
#undef PK
}
__device__ __forceinline__ void pv_d0(f32x16* o, int vb, bf16x8 pa0, bf16x8 pa1, bf16x8 pa2, bf16x8 pa3) {
    pv_one<0>(o[0], vb, pa0, pa1, pa2, pa3); pv_one<1>(o[1], vb, pa0, pa1, pa2, pa3); pv_one<2>(o[2], vb, pa0, pa1, pa2, pa3); pv_one<3>(o[3], vb, pa0, pa1, pa2, pa3);
}
__device__ __forceinline__ void partialSM(f32x16& p0, f32x16& p1, float& m_reg, float& mn, float& alpha, float C, float thr_raw) {
    float pmax = p0[0];
#pragma unroll
    for (int r = 1; r < 16; ++r) pmax = fmaxf(pmax, p0[r]);
#pragma unroll
    for (int r = 0; r < 16; ++r) pmax = fmaxf(pmax, p1[r]);
    { auto rr = __builtin_amdgcn_permlane32_swap(__builtin_bit_cast(unsigned, pmax), __builtin_bit_cast(unsigned, pmax), false, false);
      pmax = fmaxf(__builtin_bit_cast(float, rr[0]), __builtin_bit_cast(float, rr[1])); }
    if (__builtin_expect(__all(pmax - m_reg <= thr_raw), 1)) { mn = m_reg; alpha = 1.f; }
    else { mn = fmaxf(m_reg, pmax); alpha = __builtin_amdgcn_exp2f((m_reg - mn) * C); m_reg = mn; }
    const float mnC = -mn * C;
#pragma unroll
    for (int r = 0; r < 16; ++r) p0[r] = fmaf(p0[r], C, mnC);
#pragma unroll
    for (int r = 0; r < 16; ++r) p1[r] = fmaf(p1[r], C, mnC);
#pragma unroll
    for (int r = 0; r < 16; ++r) p0[r] = __builtin_amdgcn_exp2f(p0[r]);
}
__device__ __forceinline__ void finishSM(f32x16& p0, f32x16& p1, float alpha, float& l_reg, bf16x8& pa0, bf16x8& pa1, bf16x8& pa2, bf16x8& pa3) {
#pragma unroll
    for (int r = 0; r < 16; ++r) p1[r] = __builtin_amdgcn_exp2f(p1[r]);
    float ps = 0;
#pragma unroll
    for (int r = 0; r < 16; ++r) ps += p0[r];
#pragma unroll
    for (int r = 0; r < 16; ++r) ps += p1[r];
    { auto rr = __builtin_amdgcn_permlane32_swap(__builtin_bit_cast(unsigned, ps), __builtin_bit_cast(unsigned, ps), false, false);
      ps = __builtin_bit_cast(float, rr[0]) + __builtin_bit_cast(float, rr[1]); }
    l_reg = l_reg * alpha + ps;
#define PK4(P, BASE, OUT) do { unsigned a0 = cvt_pk_bf16(P[BASE + 0], P[BASE + 1]), a1 = cvt_pk_bf16(P[BASE + 2], P[BASE + 3]);   \
    unsigned b0 = cvt_pk_bf16(P[BASE + 4], P[BASE + 5]), b1 = cvt_pk_bf16(P[BASE + 6], P[BASE + 7]);                              \
    auto r0 = __builtin_amdgcn_permlane32_swap(a0, b0, false, false); auto r1 = __builtin_amdgcn_permlane32_swap(a1, b1, false, false); \
    u32x4 w = {r0[0], r1[0], r0[1], r1[1]}; OUT = __builtin_bit_cast(bf16x8, w); } while (0)
    PK4(p0, 0, pa0); PK4(p0, 8, pa1); PK4(p1, 0, pa2); PK4(p1, 8, pa3);
#undef PK4
}
__device__ __forceinline__ bf16x8 rope8(bf16x8 v, const char* tabc, unsigned off) {
    const f32x4 c01 = *(const f32x4*)(tabc + off), c23 = *(const f32x4*)(tabc + off + 16);
    const u32x4 w = __builtin_bit_cast(u32x4, v); u32x4 o;
    { const float x1 = bflo(w[0]), x2 = bfhi(w[0]); o[0] = cvt_pk_bf16(x1 * c01[0] - x2 * c01[1], x1 * c01[1] + x2 * c01[0]); }
    { const float x1 = bflo(w[1]), x2 = bfhi(w[1]); o[1] = cvt_pk_bf16(x1 * c01[2] - x2 * c01[3], x1 * c01[3] + x2 * c01[2]); }
    { const float x1 = bflo(w[2]), x2 = bfhi(w[2]); o[2] = cvt_pk_bf16(x1 * c23[0] - x2 * c23[1], x1 * c23[1] + x2 * c23[0]); }
    { const float x1 = bflo(w[3]), x2 = bfhi(w[3]); o[3] = cvt_pk_bf16(x1 * c23[2] - x2 * c23[3], x1 * c23[3] + x2 * c23[2]); }
    return __builtin_bit_cast(bf16x8, o);
}

struct UnitDesc {
    const bf16_t* Q; int ldq;
    const bf16_t* K; int ldk;
    const bf16_t* K2; int ldk2;
    const bf16_t* V; int ldv;
    bf16_t* O; int ldo;
    int NT;
    float C;
    const f32x2* rope; int qtok0;
    int seg_tiles, seg2_row0;
    int ktok0;
    float sink_l2;
};
template <int MODE>
__device__ __forceinline__ void attn_unit(const UnitDesc& U, char* lds) {
    constexpr int DQK = MODE == 0 ? 64 : (MODE == 1 ? 192 : 128), NQ = DQK / 16, NQR = (MODE == 1) ? 4 : NQ;
    int tid_ = threadIdx.x; asm volatile("" : "+v"(tid_));
    const int tid = tid_, wid = tid >> 6, lane = tid & 63, r32 = lane & 31, hi = lane >> 5;
    char* V_lds = lds + OFF_V; char* K_lds = lds + OFF_K; char* K2_lds = lds + OFF_K2;
    float* ws = (float*)(lds + OFF_WS) + wid * 64; float* li_l = ws; float* al_l = ws + 32;
    float m_reg = -1e30f, l_reg = 0; f32x16 o[4] = {}; bf16x8 qr[NQR];
    bf16x8* QRl = (bf16x8*)(lds + OFF_QR) + wid * 512 + lane;
    {   const bf16_t* Qw = U.Q + (size_t)(wid * QBLK + r32) * U.ldq + hi * 8;
        const int qt = U.qtok0 + wid * QBLK + r32, prow = qt >> 6, pcol = qt & 63;
        constexpr int RQ = (MODE == 2) ? 32 : 16;
        const unsigned orow = (unsigned)prow * RQ * 8 + hi * 32, ocol = (unsigned)pcol * RQ * 8 + hi * 32; const char* tabc = (const char*)U.rope;
#pragma unroll
        for (int d0 = 0; d0 < NQ; ++d0) { bf16x8 v = *reinterpret_cast<const bf16x8*>(Qw + d0 * 16);
            const int pi = (MODE == 1) ? (d0 - 8) * 8 : d0 * 8;
            if (MODE != 1 || d0 >= 8) { if (MODE != 0 || U.rope) v = rope8(v, tabc, (pi < RQ ? orow : ocol) + (unsigned)((pi < RQ ? pi : pi - RQ) * 8)); }
            if (MODE == 1 && d0 >= NQR) QRl[(d0 - NQR) * 64] = v; else qr[d0 < NQR ? d0 : 0] = v; }
    }
    const float thr_raw = THR * 1.4426950408889634f / U.C;
    const int sr = tid >> 4, sc = (tid & 15) * 8;
    const int vst0 = v_st(sr, sc), vst1 = v_st(32 + sr, sc);
    const int k64r = tid >> 3, k64c = (tid & 7) * 8;
    const int vb0 = (int)(uintptr_t)V_lds + v_rd_base(lane);
    constexpr int DEPTH = (MODE == 0) ? 2 : 1, SE = 0, SO = DEPTH - 1;
    bf16x8 sv0[DEPTH], sv1[DEPTH], sk0[DEPTH], sk1[DEPTH], sk2[DEPTH];
    auto krow = [&](int t) -> int { if (MODE == 2) return t < U.seg_tiles ? t * 64 : U.seg2_row0 + (t - U.seg_tiles) * 64; return t * 64; };
#define SLOAD(i, t) do { const int _r = krow(t); \
    sv0[i] = *reinterpret_cast<const bf16x8*>(U.V + (size_t)(_r + sr) * U.ldv + sc); sv1[i] = *reinterpret_cast<const bf16x8*>(U.V + (size_t)(_r + 32 + sr) * U.ldv + sc); \
    if (MODE == 0) { sk0[i] = *reinterpret_cast<const bf16x8*>(U.K + (size_t)(_r + k64r) * U.ldk + k64c); } \
    else { sk0[i] = *reinterpret_cast<const bf16x8*>(U.K + (size_t)(_r + sr) * U.ldk + sc); sk1[i] = *reinterpret_cast<const bf16x8*>(U.K + (size_t)(_r + 32 + sr) * U.ldk + sc); } \
    if (MODE == 1) { sk2[i] = *reinterpret_cast<const bf16x8*>(U.K2 + (size_t)(_r + k64r) * U.ldk2 + k64c); } } while (0)
#define SWRITE(b, i) do { *(bf16x8*)(V_lds + (b) * SHM_V + vst0) = sv0[i]; *(bf16x8*)(V_lds + (b) * SHM_V + vst1) = sv1[i]; \
    if (MODE == 0) { *(bf16x8*)(K_lds + (b) * SHM_K + KSWZ64(k64r, k64c * 2)) = sk0[i]; } \
    else { *(bf16x8*)(K_lds + (b) * SHM_K + KSWZ(sr, sc * 2)) = sk0[i]; *(bf16x8*)(K_lds + (b) * SHM_K + KSWZ(32 + sr, sc * 2)) = sk1[i]; } \
    if (MODE == 1) { *(bf16x8*)(K2_lds + (b) * SHM_K2 + KSWZ64(k64r, k64c * 2)) = sk2[i]; } } while (0)
#define SWAIT() do { if (MODE == 0) asm volatile("s_waitcnt vmcnt(3)" ::: "memory"); else asm volatile("s_waitcnt vmcnt(0)" ::: "memory"); } while (0)
#define RESC(a) do { if (__any((a) < 1.f)) { if (hi == 0) al_l[r32] = (a); asm volatile("s_waitcnt lgkmcnt(0)" ::: "memory"); \
    _Pragma("unroll") for (int d = 0; d < 4; ++d) _Pragma("unroll") for (int r = 0; r < 16; ++r) o[d][r] *= al_l[crow(r, hi)]; } } while (0)
#define QKT(p0, p1, b) do { p0 = f32x16{}; p1 = f32x16{}; \
    if (MODE == 0) { _Pragma("unroll") for (int d0 = 0; d0 < 4; ++d0) { const int cb = (d0 * 16 + hi * 8) * 2; \
        const bf16x8 b0 = *reinterpret_cast<const bf16x8*>(K_lds + (b) * SHM_K + KSWZ64(r32, cb)); const bf16x8 b1 = *reinterpret_cast<const bf16x8*>(K_lds + (b) * SHM_K + KSWZ64(32 + r32, cb)); \
        p0 = __builtin_amdgcn_mfma_f32_32x32x16_bf16(b0, qr[d0], p0, 0, 0, 0); p1 = __builtin_amdgcn_mfma_f32_32x32x16_bf16(b1, qr[d0], p1, 0, 0, 0); } } \
    else { _Pragma("unroll") for (int d0 = 0; d0 < 8; ++d0) { const int cb = (d0 * 16 + hi * 8) * 2; \
        const bf16x8 b0 = *reinterpret_cast<const bf16x8*>(K_lds + (b) * SHM_K + KSWZ(r32, cb)); const bf16x8 b1 = *reinterpret_cast<const bf16x8*>(K_lds + (b) * SHM_K + KSWZ(32 + r32, cb)); \
        const bf16x8 qf = (MODE == 1 && d0 >= NQR) ? QRl[(d0 >= NQR ? d0 - NQR : 0) * 64] : qr[d0 < NQR ? d0 : 0]; \
        p0 = __builtin_amdgcn_mfma_f32_32x32x16_bf16(b0, qf, p0, 0, 0, 0); p1 = __builtin_amdgcn_mfma_f32_32x32x16_bf16(b1, qf, p1, 0, 0, 0); } \
      if (MODE == 1) { _Pragma("unroll") for (int d0 = 0; d0 < 4; ++d0) { const int cb = (d0 * 16 + hi * 8) * 2; \
        const bf16x8 b0 = *reinterpret_cast<const bf16x8*>(K2_lds + (b) * SHM_K2 + KSWZ64(r32, cb)); const bf16x8 b1 = *reinterpret_cast<const bf16x8*>(K2_lds + (b) * SHM_K2 + KSWZ64(32 + r32, cb)); \
        const bf16x8 qf = QRl[(8 - NQR + d0) * 64]; p0 = __builtin_amdgcn_mfma_f32_32x32x16_bf16(b0, qf, p0, 0, 0, 0); p1 = __builtin_amdgcn_mfma_f32_32x32x16_bf16(b1, qf, p1, 0, 0, 0); } } } } while (0)
#define MASK(p0, p1, t) do { if (MODE == 2) { if ((t) >= U.seg_tiles) { const int _d0 = U.ktok0 + ((t) - U.seg_tiles) * 64 - (U.qtok0 + wid * QBLK + r32); \
    _Pragma("unroll") for (int r = 0; r < 16; ++r) { const int _dk = _d0 + crow(r, hi); \
        if (_dk > 128 || _dk < -128) p0[r] = -1e30f; if (_dk + 32 > 128 || _dk + 32 < -128) p1[r] = -1e30f; } } } } while (0)
    f32x16 pA0, pA1, pB0, pB1; float mnA, mnB, alA, alB; bf16x8 pa0, pa1, pa2, pa3; const int NT = U.NT;
    SLOAD(SE, 0); asm volatile("s_waitcnt vmcnt(0)" ::: "memory"); SWRITE(0, SE); __syncthreads();
    QKT(pA0, pA1, 0); MASK(pA0, pA1, 0); partialSM(pA0, pA1, m_reg, mnA, alA, U.C, thr_raw);
    SLOAD(SO, 1); if (DEPTH == 2) { if (2 < NT) SLOAD(SE, 2); }
    if (DEPTH == 2 && 2 < NT) SWAIT(); else asm volatile("s_waitcnt vmcnt(0)" ::: "memory");
    SWRITE(1, SO); __syncthreads();
    for (int j = 1; j + 1 < NT; j += 2) {
        SBAR(); QKT(pB0, pB1, 1); MASK(pB0, pB1, j);
        finishSM(pA0, pA1, alA, l_reg, pa0, pa1, pa2, pa3); SBAR();
        SLOAD(SO, j + DEPTH); SBAR();
        pv_d0(o, vb0, pa0, pa1, pa2, pa3); partialSM(pB0, pB1, m_reg, mnB, alB, U.C, thr_raw);
        __syncthreads(); SWAIT(); SWRITE(0, SE);
        RESC(alB); __syncthreads();
        SBAR(); QKT(pA0, pA1, 0); MASK(pA0, pA1, j + 1);
        finishSM(pB0, pB1, alB, l_reg, pa0, pa1, pa2, pa3); SBAR();
        if (DEPTH == 1 || j + 3 < NT) SLOAD(SE, j + 1 + DEPTH); SBAR();
        pv_d0(o, vb0 + SHM_V, pa0, pa1, pa2, pa3); partialSM(pA0, pA1, m_reg, mnA, alA, U.C, thr_raw);
        __syncthreads(); if (DEPTH == 1 || j + 3 < NT) SWAIT(); else asm volatile("s_waitcnt vmcnt(0)" ::: "memory");
        SWRITE(1, SO);
        RESC(alA); __syncthreads();
    }
    SBAR(); QKT(pB0, pB1, 1); MASK(pB0, pB1, NT - 1);
    finishSM(pA0, pA1, alA, l_reg, pa0, pa1, pa2, pa3); SBAR();
    pv_d0(o, vb0, pa0, pa1, pa2, pa3); partialSM(pB0, pB1, m_reg, mnB, alB, U.C, thr_raw);
    __syncthreads(); RESC(alB);
    finishSM(pB0, pB1, alB, l_reg, pa0, pa1, pa2, pa3); SBAR();
    pv_d0(o, vb0 + SHM_V, pa0, pa1, pa2, pa3);
    if (MODE == 2) l_reg += __builtin_amdgcn_exp2f(U.sink_l2 - m_reg * U.C);
    if (hi == 0) li_l[r32] = l_reg; asm volatile("s_waitcnt lgkmcnt(0)" ::: "memory");
    float rli[16];
#pragma unroll
    for (int r = 0; r < 16; ++r) rli[r] = __builtin_amdgcn_rcpf(li_l[crow(r, hi)]);
    int hio = hi, r32o = r32; asm volatile("" : "+v"(hio), "+v"(r32o));
    bf16_t* Ow = U.O + (size_t)(wid * QBLK + 4 * hio) * U.ldo + r32o;
#pragma unroll
    for (int r = 0; r < 16; ++r) { const int orow = (r & 3) + 8 * (r >> 2);
#pragma unroll
        for (int d0 = 0; d0 < 4; ++d0) Ow[(size_t)orow * U.ldo + d0 * 32] = (bf16_t)f2bf(o[d0][r] * rli[r]); }
    __syncthreads();
#undef SLOAD
#undef SWRITE
#undef SWAIT
#undef RESC
#undef QKT
#undef MASK
}
}

struct Args { const float* in[31]; float* out; unsigned char* ws; int ph_lo, ph_hi; };
enum { I_X = 0, I_C, I_CTX, I_CCTX, I_MODW, I_MODB, I_NMPRE, I_NMPOST, I_NFPRE, I_NFPOST, I_ABIN, I_ABOUT, I_DLAM, I_DNORM, I_MGB, I_MNORM, I_CDIN, I_CDOUT,
       I_QNORM, I_WUQ, I_KVNORM, I_WUKV, I_SINK, I_RW, I_RB, I_EG, I_EU, I_ED, I_SG, I_SU, I_SD };
struct Frame {
    LAS unsigned char* lds; char* ldsg;
    unsigned char* ws; const float* const* in; float* out;
    int tid, lane, wave, G, bid, gw, NGW;
};
__device__ __forceinline__ int row_batch(int r) { return r >= TPB ? 1 : 0; }
__device__ __forceinline__ const float* src_row(const Frame& F, int r) {
    const int b = row_batch(r), pos = r - b * TPB;
    return pos < CTXL ? F.in[I_CTX] + ((size_t)b * CTXL + pos) * DM : F.in[I_X] + ((size_t)b * SEQ + (pos - CTXL)) * DM;
}
__device__ __forceinline__ int row_variant(int r) { const int b = row_batch(r), pos = r - b * TPB; return pos < CTXL ? 2 : b; }

__device__ __forceinline__ void tr_item(const float* __restrict__ src, size_t ldsrc, bf16_t* __restrict__ dst, size_t ldd, LAS float* scr, int lane) {
    const int kk = lane >> 3, n4 = (lane & 7) * 4;
    f32x4 v[8];
#pragma unroll
    for (int i = 0; i < 8; ++i) v[i] = *(const f32x4*)(src + (size_t)(8 * i + kk) * ldsrc + n4);
#pragma unroll
    for (int i = 0; i < 8; ++i) { LAS float* s = scr + (8 * i + kk) * 33 + n4; s[0] = v[i].x; s[1] = v[i].y; s[2] = v[i].z; s[3] = v[i].w; }
    LDS_WAIT(); asm volatile("" ::: "memory");
    const int c = lane & 7;
#pragma unroll
    for (int j = 0; j < 4; ++j) { const int n = (lane >> 3) + 8 * j; const LAS float* s = scr + (8 * c) * 33 + n;
        u32x4 o; o.x = cvt_pk_bf16(s[0 * 33], s[1 * 33]); o.y = cvt_pk_bf16(s[2 * 33], s[3 * 33]); o.z = cvt_pk_bf16(s[4 * 33], s[5 * 33]); o.w = cvt_pk_bf16(s[6 * 33], s[7 * 33]);
        *(u32x4*)(dst + (size_t)n * ldd + 8 * c) = o; }
    LDS_WAIT(); asm volatile("" ::: "memory");
}
__device__ __forceinline__ void p0_prologue(Frame& F) {
    unsigned char* ws = F.ws;
    LAS float* sil = (LAS float*)(F.lds + LDS_AUX);
    for (int i = F.tid; i < 3 * DM; i += 512) { const int v = i / DM, k = i % DM; const float c = v < 2 ? F.in[I_C][v * DM + k] : F.in[I_CCTX][k]; sil[i] = c / (1.f + __expf(-c)); }
    __syncthreads();
    if (F.gw < 2 * 8 * 48) {
        const int l = F.gw / 384, r = F.gw % 384, ks = r / 48, cg = r % 48;
        const float* W = F.in[I_MODW] + ((size_t)l * DM + ks * 256) * 12288 + cg * 256 + F.lane * 4;
        f32x4 a0 = {0, 0, 0, 0}, a1 = a0, a2 = a0;
#pragma unroll 8
        for (int k = 0; k < 256; ++k) { const f32x4 w = *(const f32x4*)(W + (size_t)k * 12288); const float s0 = sil[ks * 256 + k], s1 = sil[DM + ks * 256 + k], s2 = sil[2 * DM + ks * 256 + k];
            a0 += w * s0; a1 += w * s1; a2 += w * s2; }
        float* o = (float*)(ws + WS_MODP) + ((size_t)(l * 8 + ks) * 3) * 12288 + cg * 256 + F.lane * 4;
        *(f32x4*)(o) = a0; *(f32x4*)(o + 12288) = a1; *(f32x4*)(o + 2 * 12288) = a2;
    }
    if (F.bid == 0) {
        f32x2* t64 = (f32x2*)(ws + WS_ROPE); f32x2* t128 = (f32x2*)(ws + WS_ROPE + 65536);
        for (int i = F.tid; i < 128 * 16; i += 512) { const int pos = i >> 4, j = i & 15; const float inv = exp2f(-(float)j * (13.287712379549449f / 16.f)); const float a = (float)pos * inv * 0.15915494309189535f; t64[i] = (f32x2){__builtin_amdgcn_cosf(a), __builtin_amdgcn_sinf(a)}; }
        for (int i = F.tid; i < 128 * 32; i += 512) { const int pos = i >> 5, j = i & 31; const float inv = exp2f(-(float)j * (13.287712379549449f / 32.f)); const float a = (float)pos * inv * 0.15915494309189535f; t128[i] = (f32x2){__builtin_amdgcn_cosf(a), __builtin_amdgcn_sinf(a)}; }
    }
    for (int i = F.bid * 512 + F.tid; i < 2 * 256 * 512; i += F.G * 512) {
        const int k8 = i & 511, r = (i >> 9) & 255, l = i >> 17; const int k0 = k8 * 8;
        unsigned o[8];
#pragma unroll
        for (int j = 0; j < 8; ++j) { const int k = k0 + j; float val = 0.f;
            if (r < 128 && (r < 64 || k < 2048)) { const float w = F.in[I_RW][((size_t)l * DM + (k & 2047)) * 64 + (r & 63)]; const float h = bf2f(f2bf(w)); val = r < 64 ? h : (w - h); }
            o[j] = f2bf(val); }
        u32x4 w4 = {o[0] | (o[1] << 16), o[2] | (o[3] << 16), o[4] | (o[5] << 16), o[6] | (o[7] << 16)};
        *(u32x4*)((bf16_t*)(ws + WS_WRT) + ((size_t)(l * 256 + r) * 4096 + k0)) = w4;
    }
    for (int i = F.bid * 512 + F.tid; i < 224 * 256; i += F.G * 512) *(u32x4*)((bf16_t*)(ws + WS_WABIN) + (size_t)AB_IN * DM + (size_t)i * 8) = (u32x4){0, 0, 0, 0};
    for (int i = F.bid * 512 + F.tid; i < 1536 * 8; i += F.G * 512) *(u32x4*)((bf16_t*)(ws + WS_WUQ) + (size_t)(i >> 3) * 512 + 448 + (i & 7) * 8) = (u32x4){0, 0, 0, 0};
    LAS float* scr = (LAS float*)(F.lds + LDS_SCR + F.wave * 16384);
    constexpr int J1 = 32 * 193, J2 = 32 * 64, J3 = 32 * 80, J4 = 32 * 64, J5 = 7 * 48, J6 = 8 * 64, JE = 2 * 64 * 512, JS = 2 * 512;
    constexpr int NITEMS = J1 + J2 + J3 + J4 + J5 + J6 + 3 * JE + 3 * JS;
    for (int it = F.gw; it < NITEMS; it += F.NGW) {
        int r = it;
        if (r < J1) { const int kb = r / 193, nb = r % 193; tr_item(F.in[I_ABIN] + (size_t)kb * 64 * AB_IN + nb * 32, AB_IN, (bf16_t*)(ws + WS_WABIN) + (size_t)nb * 32 * DM + kb * 64, DM, scr, F.lane); continue; } r -= J1;
        if (r < J2) { const int kb = r / 64, nb = r % 64; tr_item(F.in[I_ABOUT] + (size_t)kb * 64 * DM + nb * 32, DM, (bf16_t*)(ws + WS_WABOUT) + (size_t)nb * 32 * DM + kb * 64, DM, scr, F.lane); continue; } r -= J2;
        if (r < J3) { const int kb = r / 80, nb = r % 80; tr_item(F.in[I_CDIN] + (size_t)kb * 64 * CD_IN + nb * 32, CD_IN, (bf16_t*)(ws + WS_WCDIN) + (size_t)nb * 32 * DM + kb * 64, DM, scr, F.lane); continue; } r -= J3;
        if (r < J4) { const int kb = r / 64, nb = r % 64; tr_item(F.in[I_CDOUT] + (size_t)kb * 64 * DM + nb * 32, DM, (bf16_t*)(ws + WS_WCDOUT) + (size_t)nb * 32 * DM + kb * 64, DM, scr, F.lane); continue; } r -= J4;
        if (r < J5) { const int kb = r / 48, nb = r % 48; tr_item(F.in[I_WUQ] + (size_t)kb * 64 * 1536 + nb * 32, 1536, (bf16_t*)(ws + WS_WUQ) + (size_t)nb * 32 * 512 + kb * 64, 512, scr, F.lane); continue; } r -= J5;
        if (r < J6) { const int kb = r / 64, nb = r % 64; tr_item(F.in[I_WUKV] + (size_t)kb * 64 * 2048 + nb * 32, 2048, (bf16_t*)(ws + WS_WUKV) + (size_t)nb * 32 * 512 + kb * 64, 512, scr, F.lane); continue; } r -= J6;
        if (r < 2 * JE) {
            const int up = r >= JE; if (up) r -= JE; const int le = r / 512, q = r % 512, kb = q / 16, nb = q % 16, l = le >> 6, e = le & 63; const int n0 = nb * 32;
            tr_item((up ? F.in[I_EU] : F.in[I_EG]) + ((size_t)le * DM + kb * 64) * EFF + n0, EFF, (bf16_t*)(ws + WS_WGU) + ((size_t)(l * 65 + e) * 1024 + (n0 >> 7) * 256 + up * 128 + (n0 & 127)) * DM + kb * 64, DM, scr, F.lane); continue; } r -= 2 * JE;
        if (r < JE) {
            const int le = r / 512, q = r % 512, kb = q / 64, nb = q % 64, l = le >> 6, e = le & 63;
            tr_item(F.in[I_ED] + ((size_t)le * EFF + kb * 64) * DM + nb * 32, DM, (bf16_t*)(ws + WS_WDN) + ((size_t)(l * 65 + e) * 2048 + nb * 32) * EFF + kb * 64, EFF, scr, F.lane); continue; } r -= JE;
        if (r < 2 * JS) {
            const int up = r >= JS; if (up) r -= JS; const int l = r / 512, q = r % 512, kb = q / 16, nb = q % 16; const int n0 = nb * 32;
            tr_item((up ? F.in[I_SU] : F.in[I_SG]) + ((size_t)l * DM + kb * 64) * EFF + n0, EFF, (bf16_t*)(ws + WS_WGU) + ((size_t)(l * 65 + 64) * 1024 + (n0 >> 7) * 256 + up * 128 + (n0 & 127)) * DM + kb * 64, DM, scr, F.lane); continue; } r -= 2 * JS;
        {   const int l = r / 512, q = r % 512, kb = q / 64, nb = q % 64;
            tr_item(F.in[I_SD] + ((size_t)l * EFF + kb * 64) * DM + nb * 32, DM, (bf16_t*)(ws + WS_WDN) + ((size_t)(l * 65 + 64) * 2048 + nb * 32) * EFF + kb * 64, EFF, scr, F.lane); }
    }
}

__device__ __forceinline__ void load_row_f32(const float* p, int lane, f32x4 (&v)[8]) {
#pragma unroll
    for (int j = 0; j < 8; ++j) v[j] = *(const f32x4*)(p + 4 * lane + 256 * j);
}
__device__ __forceinline__ void load_row_bf16(const bf16_t* p, int lane, f32x4 (&v)[8]) {
#pragma unroll
    for (int j = 0; j < 8; ++j) { const u32x2 w = *(const u32x2*)(p + 4 * lane + 256 * j); v[j] = (f32x4){bflo(w.x), bfhi(w.x), bflo(w.y), bfhi(w.y)}; }
}
__device__ __forceinline__ float row_rstd(const f32x4 (&v)[8]) {
    float s = 0.f;
#pragma unroll
    for (int j = 0; j < 8; ++j) s += (v[j].x * v[j].x + v[j].y * v[j].y) + (v[j].z * v[j].z + v[j].w * v[j].w);
    return rsqrtf(wave_sum(s) * (1.f / DM) + NORM_EPS);
}
__device__ __forceinline__ void store_row_bf16(bf16_t* p, int lane, const f32x4 (&v)[8]) {
#pragma unroll
    for (int j = 0; j < 8; ++j) { u32x2 w; w.x = cvt_pk_bf16(v[j].x, v[j].y); w.y = cvt_pk_bf16(v[j].z, v[j].w); *(u32x2*)(p + 4 * lane + 256 * j) = w; }
}
#define LV4(tab, idx) (*(const LAS f32x4*)((tab) + (idx)))
__device__ __forceinline__ void lds_load_vec(Frame& F, LAS float* dst, const float* src) { for (int i = F.tid; i < DM / 4; i += 512) *(LAS f32x4*)(dst + 4 * i) = *(const f32x4*)(src + 4 * i); }

__device__ __forceinline__ void p1_norm0(Frame& F) {
    unsigned char* ws = F.ws;
    const float* modp = (const float*)(ws + WS_MODP); float* modf = (float*)(ws + WS_MODF);
    LAS float* T = (LAS float*)(F.lds + LDS_SCR);
    for (int i = F.tid; i < 6 * DM; i += 512) { const int t = i / DM, k = i % DM, ch = t / 3, v = t % 3; const int idx = ch * DM + k;
        float s = F.in[I_MODB][idx];
#pragma unroll
        for (int ks = 0; ks < 8; ++ks) s += modp[((size_t)(0 * 8 + ks) * 3 + v) * 12288 + idx];
        T[i] = s; }
    for (int i = F.tid; i < DM; i += 512) T[6 * DM + i] = F.in[I_NMPRE][i];
    if (F.bid < 36) { const int base = F.bid * 2048;
        for (int i = F.tid; i < 2048; i += 512) { const int g = base + i, l = g / 36864, rem = g % 36864, v = rem / 12288, idx = rem % 12288;
            float s = F.in[I_MODB][l * 12288 + idx];
#pragma unroll
            for (int ks = 0; ks < 8; ++ks) s += modp[((size_t)(l * 8 + ks) * 3 + v) * 12288 + idx];
            modf[g] = s; } }
    __syncthreads();
    bf16_t* HN = (bf16_t*)(ws + WS_HN);
    for (int r = F.gw; r < MROWS; r += F.NGW) {
        f32x4 v[8]; load_row_f32(src_row(F, r), F.lane, v); const float rs = row_rstd(v); const int var = row_variant(r);
#pragma unroll
        for (int j = 0; j < 8; ++j) { const int c = 4 * F.lane + 256 * j; const f32x4 g = LV4(T + 6 * DM, c), sh = LV4(T + var * DM, c), sc = LV4(T + (3 + var) * DM, c);
            v[j] = v[j] * rs * g * (sc + 1.f) + sh; }
        store_row_bf16(HN + (size_t)r * DM, F.lane, v);
    }
}

struct PolPlain {
    static constexpr bool PERM = true;
    const bf16_t* A; const bf16_t* Bt; bf16_t* C; unsigned lda, ldb; size_t ldc; int nt, nM, nN, G, c; bool lat;
    __device__ __forceinline__ bool next(int i, pg8::Unit& u) const { int pm, pn; if (!pg8::static_order(nM, nN, G, c, i, pm, pn)) return false; u.pm = lat ? pm + 1 + (pm >= 32) : pm; u.pn = pn; u.ex = 0; u.rows = 256; return true; }
    __device__ __forceinline__ const char* a_base(const pg8::Unit& u) const { return (const char*)A + (size_t)u.pm * 256 * lda; }
    __device__ __forceinline__ void a_off(const pg8::Unit&, int R0, int R1, int C0, int C1, unsigned (&o)[2][2]) const {
        o[0][0] = (unsigned)R0 * lda + C0 * 2; o[0][1] = (unsigned)R1 * lda + C1 * 2; o[1][0] = (unsigned)(R0 + 128) * lda + C0 * 2; o[1][1] = (unsigned)(R1 + 128) * lda + C1 * 2; }
    __device__ __forceinline__ const char* b_base(const pg8::Unit& u) const { return (const char*)Bt + (size_t)u.pn * 256 * ldb; }
    __device__ __forceinline__ void epi(const f32x4 (&acc)[2][2][4][2], const pg8::Unit& u, int wr, int wc, int fr, int fq) const {
        pg8::store_tile_bf16(acc, C + (size_t)u.pm * 256 * ldc + (size_t)u.pn * 256, ldc, wr, wc, fr, fq, 256); }
};
struct PolUqUkv {
    static constexpr bool PERM = true;
    const bf16_t *CKVN, *CQN, *Wukv, *Wuq; bf16_t *KV, *QB; unsigned ldb; int nt, G, c;
    __device__ __forceinline__ bool next(int i, pg8::Unit& u) const { const long L = (long)i * G + c; if (L >= 528 + 384) return false;
        if (L < 528) { u.ex = 0; u.pm = (int)L / 8; u.pn = (int)L % 8; } else { const int q = (int)L - 528; u.ex = 1; const int pm = q / 6; u.pm = pm + 1 + (pm >= 32); u.pn = q % 6; } u.rows = 256; return true; }
    __device__ __forceinline__ const char* a_base(const pg8::Unit& u) const { return (const char*)(u.ex ? CQN : CKVN) + (size_t)u.pm * 256 * 1024; }
    __device__ __forceinline__ void a_off(const pg8::Unit&, int R0, int R1, int C0, int C1, unsigned (&o)[2][2]) const {
        o[0][0] = (unsigned)R0 * 1024u + C0 * 2; o[0][1] = (unsigned)R1 * 1024u + C1 * 2; o[1][0] = (unsigned)(R0 + 128) * 1024u + C0 * 2; o[1][1] = (unsigned)(R1 + 128) * 1024u + C1 * 2; }
    __device__ __forceinline__ const char* b_base(const pg8::Unit& u) const { return (const char*)(u.ex ? Wuq : Wukv) + (size_t)u.pn * 256 * 1024; }
    __device__ __forceinline__ void epi(const f32x4 (&acc)[2][2][4][2], const pg8::Unit& u, int wr, int wc, int fr, int fq) const {
        if (u.ex) pg8::store_tile_bf16(acc, QB + (size_t)u.pm * 256 * 1536 + (size_t)u.pn * 256, 1536, wr, wc, fr, fq, 256);
        else pg8::store_tile_bf16(acc, KV + (size_t)u.pm * 256 * 2048 + (size_t)u.pn * 256, 2048, wr, wc, fr, fq, 256); }
};
struct PolRouter {
    static constexpr bool PERM = false;
    const bf16_t* A; const bf16_t* Bt; float* C; unsigned ldb; int nt, nM, G, c; bool lat;
    __device__ __forceinline__ bool next(int i, pg8::Unit& u) const { int pm, pn; if (!pg8::static_order(nM, 4, G, c, i, pm, pn)) return false; u.pm = lat ? pm + 1 + (pm >= 32) : pm; u.pn = 0; u.ex = pn; u.rows = 256; return true; }
    __device__ __forceinline__ const char* a_base(const pg8::Unit& u) const { return (const char*)A + (size_t)u.pm * 256 * 8192 + (size_t)u.ex * 2048; }
    __device__ __forceinline__ void a_off(const pg8::Unit&, int R0, int R1, int C0, int C1, unsigned (&o)[2][2]) const {
        o[0][0] = (unsigned)R0 * 8192u + C0 * 2; o[0][1] = (unsigned)R1 * 8192u + C1 * 2; o[1][0] = (unsigned)(R0 + 128) * 8192u + C0 * 2; o[1][1] = (unsigned)(R1 + 128) * 8192u + C1 * 2; }
    __device__ __forceinline__ const char* b_base(const pg8::Unit& u) const { return (const char*)Bt + (size_t)u.ex * 2048; }
    __device__ __forceinline__ void epi(const f32x4 (&acc)[2][2][4][2], const pg8::Unit& u, int wr, int wc, int fr, int fq) const {
        float* base = C + ((size_t)u.ex * MROWS + (size_t)u.pm * 256) * 256;
#pragma unroll
        for (int ai = 0; ai < 2; ++ai)
#pragma unroll
            for (int m = 0; m < 4; ++m) { float* rowp = base + (size_t)(ai * 128 + wr * 64 + m * 16 + fr) * 256 + wc * 32 + 4 * fq;
#pragma unroll
                for (int n = 0; n < 2; ++n) *(f32x4*)(rowp + n * 16) = acc[ai][0][m][n]; }
    }
};
template <int NT_N>
__device__ __forceinline__ bool grouped_next(const LAS int* tab, int G, int c, int i, pg8::Unit& u) {
    const long L = (long)i * G + c; const int total = tab[65] * NT_N; if (L >= total) return false;
    const int tile = (int)L / NT_N; u.pn = (int)L % NT_N;
    int lo = 0, hi = 65;
    while (hi - lo > 1) { const int mid = (lo + hi) >> 1; if (tab[mid] <= tile) lo = mid; else hi = mid; }
    u.ex = lo; u.pm = tile - tab[lo]; const int rem = tab[128 + lo] - u.pm * 256; u.rows = rem < 256 ? rem : 256; return true;
}
__device__ __forceinline__ int slot_token(int slot) { return slot < NSLOT ? slot / TOPK : slot - NSLOT; }
struct PolGU {
    static constexpr bool PERM = true;
    const bf16_t* FN2; const bf16_t* W; bf16_t* H; const int* list; const LAS int* tab; unsigned ldb; int nt, G, c;
    __device__ __forceinline__ bool next(int i, pg8::Unit& u) const { return grouped_next<4>(tab, G, c, i, u); }
    __device__ __forceinline__ const char* a_base(const pg8::Unit&) const { return (const char*)FN2; }
    __device__ __forceinline__ void a_off(const pg8::Unit& u, int R0, int R1, int C0, int C1, unsigned (&o)[2][2]) const {
        const int* lp = list + (size_t)u.ex * MROWS + u.pm * 256; const int last = u.rows - 1;
        const int r00 = R0 < last ? R0 : last, r01 = R1 < last ? R1 : last, r10 = R0 + 128 < last ? R0 + 128 : last, r11 = R1 + 128 < last ? R1 + 128 : last;
        const int s00 = lp[r00], s01 = lp[r01], s10 = lp[r10], s11 = lp[r11];
        o[0][0] = (unsigned)slot_token(s00) * 8192u + C0 * 2; o[0][1] = (unsigned)slot_token(s01) * 8192u + C1 * 2; o[1][0] = (unsigned)slot_token(s10) * 8192u + C0 * 2; o[1][1] = (unsigned)slot_token(s11) * 8192u + C1 * 2; }
    __device__ __forceinline__ const char* b_base(const pg8::Unit& u) const { return (const char*)W + ((size_t)u.ex * 1024 + (size_t)u.pn * 256) * 4096; }
    __device__ __forceinline__ void epi(const f32x4 (&acc)[2][2][4][2], const pg8::Unit& u, int wr, int wc, int fr, int fq) const {
        const int* lp = list + (size_t)u.ex * MROWS + u.pm * 256;
#pragma unroll
        for (int ai = 0; ai < 2; ++ai)
#pragma unroll
            for (int m = 0; m < 4; ++m) { const int r = ai * 128 + wr * 64 + m * 16 + fr; if (r < u.rows) { const int slot = lp[r];
                const f32x4 g0 = acc[ai][0][m][0], g1 = acc[ai][0][m][1], u0 = acc[ai][1][m][0], u1 = acc[ai][1][m][1]; float h[8];
#pragma unroll
                for (int j = 0; j < 4; ++j) { h[j] = g0[j] / (1.f + __expf(-g0[j])) * u0[j]; h[4 + j] = g1[j] / (1.f + __expf(-g1[j])) * u1[j]; }
                u32x4 w; w.x = cvt_pk_bf16(h[0], h[1]); w.y = cvt_pk_bf16(h[2], h[3]); w.z = cvt_pk_bf16(h[4], h[5]); w.w = cvt_pk_bf16(h[6], h[7]);
                *(u32x4*)(H + (size_t)slot * EFF + u.pn * 128 + wc * 32 + 8 * fq) = w; } }
    }
};
struct PolDN {
    static constexpr bool PERM = true;
    const bf16_t* H; const bf16_t* W; bf16_t* YS; const int* list; const LAS int* tab; unsigned ldb; int nt, G, c;
    __device__ __forceinline__ bool next(int i, pg8::Unit& u) const { return grouped_next<8>(tab, G, c, i, u); }
    __device__ __forceinline__ const char* a_base(const pg8::Unit&) const { return (const char*)H; }
    __device__ __forceinline__ void a_off(const pg8::Unit& u, int R0, int R1, int C0, int C1, unsigned (&o)[2][2]) const {
        const int* lp = list + (size_t)u.ex * MROWS + u.pm * 256; const int last = u.rows - 1;
        const int r00 = R0 < last ? R0 : last, r01 = R1 < last ? R1 : last, r10 = R0 + 128 < last ? R0 + 128 : last, r11 = R1 + 128 < last ? R1 + 128 : last;
        o[0][0] = (unsigned)lp[r00] * 1024u + C0 * 2; o[0][1] = (unsigned)lp[r01] * 1024u + C1 * 2; o[1][0] = (unsigned)lp[r10] * 1024u + C0 * 2; o[1][1] = (unsigned)lp[r11] * 1024u + C1 * 2; }
    __device__ __forceinline__ const char* b_base(const pg8::Unit& u) const { return (const char*)W + ((size_t)u.ex * 2048 + (size_t)u.pn * 256) * 1024; }
    __device__ __forceinline__ void epi(const f32x4 (&acc)[2][2][4][2], const pg8::Unit& u, int wr, int wc, int fr, int fq) const {
        const int* lp = list + (size_t)u.ex * MROWS + u.pm * 256;
#pragma unroll
        for (int ai = 0; ai < 2; ++ai)
#pragma unroll
            for (int m = 0; m < 4; ++m) { const int r = ai * 128 + wr * 64 + m * 16 + fr; if (r < u.rows) { const int slot = lp[r]; bf16_t* rowp = YS + (size_t)slot * DM + u.pn * 256 + wc * 32 + 8 * fq;
#pragma unroll
                for (int bj = 0; bj < 2; ++bj) { const f32x4 v0 = acc[ai][bj][m][0], v1 = acc[ai][bj][m][1];
                    u32x4 w; w.x = cvt_pk_bf16(v0[0], v0[1]); w.y = cvt_pk_bf16(v0[2], v0[3]); w.z = cvt_pk_bf16(v1[0], v1[1]); w.w = cvt_pk_bf16(v1[2], v1[3]);
                    *(u32x4*)(rowp + bj * 128) = w; } } }
    }
};
__device__ __forceinline__ void build_group_table(Frame& F, const unsigned* cnt) {
    LAS int* tab = (LAS int*)(F.lds + LDS_AUX);
    if (F.tid < 65) tab[128 + F.tid] = (int)cnt[F.tid];
    __syncthreads();
    if (F.tid == 0) { int acc = 0; for (int e = 0; e < 65; ++e) { tab[e] = acc; acc += (tab[128 + e] + 255) >> 8; } tab[65] = acc; }
    __syncthreads();
}

__device__ __forceinline__ f32x16 mma32(f32x16 acc, const LAS unsigned char* A, int pa, const LAS unsigned char* B, int pb, int ksteps, int r32, int hi) {
    const LAS unsigned char* ap = A + r32 * pa + hi * 16; const LAS unsigned char* bp = B + r32 * pb + hi * 16;
    for (int ks = 0; ks < ksteps; ++ks) { const bf16x8 a = *(const LAS bf16x8*)(ap + ks * 32), b = *(const LAS bf16x8*)(bp + ks * 32);
        acc = __builtin_amdgcn_mfma_f32_32x32x16_bf16(a, b, acc, 0, 0, 0); }
    return acc;
}
constexpr int ML_VT = 0, ML_QS = 34816, ML_KS = 53248, ML_PM = 71680, ML_QD = 106496, ML_HS = 53248;
constexpr int P64 = 144, P128 = 272;
constexpr int AX_IF = 0, AX_LF = 128, AX_IB = 256, AX_LB = 384, AX_WF = 512, AX_WB = 640, AX_AF = 768, AX_MF = 896, AX_WIF = 1024, AX_EMF = 1152, AX_AB = 1280, AX_MB = 1408, AX_WIB = 1536, AX_EMB = 1664,
              AX_DEN = 1792, AX_NST = 1920  , AX_SC = 2048  ;

__device__ __forceinline__ void ml_load_gates(Frame& F, const bf16_t* Prow0, int h, LAS float* ax) {
    const int t = F.tid & 127, ty = F.tid >> 7;
    const float v = bf2f(Prow0[(size_t)t * AB_INP + C_GT + ty * 8 + h]) + F.in[I_MGB][ty * 8 + h];
    ax[ty * 128 + t] = (ty & 1) ? logsigmoidf_(v) : v;
}
__device__ __forceinline__ void ml_load_vt(Frame& F, const bf16_t* Prow0, int h) {
    const int t = F.tid >> 2, vq = F.tid & 3; const bf16_t* src = Prow0 + (size_t)t * AB_INP + C_MV + h * 128 + vq * 32;
    LAS bf16_t* VT = (LAS bf16_t*)(F.lds + ML_VT);
#pragma unroll
    for (int i = 0; i < 4; ++i) { const bf16x8 x = *(const bf16x8*)(src + i * 8);
#pragma unroll
        for (int j = 0; j < 8; ++j) VT[(vq * 32 + i * 8 + j) * (P128 / 2) + t] = (bf16_t)x[j]; }
}
__device__ __forceinline__ void mlstm_a_item(Frame& F, int b, int h, int g) {
    unsigned char* ws = F.ws; const bf16_t* Prow0 = (const bf16_t*)(ws + WS_P) + (size_t)(b * TPB + g * 128) * AB_INP;
    LAS float* ax = (LAS float*)(F.lds + LDS_AUX);
    const int r32 = F.lane & 31, hi = F.lane >> 5;
    ml_load_gates(F, Prow0, h, ax);
    ml_load_vt(F, Prow0, h);
    __syncthreads();
    if (F.tid == 0) { float s = 0.f, mx = -1e30f; for (int t = 127; t >= 0; --t) { const float w = s + ax[AX_IF + t]; ax[AX_WF + t] = w; mx = fmaxf(mx, w); s += ax[AX_LF + t]; }
        ax[AX_SC + 0] = s; ax[AX_SC + 1] = mx; for (int t = 0; t < 128; ++t) ax[AX_WF + t] = __expf(ax[AX_WF + t] - mx); }
    if (F.tid == 64) { float s = 0.f, mx = -1e30f; for (int t = 0; t < 128; ++t) { const float w = s + ax[AX_IB + t]; ax[AX_WB + t] = w; mx = fmaxf(mx, w); s += ax[AX_LB + t]; }
        ax[AX_SC + 2] = s; ax[AX_SC + 3] = mx; for (int t = 0; t < 128; ++t) ax[AX_WB + t] = __expf(ax[AX_WB + t] - mx); }
    __syncthreads();
    {
        const int t = F.tid >> 2, dq = F.tid & 3; const bf16_t* src = Prow0 + (size_t)t * AB_INP + C_MK + h * 64 + dq * 16;
        LAS bf16_t* KTf = (LAS bf16_t*)(F.lds + ML_QS); LAS bf16_t* KTb = (LAS bf16_t*)(F.lds + ML_KS);
        const float wf = ax[AX_WF + t] * 0.125f, wb = ax[AX_WB + t] * 0.125f;
#pragma unroll
        for (int i = 0; i < 2; ++i) { const bf16x8 x = *(const bf16x8*)(src + i * 8);
#pragma unroll
            for (int j = 0; j < 8; ++j) { const float k = bf2f((unsigned short)x[j]); const int d = dq * 16 + i * 8 + j;
                KTf[d * (P128 / 2) + t] = (bf16_t)f2bf(k * wf); KTb[d * (P128 / 2) + t] = (bf16_t)f2bf(k * wb); } }
    }
    __syncthreads();
    const int vb = F.wave >> 1, db = F.wave & 1;
    f32x16 cf = {}, cb = {};
    cf = mma32(cf, F.lds + ML_VT + vb * 32 * P128, P128, F.lds + ML_QS + db * 32 * P128, P128, 8, r32, hi);
    cb = mma32(cb, F.lds + ML_VT + vb * 32 * P128, P128, F.lds + ML_KS + db * 32 * P128, P128, 8, r32, hi);
    const int chf = (b * 8 + h) * 2, chb = chf + 1;
    float* dCf = (float*)(ws + WS_MDC) + ((size_t)chf * 66 + g) * 8192; float* dCb = (float*)(ws + WS_MDC) + ((size_t)chb * 66 + g) * 8192;
#pragma unroll
    for (int r = 0; r < 16; ++r) { const int v = vb * 32 + att::crow(r, hi), d = db * 32 + r32; dCf[v * 64 + d] = cf[r]; dCb[v * 64 + d] = cb[r]; }
    if (F.tid < 128) { const int dir = F.tid >> 6, d = F.tid & 63; const LAS bf16_t* kt = (const LAS bf16_t*)(F.lds + (dir ? ML_KS : ML_QS)) + d * (P128 / 2);
        float s = 0.f; for (int t = 0; t < 128; ++t) s += bf2f(kt[t]);
        ((float*)(ws + WS_MSM + MSM_DN))[((size_t)(chf + dir) * 66 + g) * 64 + d] = s; }
    if (F.tid < 2) { ((float*)(ws + WS_MSM + MSM_BTOT))[(chf + F.tid) * 66 + g] = ax[AX_SC + 2 * F.tid]; ((float*)(ws + WS_MSM + MSM_MLOC))[(chf + F.tid) * 66 + g] = ax[AX_SC + 2 * F.tid + 1]; }
    __syncthreads();
}
__device__ __forceinline__ int chain_chunk(int dir, int j) { return dir == 0 ? j : (j == 0 ? 1 : (j == 1 ? 0 : 67 - j)); }
__device__ __forceinline__ void mlstm_scan_item(Frame& F, int chain, int slice) {
    unsigned char* ws = F.ws; const int dir = chain & 1;
    const float* dC = (const float*)(ws + WS_MDC) + (size_t)chain * 66 * 8192 + slice * 1024 + F.tid * 2;
    bf16_t* cst = (bf16_t*)(ws + WS_MCST) + (size_t)chain * 66 * 8192 + slice * 1024 + F.tid * 2;
    const float* btot = (const float*)(ws + WS_MSM + MSM_BTOT) + chain * 66; const float* mloc = (const float*)(ws + WS_MSM + MSM_MLOC) + chain * 66;
    const float* dn = (const float*)(ws + WS_MSM + MSM_DN) + (size_t)chain * 66 * 64; float* nst = (float*)(ws + WS_MSM + MSM_NST) + (size_t)chain * 66 * 64; float* mst = (float*)(ws + WS_MSM + MSM_MST) + chain * 66;
    float c0 = 0.f, c1 = 0.f, n = 0.f, m = 0.f; const bool don = (slice == 0 && F.tid < 64);
#pragma unroll 6
    for (int j = 0; j < 66; ++j) { const int g = chain_chunk(dir, j);
        const f32x2 d = *(const f32x2*)(dC + (size_t)g * 8192); const float bt = btot[g], ml = mloc[g];
        *(unsigned*)(cst + (size_t)g * 8192) = cvt_pk_bf16(c0, c1);
        if (don) { nst[g * 64 + F.tid] = n; if (F.tid == 0) mst[g] = m; }
        const float mn = fmaxf(bt + m, ml), dec = __expf(bt + m - mn), sc = __expf(ml - mn);
        c0 = dec * c0 + sc * d.x; c1 = dec * c1 + sc * d.y;
        if (don) n = dec * n + sc * dn[g * 64 + F.tid];
        m = mn; }
}
__device__ __forceinline__ void mlstm_c_item(Frame& F, int b, int h, int g) {
    unsigned char* ws = F.ws; const int row0 = b * TPB + g * 128; const bf16_t* Prow0 = (const bf16_t*)(ws + WS_P) + (size_t)row0 * AB_INP;
    LAS float* ax = (LAS float*)(F.lds + LDS_AUX);
    const int r32 = F.lane & 31, hi = F.lane >> 5; const int chf = (b * 8 + h) * 2;
    ml_load_gates(F, Prow0, h, ax);
    ml_load_vt(F, Prow0, h);
    {
        const int t = F.tid >> 2, dq = F.tid & 3;
        const bf16_t* qs = Prow0 + (size_t)t * AB_INP + C_MQ + h * 64 + dq * 16; const bf16_t* ks = Prow0 + (size_t)t * AB_INP + C_MK + h * 64 + dq * 16;
#pragma unroll
        for (int i = 0; i < 2; ++i) { *(LAS bf16x8*)(F.lds + ML_QS + t * P64 + (dq * 16 + i * 8) * 2) = *(const bf16x8*)(qs + i * 8);
            const bf16x8 x = *(const bf16x8*)(ks + i * 8); u32x4 o;
#pragma unroll
            for (int j = 0; j < 4; ++j) o[j] = cvt_pk_bf16(bf2f((unsigned short)x[2 * j]) * 0.125f, bf2f((unsigned short)x[2 * j + 1]) * 0.125f);
            *(LAS u32x4*)(F.lds + ML_KS + t * P64 + (dq * 16 + i * 8) * 2) = o; }
    }
    if (F.tid < 128) ax[AX_NST + F.tid] = ((const float*)(ws + WS_MSM + MSM_NST))[((size_t)(chf + (F.tid >> 6)) * 66 + g) * 64 + (F.tid & 63)];
    __syncthreads();
    if (F.tid == 0) { const float mst = ((const float*)(ws + WS_MSM + MSM_MST))[chf * 66 + g]; float c = 0.f, amax = -1e30f;
        for (int t = 0; t < 128; ++t) { c += ax[AX_LF + t]; const float a = ax[AX_IF + t] - c; amax = fmaxf(amax, a); const float M = fmaxf(mst, amax);
            ax[AX_AF + t] = a; ax[AX_MF + t] = M; ax[AX_WIF + t] = __expf(mst - M); ax[AX_EMF + t] = __expf(-(c + M)); } }
    if (F.tid == 64) { const float mst = ((const float*)(ws + WS_MSM + MSM_MST))[(chf + 1) * 66 + g]; float c = 0.f, amax = -1e30f;
        for (int t = 127; t >= 0; --t) { c += ax[AX_LB + t]; const float a = ax[AX_IB + t] - c; amax = fmaxf(amax, a); const float M = fmaxf(mst, amax);
            ax[AX_AB + t] = a; ax[AX_MB + t] = M; ax[AX_WIB + t] = __expf(mst - M); ax[AX_EMB + t] = __expf(-(c + M)); } }
    const int qb = F.wave >> 1, sb0 = (F.wave & 1) * 2;
    f32x16 S0 = {}, S1 = {};
    S0 = mma32(S0, F.lds + ML_KS + (sb0 * 32) * P64, P64, F.lds + ML_QS + qb * 32 * P64, P64, 4, r32, hi);
    S1 = mma32(S1, F.lds + ML_KS + (sb0 * 32 + 32) * P64, P64, F.lds + ML_QS + qb * 32 * P64, P64, 4, r32, hi);
    __syncthreads();
    f32x16 H0 = {}, H1 = {};
    const int qb2 = F.wave >> 1, vb0 = (F.wave & 1) * 2;
#pragma unroll 1
    for (int dir = 0; dir < 2; ++dir) {
        const LAS float* A_ = ax + (dir ? AX_AB : AX_AF); const LAS float* M_ = ax + (dir ? AX_MB : AX_MF); const LAS float* WI_ = ax + (dir ? AX_WIB : AX_WIF); const LAS float* EM_ = ax + (dir ? AX_EMB : AX_EMF);
        {
            const int q = qb * 32 + r32; const float Mq = M_[q];
#pragma unroll
            for (int i = 0; i < 2; ++i) { const f32x16& S = i ? S1 : S0; const int sbase = (sb0 + i) * 32;
#pragma unroll
                for (int gq = 0; gq < 4; ++gq) { float p[4];
#pragma unroll
                    for (int j = 0; j < 4; ++j) { const int s = sbase + 8 * gq + 4 * hi + j; const bool keep = dir ? (s >= q) : (s <= q); p[j] = keep ? S[gq * 4 + j] * __expf(A_[s] - Mq) : 0.f; }
                    u32x2 w; w.x = cvt_pk_bf16(p[0], p[1]); w.y = cvt_pk_bf16(p[2], p[3]);
                    *(LAS u32x2*)(F.lds + ML_PM + q * P128 + (sbase + 8 * gq + 4 * hi) * 2) = w; } }
        }
        {
            const int t = F.tid >> 2, dq = F.tid & 3; const float wi = WI_[t];
            const bf16_t* cs = (const bf16_t*)(ws + WS_MCST) + ((size_t)(chf + dir) * 66 + g) * 8192 + t * 64 + dq * 16;
#pragma unroll
            for (int i = 0; i < 2; ++i) { const bf16x8 x = *(const LAS bf16x8*)(F.lds + ML_QS + t * P64 + (dq * 16 + i * 8) * 2); u32x4 o;
#pragma unroll
                for (int j = 0; j < 4; ++j) o[j] = cvt_pk_bf16(bf2f((unsigned short)x[2 * j]) * wi, bf2f((unsigned short)x[2 * j + 1]) * wi);
                *(LAS u32x4*)(F.lds + ML_QD + t * P64 + (dq * 16 + i * 8) * 2) = o;
                *(LAS bf16x8*)(F.lds + ML_KS + t * P64 + (dq * 16 + i * 8) * 2) = *(const bf16x8*)(cs + i * 8); }
        }
        __syncthreads();
        {
            const int q = F.tid >> 2, part = F.tid & 3; float s = 0.f;
            const LAS bf16_t* pr = (const LAS bf16_t*)(F.lds + ML_PM + q * P128) + part * 32;
#pragma unroll
            for (int j = 0; j < 32; ++j) s += bf2f(pr[j]);
            const LAS bf16_t* qd = (const LAS bf16_t*)(F.lds + ML_QD + q * P64) + part * 16; const LAS float* nn = ax + AX_NST + dir * 64 + part * 16;
#pragma unroll
            for (int j = 0; j < 16; ++j) s += bf2f(qd[j]) * nn[j];
            s += __shfl_xor(s, 1); s += __shfl_xor(s, 2);
            if (part == 0) ax[AX_DEN + q] = fmaxf(fabsf(s), EM_[q]);
        }
        f32x16 N0 = {}, N1 = {};
        N0 = mma32(N0, F.lds + ML_PM + qb2 * 32 * P128, P128, F.lds + ML_VT + (vb0 * 32) * P128, P128, 8, r32, hi);
        N0 = mma32(N0, F.lds + ML_QD + qb2 * 32 * P64, P64, F.lds + ML_KS + (vb0 * 32) * P64, P64, 4, r32, hi);
        N1 = mma32(N1, F.lds + ML_PM + qb2 * 32 * P128, P128, F.lds + ML_VT + (vb0 * 32 + 32) * P128, P128, 8, r32, hi);
        N1 = mma32(N1, F.lds + ML_QD + qb2 * 32 * P64, P64, F.lds + ML_KS + (vb0 * 32 + 32) * P64, P64, 4, r32, hi);
        __syncthreads();
#pragma unroll
        for (int r = 0; r < 16; ++r) { const float inv = 1.f / ax[AX_DEN + qb2 * 32 + att::crow(r, hi)]; H0[r] += N0[r] * inv; H1[r] += N1[r] * inv; }
        __syncthreads();
    }
    {   LAS float* HS = (LAS float*)(F.lds + ML_HS);
#pragma unroll
        for (int r = 0; r < 16; ++r) { const int q = qb2 * 32 + att::crow(r, hi); HS[q * 128 + vb0 * 32 + r32] = H0[r]; HS[q * 128 + vb0 * 32 + 32 + r32] = H1[r]; } }
    __syncthreads();
    {   const LAS float* HS = (const LAS float*)(F.lds + ML_HS); bf16_t* CC = (bf16_t*)(ws + WS_CC);
        const float g0 = F.in[I_MNORM][2 * F.lane], g1 = F.in[I_MNORM][2 * F.lane + 1];
        for (int i = 0; i < 16; ++i) { const int q = F.wave * 16 + i; const float x0 = HS[q * 128 + 2 * F.lane], x1 = HS[q * 128 + 2 * F.lane + 1];
            const float rs = rsqrtf(wave_sum(x0 * x0 + x1 * x1) * (1.f / 128.f) + NORM_EPS);
            const unsigned mo = *(const unsigned*)(Prow0 + (size_t)q * AB_INP + C_MO + h * 128 + 2 * F.lane);
            *(unsigned*)(CC + (size_t)(row0 + q) * DM + 1024 + h * 128 + 2 * F.lane) = cvt_pk_bf16(x0 * rs * g0 * sigmoidf_(bflo(mo)), x1 * rs * g1 * sigmoidf_(bfhi(mo))); }
    }
    __syncthreads();
}
__device__ __forceinline__ void diff_combine_row(Frame& F, int r, float lam, float oml) {
    const bf16_t* AO = (const bf16_t*)(F.ws + WS_AO) + (size_t)r * DM; bf16_t* CC = (bf16_t*)(F.ws + WS_CC) + (size_t)r * DM;
    const int h = F.lane >> 3, v0 = (F.lane & 7) * 16; float a[16]; float ss = 0.f;
#pragma unroll
    for (int i = 0; i < 2; ++i) { const u32x4 x1 = *(const u32x4*)(AO + (2 * h) * 128 + v0 + i * 8), x2 = *(const u32x4*)(AO + (2 * h + 1) * 128 + v0 + i * 8);
#pragma unroll
        for (int j = 0; j < 4; ++j) { a[i * 8 + 2 * j] = bflo(x1[j]) - lam * bflo(x2[j]); a[i * 8 + 2 * j + 1] = bfhi(x1[j]) - lam * bfhi(x2[j]); } }
#pragma unroll
    for (int j = 0; j < 16; ++j) ss += a[j] * a[j];
    ss += __shfl_xor(ss, 1); ss += __shfl_xor(ss, 2); ss += __shfl_xor(ss, 4);
    const float rs = rsqrtf(ss * (1.f / 128.f) + NORM_EPS) * oml;
#pragma unroll
    for (int i = 0; i < 2; ++i) { u32x4 o;
#pragma unroll
        for (int j = 0; j < 4; ++j) o[j] = cvt_pk_bf16(a[i * 8 + 2 * j] * rs * F.in[I_DNORM][v0 + i * 8 + 2 * j], a[i * 8 + 2 * j + 1] * rs * F.in[I_DNORM][v0 + i * 8 + 2 * j + 1]);
        *(u32x4*)(CC + h * 128 + v0 + i * 8) = o; }
}

template <int Q> __device__ __forceinline__ u32x4 rope_w4(u32x4 w, const f32x2* __restrict__ tab, int prow, int pcol, int i0) {
    u32x4 o;
#pragma unroll
    for (int q = 0; q < 4; ++q) { const int i = i0 + q; const f32x2 cs = (i < Q) ? tab[prow * Q + i] : tab[pcol * Q + (i - Q)];
        const float x1 = bflo(w[q]), x2 = bfhi(w[q]); o[q] = cvt_pk_bf16(x1 * cs.x - x2 * cs.y, x1 * cs.y + x2 * cs.x); }
    return o;
}
__device__ __forceinline__ void rope_dk_row(Frame& F, int r) {
    const int b = row_batch(r), pos = r - b * TPB; if (pos < CTXL) return; const int tok = pos - CTXL, prow = tok >> 6, pcol = tok & 63;
    bf16_t* p = (bf16_t*)(F.ws + WS_P) + (size_t)r * AB_INP + C_DK; const f32x2* tab = (const f32x2*)(F.ws + WS_ROPE);
#pragma unroll
    for (int j = 0; j < 2; ++j) { const int e = (F.lane + 64 * j) * 8; u32x4 w = *(const u32x4*)(p + e); w = rope_w4<16>(w, tab, prow, pcol, (e & 63) >> 1); *(u32x4*)(p + e) = w; }
}
__device__ __forceinline__ void post1_row(Frame& F, int r) {
    unsigned char* ws = F.ws; const bf16_t* p = (const bf16_t*)(ws + WS_P) + (size_t)r * CD_IN;
    const int b = row_batch(r), pos = r - b * TPB; const bool lat = pos >= CTXL; const int tok = pos - CTXL, prow = tok >> 6, pcol = tok & 63;
    {   float x[8]; float ss = 0.f; const bool act = F.lane < 56;
        if (act) { const u32x4 w = *(const u32x4*)(p + C_CQ + F.lane * 8);
#pragma unroll
            for (int j = 0; j < 4; ++j) { x[2 * j] = bflo(w[j]); x[2 * j + 1] = bfhi(w[j]); ss += x[2 * j] * x[2 * j] + x[2 * j + 1] * x[2 * j + 1]; } }
        const float rs = rsqrtf(wave_sum(ss) * (1.f / 448.f) + NORM_EPS); u32x4 o = {0, 0, 0, 0};
        if (act) {
#pragma unroll
            for (int j = 0; j < 4; ++j) o[j] = cvt_pk_bf16(x[2 * j] * rs * F.in[I_QNORM][F.lane * 8 + 2 * j], x[2 * j + 1] * rs * F.in[I_QNORM][F.lane * 8 + 2 * j + 1]); }
        *(u32x4*)((bf16_t*)(ws + WS_CQN) + (size_t)r * 512 + F.lane * 8) = o;
    }
    {   float x[8]; float ss = 0.f; const u32x4 w = *(const u32x4*)(p + C_CKV + F.lane * 8);
#pragma unroll
        for (int j = 0; j < 4; ++j) { x[2 * j] = bflo(w[j]); x[2 * j + 1] = bfhi(w[j]); ss += x[2 * j] * x[2 * j] + x[2 * j + 1] * x[2 * j + 1]; }
        const float rs = rsqrtf(wave_sum(ss) * (1.f / 512.f) + NORM_EPS); u32x4 o;
#pragma unroll
        for (int j = 0; j < 4; ++j) o[j] = cvt_pk_bf16(x[2 * j] * rs * F.in[I_KVNORM][F.lane * 8 + 2 * j], x[2 * j + 1] * rs * F.in[I_KVNORM][F.lane * 8 + 2 * j + 1]);
        *(u32x4*)((bf16_t*)(ws + WS_CKVN) + (size_t)r * 512 + F.lane * 8) = o;
    }
    if (F.lane < 8) { u32x4 w = *(const u32x4*)(p + C_KR + F.lane * 8); if (lat) w = rope_w4<16>(w, (const f32x2*)(ws + WS_ROPE), prow, pcol, F.lane * 4);
        *(u32x4*)((bf16_t*)(ws + WS_KR) + (size_t)r * 64 + F.lane * 8) = w; }
    if (lat && F.lane >= 32) { const int l2 = F.lane - 32; bf16_t* sk = (bf16_t*)(ws + WS_P) + (size_t)r * CD_IN + C_SK + l2 * 8;
        u32x4 w = *(const u32x4*)sk; w = rope_w4<32>(w, (const f32x2*)(ws + WS_ROPE + 65536), prow, pcol, ((l2 * 8) & 127) >> 1); *(u32x4*)sk = w; }
}
constexpr int TB = DM;
__device__ __forceinline__ const float* modf_vec(const Frame& F, int l, int v, int ch) { return (const float*)(F.ws + WS_MODF) + ((size_t)l * 3 + v) * 12288 + ch * DM; }
__device__ __forceinline__ void row_phase(Frame& F, int l) {
    LAS float* T = (LAS float*)(F.lds + LDS_SCR);
    lds_load_vec(F, T + 0 * TB, F.in[I_NMPOST] + l * DM); lds_load_vec(F, T + 1 * TB, F.in[I_NFPRE] + l * DM);
    for (int v = 0; v < 3; ++v) { lds_load_vec(F, T + (2 + v) * TB, modf_vec(F, l, v, 2)); lds_load_vec(F, T + (5 + v) * TB, modf_vec(F, l, v, 3)); lds_load_vec(F, T + (8 + v) * TB, modf_vec(F, l, v, 4)); }
    __syncthreads();
    const bf16_t* Y2 = (const bf16_t*)(F.ws + WS_Y2); float* XR = (float*)(F.ws + WS_XR); bf16_t* FN2 = (bf16_t*)(F.ws + WS_FN2);
    for (int r = F.gw; r < MROWS; r += F.NGW) {
        const int var = row_variant(r); if (l == 1 && var == 2) continue;
        f32x4 y[8], x[8]; load_row_bf16(Y2 + (size_t)r * DM, F.lane, y); load_row_f32(l == 0 ? src_row(F, r) : XR + (size_t)r * DM, F.lane, x);
        const float rs = row_rstd(y);
#pragma unroll
        for (int j = 0; j < 8; ++j) { const int c = 4 * F.lane + 256 * j; x[j] = x[j] + LV4(T + (2 + var) * TB, c) * (y[j] * rs * LV4(T, c)); *(f32x4*)(XR + (size_t)r * DM + c) = x[j]; }
        const float rs2 = row_rstd(x);
#pragma unroll
        for (int j = 0; j < 8; ++j) { const int c = 4 * F.lane + 256 * j; const f32x4 f = x[j] * rs2 * LV4(T + TB, c) * (LV4(T + (8 + var) * TB, c) + 1.f) + LV4(T + (5 + var) * TB, c);
            u32x2 hw; hw.x = cvt_pk_bf16(f.x, f.y); hw.y = cvt_pk_bf16(f.z, f.w);
            u32x2 lw; lw.x = cvt_pk_bf16(f.x - bflo(hw.x), f.y - bfhi(hw.x)); lw.y = cvt_pk_bf16(f.z - bflo(hw.y), f.w - bfhi(hw.y));
            *(u32x2*)(FN2 + (size_t)r * 4096 + c) = hw; *(u32x2*)(FN2 + (size_t)r * 4096 + 2048 + c) = lw; }
    }
}
__device__ __forceinline__ void routing_phase(Frame& F, int l) {
    unsigned char* ws = F.ws; const float* LOG4 = (const float*)(ws + WS_LOG4); int* list = (int*)(ws + WS_LIST); float* GATE = (float*)(ws + WS_GATE);
    unsigned* cnt = (unsigned*)(ws + WS_CTL) + CW_CNT + l * 128;
    LAS int* L = (LAS int*)(F.lds + LDS_SCR);
    const int chunk = (MROWS + F.G - 1) / F.G; const int r0 = F.bid * chunk, r1 = (r0 + chunk < MROWS) ? r0 + chunk : MROWS;
    LAS int* sel_e = L + 128; LAS int* sel_r = L + 128 + chunk * 6;
    if (F.tid < 128) L[F.tid] = 0;
    __syncthreads();
    const float rb = F.in[I_RB][l * 64 + F.lane];
    for (int r = r0 + F.wave; r < r1; r += 8) {
        const int var = row_variant(r); const int tl = r - r0;
        if (l == 1 && var == 2) { if (F.lane < 6) sel_e[tl * 6 + F.lane] = -1; continue; }
        float lg = 0.f;
#pragma unroll
        for (int s = 0; s < 4; ++s) { const float* p = LOG4 + ((size_t)s * MROWS + r) * 256; lg += p[F.lane] + p[64 + F.lane]; }
        const float score = 1.f / (1.f + __expf(-lg)); const float choice = score + rb;
        float m1 = choice; m1 = fmaxf(m1, __shfl_xor(m1, 1)); m1 = fmaxf(m1, __shfl_xor(m1, 2)); m1 = fmaxf(m1, __shfl_xor(m1, 4));
        const unsigned long long bm = __ballot(choice == m1); const int grp = F.lane >> 3; const unsigned gb = (unsigned)(bm >> (grp * 8)) & 0xffu; const int first = __builtin_ctz(gb);
        float c2 = ((F.lane & 7) == first) ? -1e30f : choice; c2 = fmaxf(c2, __shfl_xor(c2, 1)); c2 = fmaxf(c2, __shfl_xor(c2, 2)); c2 = fmaxf(c2, __shfl_xor(c2, 4));
        const float gs = m1 + c2; int rank = 0;
#pragma unroll
        for (int j = 0; j < 8; ++j) { const float gj = __shfl(gs, j * 8); rank += (gj > gs || (gj == gs && j < grp)) ? 1 : 0; }
        float masked = rank < 4 ? choice : -1e30f;
        int myk = -1; float ssum = 0.f; float sk_[6]; int ek_[6];
#pragma unroll
        for (int k = 0; k < 6; ++k) { const float mx = wave_max(masked); const unsigned long long bb = __ballot(masked == mx); const int e = __builtin_ctzll(bb);
            if (F.lane == e) masked = -1e30f; const float sc = __shfl(score, e); sk_[k] = sc; ek_[k] = e; ssum += sc; }
        (void)myk;
        if (F.lane < 6) { float gsel = 0.f; int esel = 0;
#pragma unroll
            for (int k = 0; k < 6; ++k) if (F.lane == k) { gsel = sk_[k]; esel = ek_[k]; }
            GATE[(size_t)r * 6 + F.lane] = gsel / ssum * 2.5f;
            const int rk = atomicAdd((int*)&L[esel], 1); sel_e[tl * 6 + F.lane] = esel; sel_r[tl * 6 + F.lane] = rk; }
    }
    __syncthreads();
    if (F.tid < 64) L[64 + F.tid] = (int)atomicAdd(&cnt[F.tid], (unsigned)L[F.tid]);
    if (F.bid == 0 && F.tid == 64) cnt[64] = (l == 0) ? MROWS : NB * SEQ;
    __syncthreads();
    for (int i = F.tid; i < (r1 - r0) * 6; i += 512) { const int e = sel_e[i]; if (e >= 0) list[(size_t)e * MROWS + L[64 + e] + sel_r[i]] = (r0 + i / 6) * 6 + (i % 6); }
    for (int r = r0 + F.tid; r < r1; r += 512) { const int b = row_batch(r), pos = r - b * TPB;
        if (l == 0) list[(size_t)64 * MROWS + r] = NSLOT + r; else if (pos >= CTXL) list[(size_t)64 * MROWS + b * SEQ + (pos - CTXL)] = NSLOT + r; }
}
__device__ __forceinline__ void combine_phase(Frame& F, int l) {
    LAS float* T = (LAS float*)(F.lds + LDS_SCR);
    lds_load_vec(F, T, F.in[I_NFPOST] + l * DM);
    for (int v = 0; v < 3; ++v) lds_load_vec(F, T + (1 + v) * TB, modf_vec(F, l, v, 5));
    if (l == 0) { lds_load_vec(F, T + 4 * TB, F.in[I_NMPRE] + DM); for (int v = 0; v < 3; ++v) { lds_load_vec(F, T + (5 + v) * TB, modf_vec(F, 1, v, 0)); lds_load_vec(F, T + (8 + v) * TB, modf_vec(F, 1, v, 1)); } }
    __syncthreads();
    const bf16_t* YS = (const bf16_t*)(F.ws + WS_YS); const float* GATE = (const float*)(F.ws + WS_GATE); float* XR = (float*)(F.ws + WS_XR); bf16_t* HN = (bf16_t*)(F.ws + WS_HN);
    for (int r = F.gw; r < MROWS; r += F.NGW) {
        const int var = row_variant(r); if (l == 1 && var == 2) continue;
        f32x4 f[8], t[8]; load_row_bf16(YS + (size_t)(NSLOT + r) * DM, F.lane, f);
#pragma unroll 1
        for (int k = 0; k < 6; ++k) { const float gk = GATE[(size_t)r * 6 + k]; load_row_bf16(YS + ((size_t)r * 6 + k) * DM, F.lane, t);
#pragma unroll
            for (int j = 0; j < 8; ++j) f[j] += t[j] * gk; }
        const float rs = row_rstd(f); load_row_f32(XR + (size_t)r * DM, F.lane, t);
#pragma unroll
        for (int j = 0; j < 8; ++j) { const int c = 4 * F.lane + 256 * j; t[j] = t[j] + LV4(T + (1 + var) * TB, c) * (f[j] * rs * LV4(T, c)); }
        if (l == 0) {
#pragma unroll
            for (int j = 0; j < 8; ++j) *(f32x4*)(XR + (size_t)r * DM + 4 * F.lane + 256 * j) = t[j];
            const float rs2 = row_rstd(t);
#pragma unroll
            for (int j = 0; j < 8; ++j) { const int c = 4 * F.lane + 256 * j; t[j] = t[j] * rs2 * LV4(T + 4 * TB, c) * (LV4(T + (8 + var) * TB, c) + 1.f) + LV4(T + (5 + var) * TB, c); }
            store_row_bf16(HN + (size_t)r * DM, F.lane, t);
        } else {
            const int b = row_batch(r), pos = r - b * TPB; float* o = F.out + ((size_t)b * SEQ + (pos - CTXL)) * DM;
#pragma unroll
            for (int j = 0; j < 8; ++j) *(f32x4*)(o + 4 * F.lane + 256 * j) = t[j];
        }
    }
}

constexpr float LOG2E = 1.4426950408889634f;
__device__ __forceinline__ void diff_attn_units(Frame& F) {
    const bf16_t* P = (const bf16_t*)(F.ws + WS_P); bf16_t* AO = (bf16_t*)(F.ws + WS_AO); const f32x2* tab = (const f32x2*)(F.ws + WS_ROPE);
    for (long L = F.bid; L < 1024 + 32; L += F.G) {
        att::UnitDesc U{}; int hh, u; const bool ctxq = L >= 1024;
        if (!ctxq) { hh = (int)(L / 256) * 8 + (int)(L % 8); u = (int)(L % 256) / 8; } else { hh = (int)L - 1024; u = 0; }
        const int b = hh >> 4, vh = hh & 15; const size_t krow0 = (size_t)b * TPB, qrow0 = ctxq ? krow0 : krow0 + CTXL + 256 * u;
        U.Q = P + qrow0 * AB_INP + C_DQ + vh * 64; U.ldq = AB_INP; U.K = P + krow0 * AB_INP + C_DK + vh * 64; U.ldk = AB_INP; U.K2 = nullptr; U.ldk2 = 0;
        U.V = P + krow0 * AB_INP + C_DV + (vh >> 1) * 128; U.ldv = AB_INP; U.O = AO + qrow0 * DM + vh * 128; U.ldo = DM;
        U.NT = ctxq ? 4 : 132; U.C = 0.125f * LOG2E; U.rope = ctxq ? nullptr : tab; U.qtok0 = 256 * u; U.seg_tiles = 0; U.seg2_row0 = 0; U.ktok0 = 0; U.sink_l2 = 0.f;
        att::attn_unit<0>(U, F.ldsg + LDS_SCR);
    }
}
__device__ __forceinline__ void mla_units(Frame& F) {
    const bf16_t* QB = (const bf16_t*)(F.ws + WS_QB); const bf16_t* KV = (const bf16_t*)(F.ws + WS_KV); const bf16_t* KR = (const bf16_t*)(F.ws + WS_KR); bf16_t* CC = (bf16_t*)(F.ws + WS_CC);
    const f32x2* tab = (const f32x2*)(F.ws + WS_ROPE);
    for (long L = F.bid; L < 512; L += F.G) {
        att::UnitDesc U{}; const int hh = (int)(L / 256) * 8 + (int)(L % 8), u = (int)(L % 256) / 8; const int b = hh >> 3, h = hh & 7;
        const size_t krow0 = (size_t)b * TPB, qrow0 = krow0 + CTXL + 256 * u;
        U.Q = QB + qrow0 * 1536 + h * 192; U.ldq = 1536; U.K = KV + krow0 * 2048 + h * 256; U.ldk = 2048; U.K2 = KR + krow0 * 64; U.ldk2 = 64;
        U.V = KV + krow0 * 2048 + h * 256 + 128; U.ldv = 2048; U.O = CC + qrow0 * DM + h * 128; U.ldo = DM;
        U.NT = 132; U.C = 0.07216878364870322f * LOG2E; U.rope = tab; U.qtok0 = 256 * u; U.seg_tiles = 0; U.seg2_row0 = 0; U.ktok0 = 0; U.sink_l2 = 0.f;
        att::attn_unit<1>(U, F.ldsg + LDS_SCR);
    }
}
__device__ __forceinline__ void swa_units(Frame& F) {
    const bf16_t* P1 = (const bf16_t*)(F.ws + WS_P); bf16_t* CC = (bf16_t*)(F.ws + WS_CC); const f32x2* tab = (const f32x2*)(F.ws + WS_ROPE + 65536);
    for (long L = F.bid; L < 512; L += F.G) {
        att::UnitDesc U{}; const int hh = (int)(L / 256) * 8 + (int)(L % 8), u = (int)(L % 256) / 8; const int b = hh >> 3, h = hh & 7, g = h >> 2;
        const size_t krow0 = (size_t)b * TPB, qrow0 = krow0 + CTXL + 256 * u;
        const int tok0 = (256 * u - 128) > 0 ? (256 * u - 128) : 0, tok1 = (256 * u + 384) < SEQ ? (256 * u + 384) : SEQ;
        U.Q = P1 + qrow0 * CD_IN + C_SQ + h * 128; U.ldq = CD_IN; U.K = P1 + krow0 * CD_IN + C_SK + g * 128; U.ldk = CD_IN; U.K2 = nullptr; U.ldk2 = 0;
        U.V = P1 + krow0 * CD_IN + C_SV + g * 128; U.ldv = CD_IN; U.O = CC + qrow0 * DM + 1024 + h * 128; U.ldo = DM;
        U.NT = 4 + (tok1 - tok0) / 64; U.C = 0.08838834764831845f * LOG2E; U.rope = tab; U.qtok0 = 256 * u; U.seg_tiles = 4; U.seg2_row0 = CTXL + tok0; U.ktok0 = tok0; U.sink_l2 = F.in[I_SINK][h] * LOG2E;
        att::attn_unit<2>(U, F.ldsg + LDS_SCR);
    }
}

constexpr int N_PHASES = 24;
__global__ void __launch_bounds__(512, 2) mk_fwd(Args args) {
    extern __shared__ __attribute__((aligned(16))) unsigned char lds_raw[];
    Frame F;
    F.lds = (LAS unsigned char*)lds_raw; F.ldsg = (char*)lds_raw; F.ws = args.ws; F.in = (const float* const*)__builtin_amdgcn_kernarg_segment_ptr()  ; F.out = args.out;
    F.tid = threadIdx.x; F.lane = F.tid & 63; F.wave = __builtin_amdgcn_readfirstlane(F.tid >> 6); F.G = gridDim.x; F.bid = blockIdx.x; F.gw = F.bid * 8 + F.wave; F.NGW = F.G * 8;
    unsigned* ctl = (unsigned*)(F.ws + WS_CTL);
    for (int u = F.tid; u < (LDS_BYTES - LDS_CTL) / 4; u += 512) ((LAS unsigned*)(F.lds + LDS_CTL))[u] = 0u;
    __syncthreads();
    XcdBarrier bar; bar.bar = ctl + CW_BAR; bar.x = 0; bar.st = nullptr;
    const bool one = (args.ph_hi - args.ph_lo) > 1;
    if (one) bar = xcd_barrier_post(ctl + CW_BAR, (volatile LAS unsigned*)(F.lds + LDS_CTL));
    const int lo = args.ph_lo, hi = args.ph_hi;
#ifndef ONLY
#define ONLY -1
#endif
#define IN(k) ((ONLY < 0 || ONLY == (k)) && lo <= (k) && (k) < hi)
#define INM(j) ((ONLY < 0 || ONLY == 7 + (j)) && lo <= (pb + (j)) && (pb + (j)) < hi)
#define FREF() do { int t_ = threadIdx.x; asm volatile("" : "+v"(t_)); F.tid = t_; F.lane = t_ & 63; F.wave = __builtin_amdgcn_readfirstlane(t_ >> 6); F.gw = F.bid * 8 + F.wave; } while (0)
#define SEAM(k) do { if (lo <= (k) && (k) + 1 < hi) xcd_barrier(bar); } while (0)
    unsigned char* ws = F.ws;
    if (IN(0)) { asm volatile("; PHASE_MARK 0"); FREF(); p0_prologue(F); } SEAM(0);
    if (IN(1)) { asm volatile("; PHASE_MARK 1"); FREF(); p1_norm0(F); } SEAM(1);
#define MOE_LAYER(l, pb) do { \
        if (INM(0)) { asm volatile("; PHASE_MARK M0"); FREF(); row_phase(F, l); } SEAM(pb); \
        if (INM(1)) { asm volatile("; PHASE_MARK M1"); FREF(); PolRouter p{(const bf16_t*)(ws + WS_FN2), (const bf16_t*)(ws + WS_WRT) + (size_t)(l) * 256 * 4096, (float*)(ws + WS_LOG4), 8192, 16, (l) == 0 ? NTILE_M : 64, F.G, F.bid, (l) == 1}; \
            pg8::gemm_phase(F.lds + LDS_SCR, p); } SEAM(pb + 1); \
        if (INM(2)) { asm volatile("; PHASE_MARK M2"); FREF(); routing_phase(F, l); } SEAM(pb + 2); \
        if (INM(3)) { asm volatile("; PHASE_MARK M3"); FREF(); build_group_table(F, ctl + CW_CNT + (l) * 128); \
            PolGU p{(const bf16_t*)(ws + WS_FN2), (const bf16_t*)(ws + WS_WGU) + (size_t)(l) * 65 * 1024 * 2048, (bf16_t*)(ws + WS_H), (const int*)(ws + WS_LIST), (const LAS int*)(F.lds + LDS_AUX), 4096, 32, F.G, F.bid}; \
            pg8::gemm_phase(F.lds + LDS_SCR, p); } SEAM(pb + 3); \
        if (INM(4)) { asm volatile("; PHASE_MARK M4"); FREF(); build_group_table(F, ctl + CW_CNT + (l) * 128); \
            PolDN p{(const bf16_t*)(ws + WS_H), (const bf16_t*)(ws + WS_WDN) + (size_t)(l) * 65 * 2048 * 512, (bf16_t*)(ws + WS_YS), (const int*)(ws + WS_LIST), (const LAS int*)(F.lds + LDS_AUX), 1024, 8, F.G, F.bid}; \
            pg8::gemm_phase(F.lds + LDS_SCR, p); } SEAM(pb + 4); \
        if (INM(5)) { asm volatile("; PHASE_MARK M5"); FREF(); combine_phase(F, l); } } while (0)
    if (IN(2)) { asm volatile("; PHASE_MARK 2"); FREF(); PolPlain p{(const bf16_t*)(ws + WS_HN), (const bf16_t*)(ws + WS_WABIN), (bf16_t*)(ws + WS_P), DM * 2, DM * 2, AB_INP, DM / 64, NTILE_M, AB_INP / 256, F.G, F.bid, false};
        pg8::gemm_phase(F.lds + LDS_SCR, p); } SEAM(2);
    if (IN(3)) { asm volatile("; PHASE_MARK 3"); FREF(); for (int r = F.gw; r < MROWS; r += F.NGW) rope_dk_row(F, r);
        for (int it = F.bid; it < NB * 8 * 66; it += F.G) { const int g = it % 66, bh = it / 66; mlstm_a_item(F, bh >> 3, bh & 7, g); } } SEAM(3);
    if (IN(4)) { asm volatile("; PHASE_MARK 4"); FREF(); for (int it = F.bid; it < 32 * 8; it += F.G) mlstm_scan_item(F, it >> 3, it & 7);
        diff_attn_units(F); } SEAM(4);
    if (IN(5)) { asm volatile("; PHASE_MARK 5"); FREF(); const float* lv = F.in[I_DLAM]; float s01 = 0.f, s23 = 0.f; for (int i = 0; i < 64; ++i) { s01 += lv[i] * lv[64 + i]; s23 += lv[128 + i] * lv[192 + i]; }
        const float lam_init = 0.2f, lam = __expf(s01) - __expf(s23) + lam_init;
        for (int r = F.gw; r < MROWS; r += F.NGW) diff_combine_row(F, r, lam, 1.f - lam_init);
        for (int it = F.bid; it < NB * 8 * 66; it += F.G) { const int g = it % 66, bh = it / 66; mlstm_c_item(F, bh >> 3, bh & 7, g); } } SEAM(5);
    if (IN(6)) { asm volatile("; PHASE_MARK 6"); FREF(); PolPlain p{(const bf16_t*)(ws + WS_CC), (const bf16_t*)(ws + WS_WABOUT), (bf16_t*)(ws + WS_Y2), DM * 2, DM * 2, DM, DM / 64, NTILE_M, DM / 256, F.G, F.bid, false};
        pg8::gemm_phase(F.lds + LDS_SCR, p); } SEAM(6);
    { constexpr int pb = 7; MOE_LAYER(0, pb); } SEAM(12);
    if (IN(13)) { asm volatile("; PHASE_MARK 13"); FREF(); PolPlain p{(const bf16_t*)(ws + WS_HN), (const bf16_t*)(ws + WS_WCDIN), (bf16_t*)(ws + WS_P), DM * 2, DM * 2, CD_IN, DM / 64, NTILE_M, CD_IN / 256, F.G, F.bid, false};
        pg8::gemm_phase(F.lds + LDS_SCR, p); } SEAM(13);
    if (IN(14)) { asm volatile("; PHASE_MARK 14"); FREF(); for (int r = F.gw; r < MROWS; r += F.NGW) post1_row(F, r); } SEAM(14);
    if (IN(15)) { asm volatile("; PHASE_MARK 15"); FREF(); PolUqUkv p{(const bf16_t*)(ws + WS_CKVN), (const bf16_t*)(ws + WS_CQN), (const bf16_t*)(ws + WS_WUKV), (const bf16_t*)(ws + WS_WUQ), (bf16_t*)(ws + WS_KV), (bf16_t*)(ws + WS_QB), 1024, 8, F.G, F.bid};
        pg8::gemm_phase(F.lds + LDS_SCR, p); } SEAM(15);
    if (IN(16)) { asm volatile("; PHASE_MARK 16"); FREF();
#ifndef NO_MLA
        mla_units(F);
#endif
#ifndef NO_SWA
        swa_units(F);
#endif
    } SEAM(16);
    if (IN(17)) { asm volatile("; PHASE_MARK 17"); FREF(); PolPlain p{(const bf16_t*)(ws + WS_CC), (const bf16_t*)(ws + WS_WCDOUT), (bf16_t*)(ws + WS_Y2), DM * 2, DM * 2, DM, DM / 64, 64, DM / 256, F.G, F.bid, true};
        pg8::gemm_phase(F.lds + LDS_SCR, p); } SEAM(17);
    { constexpr int pb = 18; MOE_LAYER(1, pb); }
#undef IN
#undef INM
#undef SEAM
#undef MOE_LAYER
#undef FREF
}

extern "C" void kernel_launch(void* const* d_in, const int* in_sizes, int n_in, void* d_out, int out_size, void* d_ws, size_t ws_size, hipStream_t stream) {
    static int grid = 0;
    if (grid == 0) {
        if (n_in != 31 || ws_size < WS_END) { fprintf(stderr, "kernel_launch: unexpected n_in %d or ws_size %zu (< %zu)\n", n_in, ws_size, (size_t)WS_END); grid = -1; return; }
        int dev = 0, cus = 0, per_cu = 0;
        if (hipGetDevice(&dev) != hipSuccess || hipDeviceGetAttribute(&cus, hipDeviceAttributeMultiprocessorCount, dev) != hipSuccess) { grid = -1; return; }
        if (hipFuncSetAttribute((const void*)mk_fwd, hipFuncAttributeMaxDynamicSharedMemorySize, LDS_BYTES) != hipSuccess) { fprintf(stderr, "kernel_launch: hipFuncSetAttribute failed\n"); grid = -1; return; }
        if (hipOccupancyMaxActiveBlocksPerMultiprocessor(&per_cu, (const void*)mk_fwd, 512, LDS_BYTES) != hipSuccess || per_cu < 1) { fprintf(stderr, "kernel_launch: occupancy query says %d\n", per_cu); }
        (void)hipGetLastError();
        grid = cus;
    }
    if (grid < 0) return;
    (void)hipMemsetAsync((char*)d_ws + WS_CTL, 0, CTL_ZERO_BYTES, stream);
    Args a{};
    for (int i = 0; i < 31; ++i) a.in[i] = (const float*)d_in[i];
    a.out = (float*)d_out; a.ws = (unsigned char*)d_ws;
#if MK_N_LAUNCHES == 1
    a.ph_lo = 0; a.ph_hi = N_PHASES;
    hipLaunchKernelGGL(mk_fwd, dim3(grid), dim3(512), LDS_BYTES, stream, a);
#else
    for (int k = 0; k < N_PHASES; ++k) { a.ph_lo = k; a.ph_hi = k + 1; hipLaunchKernelGGL(mk_fwd, dim3(grid), dim3(512), LDS_BYTES, stream, a); }
#endif
    const hipError_t le = hipPeekAtLastError();
    if (le != hipSuccess) fprintf(stderr, "kernel_launch: launch failed: %s\n", hipGetErrorName(le));
}
```

```cpp
#include <hip/hip_runtime.h>
#include <stdint.h>
#include <stdio.h>

#define LAS __attribute__((address_space(3)))
#define GAS __attribute__((address_space(1)))
#ifndef GEMM_STAGGER_US
#define GEMM_STAGGER_US 0
#endif
#ifndef MK_N_LAUNCHES
#define MK_N_LAUNCHES 1
#endif

typedef unsigned short bf16_t;
typedef short bf16x8 __attribute__((ext_vector_type(8)));
typedef short s16x4 __attribute__((ext_vector_type(4)));
typedef float f32x2 __attribute__((ext_vector_type(2)));
typedef float f32x4 __attribute__((ext_vector_type(4)));
typedef float f32x16 __attribute__((ext_vector_type(16)));
typedef unsigned u32x4 __attribute__((ext_vector_type(4)));
typedef unsigned u32x2 __attribute__((ext_vector_type(2)));
typedef int v4i_t __attribute__((ext_vector_type(4)));
typedef int v8i_t __attribute__((ext_vector_type(8)));

constexpr int DM = 2048, NB = 2, SEQ = 8192, CTXL = 256, TPB = CTXL + SEQ  , MROWS = NB * TPB  ;
constexpr int NTILE_M = MROWS / 256;
constexpr int AB_IN = 6176, AB_INP = 6400, CD_IN = 2560;
constexpr int NEXP = 64, TOPK = 6, EFF = 512;
constexpr int NSLOT = MROWS * TOPK;
constexpr int NSLOT_ALL = NSLOT + MROWS;
constexpr float NORM_EPS = 1e-6f;
constexpr int C_DQ = 0, C_DK = 1024, C_DV = 2048, C_MQ = 3072, C_MK = 3584, C_MV = 4096, C_MO = 5120, C_GT = 6144;
constexpr int C_CQ = 0, C_CKV = 448, C_KR = 960, C_SQ = 1024, C_SK = 2048, C_SV = 2304;

constexpr size_t MiB = 1u << 20;
constexpr size_t WS_CTL = 0, CTL_ZERO_BYTES = 128 * 1024;
constexpr size_t WS_MODP = 1930 * MiB;
constexpr size_t WS_MODF = 4 * MiB;
constexpr size_t WS_ROPE = 5 * MiB;
constexpr size_t WS_WABIN = 6 * MiB, WS_WABOUT = 31 * MiB, WS_WCDIN = 39 * MiB, WS_WCDOUT = 49 * MiB, WS_WUQ = 57 * MiB, WS_WUKV = 59 * MiB, WS_WRT = 61 * MiB;
constexpr size_t WS_WGU = 65 * MiB;
constexpr size_t WS_WDN = 585 * MiB;
constexpr size_t WS_XR = 845 * MiB;
constexpr size_t WS_HN = 977 * MiB;
constexpr size_t WS_Y2 = 1043 * MiB;
constexpr size_t WS_REG = 1109 * MiB;
constexpr size_t WS_P = WS_REG;
constexpr size_t WS_AO = WS_P + 207 * MiB;
constexpr size_t WS_CC = WS_AO + 66 * MiB;
constexpr size_t WS_MDC = WS_CC + 66 * MiB;
constexpr size_t WS_MCST = WS_MDC + 66 * MiB;
constexpr size_t WS_MSM = WS_MCST + 33 * MiB;
constexpr size_t WS_QB = WS_MSM + 2 * MiB;
constexpr size_t WS_KV = WS_QB + 50 * MiB;
constexpr size_t WS_CQN = WS_KV + 66 * MiB;
constexpr size_t WS_CKVN = WS_CQN + 17 * MiB;
constexpr size_t WS_KR = WS_CKVN + 17 * MiB;
constexpr size_t WS_A_END = WS_KR + 3 * MiB;
constexpr size_t WS_PART = WS_REG + 560 * MiB;
constexpr size_t WS_FN2 = WS_REG;
constexpr size_t WS_LOG4 = WS_FN2 + 132 * MiB;
constexpr size_t WS_LIST = WS_LOG4 + 66 * MiB;
constexpr size_t WS_GATE = WS_LIST + 5 * MiB;
constexpr size_t WS_H = WS_GATE + 1 * MiB;
constexpr size_t WS_YS = WS_H + 116 * MiB;
constexpr size_t WS_FN8 = WS_YS + 462 * MiB;
constexpr size_t WS_B_END = WS_FN8 + 33 * MiB;
constexpr size_t WS_END = 1936 * MiB;
static_assert(WS_A_END <= 1930 * MiB && WS_B_END <= 1930 * MiB, "stage regions below the modulation partials");
constexpr size_t MSM_DN = 0;
constexpr size_t MSM_NST = 32 * 66 * 64 * 4;
constexpr size_t MSM_MLOC = 2 * 32 * 66 * 64 * 4;
constexpr size_t MSM_BTOT = MSM_MLOC + 32 * 66 * 4;
constexpr size_t MSM_MST = MSM_BTOT + 32 * 66 * 4;

constexpr int CW_TMO = 0;
constexpr int CW_BAR = 4096;
constexpr int CW_CNT = 16384;

constexpr int LDS_SCR = 0;
constexpr int LDS_AUX = 131072;
constexpr int LDS_CTL = 155648;
constexpr int LDS_BYTES = 155904;

__device__ __forceinline__ unsigned cvt_pk_bf16(float lo, float hi) { unsigned r; asm volatile("v_cvt_pk_bf16_f32 %0, %1, %2" : "=v"(r) : "v"(lo), "v"(hi)); return r; }
__device__ __forceinline__ unsigned f2bf(float f) { unsigned u = __builtin_bit_cast(unsigned, f); return (u + 0x7fffu + ((u >> 16) & 1u)) >> 16; }
__device__ __forceinline__ float bf2f(unsigned b) { return __builtin_bit_cast(float, b << 16); }
__device__ __forceinline__ float bflo(unsigned w) { return __builtin_bit_cast(float, w << 16); }
__device__ __forceinline__ float bfhi(unsigned w) { return __builtin_bit_cast(float, w & 0xffff0000u); }
__device__ __forceinline__ float wave_sum(float v) {
#pragma unroll
    for (int o = 1; o < 64; o <<= 1) v += __shfl_xor(v, o);
    return v;
}
__device__ __forceinline__ float wave_max(float v) {
#pragma unroll
    for (int o = 1; o < 64; o <<= 1) v = fmaxf(v, __shfl_xor(v, o));
    return v;
}
__device__ __forceinline__ float clamp8(float x) { return __builtin_amdgcn_fmed3f(x, -448.f, 448.f); }
__device__ __forceinline__ float sigmoidf_(float x) { return 1.f / (1.f + __expf(-x)); }
__device__ __forceinline__ float logsigmoidf_(float x) { return fminf(x, 0.f) - log1pf(__expf(-fabsf(x))); }
#define LDS_WAIT() asm volatile("s_waitcnt lgkmcnt(0)" ::: "memory")
#define VM_WAIT() asm volatile("s_waitcnt vmcnt(0)" ::: "memory")

#define XB_TMO      128
#define XB_XCNT(j)  (256  + 64 * (j))
#define XB_XSUB(j)  (1280 + 64 * (j))
#define XB_XGEN(j)  (2304 + 64 * (j))
#define XB_TOP      3328
#define XB_TOPGEN   3392
#define XCD_BAR_WORDS 3456
#define XB_SPIN_CAP (1u << 20)
__device__ __forceinline__ unsigned xb_ld(unsigned* p)              { return __hip_atomic_load(p, __ATOMIC_RELAXED, __HIP_MEMORY_SCOPE_AGENT); }
__device__ __forceinline__ unsigned xb_add(unsigned* p, unsigned v) { return __hip_atomic_fetch_add(p, v, __ATOMIC_RELAXED, __HIP_MEMORY_SCOPE_AGENT); }
__device__ __forceinline__ unsigned xb_xcc_id() { return (unsigned)__builtin_amdgcn_s_getreg((3 << 11) | 20) & 0xFu; }
#define XB_SPIN(cond, bar) do { unsigned _sp = 0; while (cond) { __builtin_amdgcn_s_sleep(1); \
    if ((++_sp & 255u) == 0u) { if (xb_ld(&(bar)[XB_TMO])) break; if (_sp > XB_SPIN_CAP) { atomicAdd(&(bar)[XB_TMO], 1u); break; } } } } while (0)
struct XcdBarrier { unsigned* bar; unsigned x; volatile LAS unsigned* st; };
__device__ __forceinline__ XcdBarrier xcd_barrier_post(unsigned* bar, volatile LAS unsigned* st) {
    XcdBarrier b; b.bar = bar; b.x = xb_xcc_id(); b.st = st;
    if (threadIdx.x == 0) (void)xb_add(&bar[XB_XCNT(b.x)], 1u);
    return b;
}
__device__ __forceinline__ void xcd_barrier_complete(unsigned* bar, unsigned x, unsigned& nloc, unsigned& nx) {
    const unsigned G = gridDim.x * gridDim.y * gridDim.z;
    unsigned sum, cnt, mine, sp = 0u;
    for (;;) {
        sum = 0u; cnt = 0u; mine = 0u;
#pragma unroll
        for (unsigned j = 0; j < 16; ++j) { const unsigned c = xb_ld(&bar[XB_XCNT(j)]); sum += c; cnt += (c > 0u) ? 1u : 0u; mine = (j == x) ? c : mine; }
        if (sum == G) break;
        __builtin_amdgcn_s_sleep(1);
        if ((++sp & 255u) == 0u) { if (xb_ld(&bar[XB_TMO])) break; if (sp > XB_SPIN_CAP) { atomicAdd(&bar[XB_TMO], 1u); break; } }
    }
    nloc = mine > 0u ? mine : 1u; nx = cnt > 0u ? cnt : 1u;
}
__device__ __forceinline__ void xcd_barrier(const XcdBarrier& b) {
    asm volatile("s_waitcnt vmcnt(0)" ::: "memory");
    __syncthreads();
    if (threadIdx.x == 0) {
        unsigned* bar = b.bar;
        __builtin_amdgcn_s_waitcnt(0);
        unsigned nloc = b.st[0], nx = b.st[1];
        if (nloc == 0u) { xcd_barrier_complete(bar, b.x, nloc, nx); b.st[0] = nloc; b.st[1] = nx; }
        const unsigned old = xb_add(&bar[XB_XSUB(b.x)], 1u);
        const unsigned gen = old / nloc;
        if (old + 1u == (gen + 1u) * nloc) {
            __builtin_amdgcn_fence(__ATOMIC_RELEASE, "agent");
            asm volatile("s_waitcnt vmcnt(0)" ::: "memory");
            const unsigned og = xb_add(&bar[XB_TOP], 1u);
            const unsigned tg = og / nx;
            if (og + 1u == (tg + 1u) * nx) xb_add(&bar[XB_TOPGEN], 1u);
            else XB_SPIN(xb_ld(&bar[XB_TOPGEN]) == tg, bar);
            __builtin_amdgcn_fence(__ATOMIC_ACQUIRE, "agent");
            xb_add(&bar[XB_XGEN(b.x)], 1u);
            asm volatile("s_waitcnt vmcnt(0)" ::: "memory");
        } else {
            XB_SPIN(xb_ld(&bar[XB_XGEN(b.x)]) == gen, bar);
            __builtin_amdgcn_fence(__ATOMIC_ACQUIRE, "agent");
            asm volatile("s_waitcnt vmcnt(0)" ::: "memory");
        }
    }
    __syncthreads();
}

#ifndef GEMM_SP2_
#define GEMM_SP2_ true
#endif
#ifndef GEMM_ALIGN_
#define GEMM_ALIGN_ true
#endif
namespace pg8 {
constexpr bool GEMM_SP2 = GEMM_SP2_, GEMM_ALIGN = GEMM_ALIGN_;
constexpr int BM = 256, BK = 64, HALF = 128, HTB = HALF * BK * 2, STAGE_BYTES = 8 * HTB;
__host__ __device__ __forceinline__ int lds_byte(int r, int c) { const int st = (r >> 4) * 2 + (c >> 5), rr = r & 15, cc = c & 31, ob = rr * 64 + cc * 2; return st * 1024 + (ob ^ (((ob >> 9) & 1) << 5)); }
__host__ __device__ __forceinline__ void stage_rc(int b, int& R, int& C) { const int st = b / 1024, sb = b % 1024, swz = sb ^ (((sb >> 9) & 1) << 5); R = (st >> 1) * 16 + swz / 64; C = (st & 1) * 32 + (swz % 64) / 2; }
__host__ __device__ __forceinline__ int perm32(int rho) { const int n = rho >> 4, i = rho & 15; return 8 * (i >> 2) + 4 * n + (i & 3); }
__host__ __device__ __forceinline__ int perm64(int rho) { const int n = rho >> 4, i = rho & 15; return 16 * (i >> 2) + 4 * n + (i & 3); }

struct Unit { int pm, pn, ex, rows, idx; };

template <class P>
__device__ __forceinline__ void gemm_phase(LAS unsigned char* lds, const P& pol) {
    int tid_ = threadIdx.x; asm volatile("" : "+v"(tid_));
    const int tid = tid_, wid = __builtin_amdgcn_readfirstlane(tid >> 6), lane = tid & 63, wr = wid >> 2, wc = wid & 3, fr = lane & 15, fq = lane >> 4;
    const int nt = pol.nt;
    int R0, C0, R1, C1; stage_rc(tid * 16, R0, C0); stage_rc(tid * 16 + 8192, R1, C1);
    unsigned voffB[2];
    { const int Rb0 = P::PERM16 ? (64 * (R0 >> 5) + perm64(R0 & 31)) : P::PERM ? ((R0 & ~31) + perm32(R0 & 31)) : R0, Rb1 = P::PERM16 ? (64 * (R1 >> 5) + perm64(R1 & 31)) : P::PERM ? ((R1 & ~31) + perm32(R1 & 31)) : R1;
      voffB[0] = (unsigned)Rb0 * pol.ldb + (unsigned)C0 * 2u; voffB[1] = (unsigned)Rb1 * pol.ldb + (unsigned)C1 * 2u; }
    const size_t kstep = (size_t)(BK * 2);
    const size_t hstepB = (size_t)(P::PERM16 ? 8 : HALF) * pol.ldb;
    const unsigned ldsw = (unsigned)wid * 1024u;
    const int aoff = lds_byte(wr * 64 + fr, fq * 8), boff = lds_byte(wc * 32 + fr, fq * 8);
#define PG8_SA(b, h) (((b) * 2 + (h)) * HTB)
#define PG8_SB(b, h) ((4 + (b) * 2 + (h)) * HTB)
#define PG8_STAGEB(bufoff, gbase) do { _Pragma("unroll") for (int _i = 0; _i < 2; ++_i) \
        __builtin_amdgcn_global_load_lds((const unsigned*)((const char*)(gbase) + voffB[_i]), (LAS unsigned*)(lds + (bufoff) + ldsw + _i * 8192), 16, 0, 0); } while (0)
#define PG8_STAGEA(bufoff, gbase, o0, o1) do { \
        __builtin_amdgcn_global_load_lds((const unsigned*)((const char*)(gbase) + (o0)), (LAS unsigned*)(lds + (bufoff) + ldsw), 16, 0, 0); \
        __builtin_amdgcn_global_load_lds((const unsigned*)((const char*)(gbase) + (o1)), (LAS unsigned*)(lds + (bufoff) + ldsw + 8192), 16, 0, 0); } while (0)
#define PG8_LDA(dst, b, h) do { _Pragma("unroll") for (int m = 0; m < 4; ++m) _Pragma("unroll") for (int k = 0; k < 2; ++k) dst[m][k] = *(const LAS bf16x8*)(lds + PG8_SA(b, h) + aoff + m * 2048 + k * 1024); } while (0)
#define PG8_LDB(dst, b, h) do { _Pragma("unroll") for (int n = 0; n < 2; ++n) _Pragma("unroll") for (int k = 0; k < 2; ++k) dst[n][k] = *(const LAS bf16x8*)(lds + PG8_SB(b, h) + boff + n * 2048 + k * 1024); } while (0)
#define PG8_CAT(x) __builtin_shufflevector(__builtin_bit_cast(v4i_t, (x)[0]), __builtin_bit_cast(v4i_t, (x)[1]), 0, 1, 2, 3, 4, 5, 6, 7)
#define PG8_MMA(ai, bj, At, Bt) do { __builtin_amdgcn_s_setprio(1); \
        if constexpr (P::FP8) {   \
            _Pragma("unroll") for (int m = 0; m < 4; ++m) _Pragma("unroll") for (int n = 0; n < 2; ++n) { const v8i_t bq = PG8_CAT(Bt[n]), aq = PG8_CAT(At[m]); \
                  \
                asm volatile("v_mfma_scale_f32_16x16x128_f8f6f4 %0, %1, %2, %0, %3, %4 op_sel_hi:[0,0,0]" : "+v"(acc[ai][bj][m][n]) : "v"(bq), "v"(aq), "v"(sc_w), "v"(sc_x)); } } \
        else { _Pragma("unroll") for (int m = 0; m < 4; ++m) _Pragma("unroll") for (int n = 0; n < 2; ++n) _Pragma("unroll") for (int k = 0; k < 2; ++k) \
            acc[ai][bj][m][n] = __builtin_amdgcn_mfma_f32_16x16x32_bf16(Bt[n][k], At[m][k], acc[ai][bj][m][n], 0, 0, 0); } \
        __builtin_amdgcn_s_setprio(0); } while (0)
#define PG8_WAIT_V(n) asm volatile("s_waitcnt vmcnt(" #n ")" ::: "memory")
#define PG8_WAIT_L(n) asm volatile("s_waitcnt lgkmcnt(" #n ")" ::: "memory")
#define PG8_BAR __builtin_amdgcn_s_barrier()
#define PG8_SCHED __builtin_amdgcn_sched_barrier(0)
    Unit cur, nxt; int ui = 0;
    if (!pol.next(0, cur)) return;
#if GEMM_STAGGER_US > 0
    {
        const unsigned long long t0 = __builtin_amdgcn_s_memrealtime(); const unsigned long long d = (unsigned long long)((blockIdx.x >> 3) & 7) * (GEMM_STAGGER_US * 100);
        while (__builtin_amdgcn_s_memrealtime() - t0 < d) __builtin_amdgcn_s_sleep(8);
    }
#endif
    f32x4 acc[2][2][4][2];
#pragma unroll
    for (int a = 0; a < 2; ++a)
#pragma unroll
        for (int b = 0; b < 2; ++b)
#pragma unroll
            for (int m = 0; m < 4; ++m)
#pragma unroll
                for (int n = 0; n < 2; ++n) acc[a][b][m][n] = (f32x4){0.f, 0.f, 0.f, 0.f};
    bf16x8 At[4][2], B0[2][2], B1[2][2];
    int sc_w = P::scale_w, sc_x = P::scale_x; if constexpr (P::FP8) asm volatile("" : "+v"(sc_w), "+v"(sc_x));
    unsigned oA[2][2], oN[2][2] = {{0u, 0u}, {0u, 0u}};
    pol.a_off(cur, R0, R1, C0, C1, oA);
    const char* cA = pol.a_base(cur); const char* cB = pol.b_base(cur);
    if constexpr (GEMM_SP2) {
        PG8_STAGEB(PG8_SB(0, 0), cB); PG8_STAGEB(PG8_SB(0, 1), cB + hstepB); PG8_STAGEA(PG8_SA(0, 0), cA, oA[0][0], oA[0][1]); PG8_STAGEA(PG8_SA(0, 1), cA, oA[1][0], oA[1][1]);
        if (wr == 1) PG8_BAR;
        PG8_WAIT_V(2); PG8_BAR;
        PG8_STAGEB(PG8_SB(1, 0), cB + kstep); PG8_STAGEA(PG8_SA(1, 0), cA + kstep, oA[0][0], oA[0][1]); PG8_STAGEB(PG8_SB(1, 1), cB + hstepB + kstep);
        PG8_WAIT_V(6); PG8_BAR;
    } else {
    PG8_STAGEB(PG8_SB(0, 0), cB); PG8_STAGEA(PG8_SA(0, 0), cA, oA[0][0], oA[0][1]); PG8_STAGEB(PG8_SB(0, 1), cB + hstepB); PG8_STAGEA(PG8_SA(0, 1), cA, oA[1][0], oA[1][1]);
    if (wr == 1) PG8_BAR;
    PG8_WAIT_V(4); PG8_BAR;
    PG8_STAGEB(PG8_SB(1, 0), cB + kstep); PG8_STAGEA(PG8_SA(1, 0), cA + kstep, oA[0][0], oA[0][1]); PG8_STAGEB(PG8_SB(1, 1), cB + hstepB + kstep);
    PG8_WAIT_V(6); PG8_BAR;
    }
    for (;;) {
        const bool has_next = pol.next(ui + 1, nxt);
        const char* nA; const char* nB;
        if (has_next) { if constexpr (P::GATHER) pol.a_off(nxt, R0, R1, C0, C1, oN); nA = pol.a_base(nxt); nB = pol.b_base(nxt); }
        else { if constexpr (P::GATHER) { oN[0][0] = oA[0][0]; oN[0][1] = oA[0][1]; oN[1][0] = oA[1][0]; oN[1][1] = oA[1][1]; } nA = cA; nB = cB; }
        for (int t = 0; t < nt; t += 2) {
            const bool last = (t == nt - 2);
            const char* a1 = cA + (size_t)(t + 1) * kstep;
            const char* a2 = last ? nA : cA + (size_t)(t + 2) * kstep; const char* b2 = last ? nB : cB + (size_t)(t + 2) * kstep;
            const char* a3 = a2 + kstep; const char* b3 = b2 + kstep;
            const unsigned s00 = (P::GATHER && last) ? oN[0][0] : oA[0][0], s01 = (P::GATHER && last) ? oN[0][1] : oA[0][1], s10 = (P::GATHER && last) ? oN[1][0] : oA[1][0], s11 = (P::GATHER && last) ? oN[1][1] : oA[1][1];
            if constexpr (GEMM_SP2) {
            PG8_LDB(B0, 0, 0); PG8_LDB(B1, 0, 1); PG8_SCHED; PG8_LDA(At, 0, 0); PG8_STAGEA(PG8_SA(1, 1), a1, oA[1][0], oA[1][1]);
            PG8_WAIT_V(8); PG8_WAIT_L(0); PG8_BAR; PG8_MMA(0, 0, At, B0); PG8_MMA(0, 1, At, B1); PG8_BAR; PG8_SCHED;
            PG8_LDA(At, 0, 1); PG8_STAGEB(PG8_SB(0, 0), b2); PG8_STAGEB(PG8_SB(0, 1), b2 + hstepB); PG8_STAGEA(PG8_SA(0, 0), a2, s00, s01);
            PG8_WAIT_V(8); PG8_WAIT_L(0); PG8_BAR; PG8_MMA(1, 0, At, B0); PG8_MMA(1, 1, At, B1); PG8_BAR; PG8_SCHED;
            PG8_LDB(B0, 1, 0); PG8_LDB(B1, 1, 1); PG8_SCHED; PG8_LDA(At, 1, 0); PG8_STAGEA(PG8_SA(0, 1), a2, s10, s11);
            PG8_WAIT_V(8); PG8_WAIT_L(0); PG8_BAR; PG8_MMA(0, 0, At, B0); PG8_MMA(0, 1, At, B1); PG8_BAR; PG8_SCHED;
            PG8_LDA(At, 1, 1); PG8_STAGEB(PG8_SB(1, 0), b3); PG8_STAGEB(PG8_SB(1, 1), b3 + hstepB); PG8_STAGEA(PG8_SA(1, 0), a3, s00, s01);
            PG8_WAIT_V(8); PG8_WAIT_L(0); PG8_BAR; PG8_MMA(1, 0, At, B0); PG8_MMA(1, 1, At, B1); PG8_BAR; PG8_SCHED;
            } else {
            PG8_LDB(B0, 0, 0); PG8_SCHED; PG8_LDA(At, 0, 0); PG8_STAGEA(PG8_SA(1, 1), a1, oA[1][0], oA[1][1]);
            PG8_WAIT_L(8); PG8_BAR; PG8_WAIT_L(0); PG8_MMA(0, 0, At, B0); PG8_BAR; PG8_SCHED;
            PG8_LDB(B1, 0, 1); PG8_STAGEB(PG8_SB(0, 0), b2);
            PG8_BAR; PG8_WAIT_L(0); PG8_MMA(0, 1, At, B1); PG8_BAR;
            PG8_LDA(At, 0, 1); PG8_STAGEA(PG8_SA(0, 0), a2, s00, s01);
            PG8_BAR; PG8_WAIT_L(0); PG8_MMA(1, 0, At, B0); PG8_BAR; PG8_SCHED;
            PG8_STAGEB(PG8_SB(0, 1), b2 + hstepB);
            PG8_WAIT_V(6); PG8_BAR; PG8_MMA(1, 1, At, B1); PG8_BAR;
            PG8_LDB(B0, 1, 0); PG8_SCHED; PG8_LDA(At, 1, 0); PG8_STAGEA(PG8_SA(0, 1), a2, s10, s11);
            PG8_WAIT_L(8); PG8_BAR; PG8_WAIT_L(0); PG8_MMA(0, 0, At, B0); PG8_BAR; PG8_SCHED;
            PG8_LDB(B1, 1, 1); PG8_STAGEB(PG8_SB(1, 0), b3);
            PG8_BAR; PG8_WAIT_L(0); PG8_MMA(0, 1, At, B1); PG8_BAR;
            PG8_LDA(At, 1, 1); PG8_STAGEA(PG8_SA(1, 0), a3, s00, s01);
            PG8_BAR; PG8_WAIT_L(0); PG8_MMA(1, 0, At, B0); PG8_BAR; PG8_SCHED;
            PG8_STAGEB(PG8_SB(1, 1), b3 + hstepB);
            PG8_WAIT_V(6); PG8_BAR; PG8_MMA(1, 1, At, B1); PG8_BAR;
            }
        }
        if constexpr (GEMM_ALIGN) { if (wr == 0) PG8_BAR; }
        if constexpr (P::FP8) asm volatile("s_nop 15\n\ts_nop 15" ::: "memory");
        pol.epi(acc, cur, wr, wc, fr, fq);
        if (!has_next) break;
#pragma unroll
        for (int a = 0; a < 2; ++a)
#pragma unroll
            for (int b = 0; b < 2; ++b)
#pragma unroll
                for (int m = 0; m < 4; ++m)
#pragma unroll
                    for (int n = 0; n < 2; ++n) acc[a][b][m][n] = (f32x4){0.f, 0.f, 0.f, 0.f};
        cur = nxt; cA = nA; cB = nB; ++ui;
        if constexpr (P::GATHER) { oA[0][0] = oN[0][0]; oA[0][1] = oN[0][1]; oA[1][0] = oN[1][0]; oA[1][1] = oN[1][1]; }
        if constexpr (GEMM_ALIGN) { if (wr == 1) PG8_BAR; }
    }
    PG8_WAIT_V(0);
    if constexpr (!GEMM_ALIGN) { if (wr == 0) PG8_BAR; }
    PG8_BAR;
#undef PG8_SA
#undef PG8_SB
#undef PG8_STAGEA
#undef PG8_STAGEB
#undef PG8_LDA
#undef PG8_LDB
#undef PG8_MMA
#undef PG8_CAT
#undef PG8_WAIT_V
#undef PG8_WAIT_L
#undef PG8_BAR
#undef PG8_SCHED
}

__device__ __forceinline__ bool static_order(int nM, int nN, int G, int c, int i, int& pm, int& pn) {
    const int nwg = nM * nN; const long L = (long)i * G + c; if (L >= nwg) return false;
    int wgid = (int)L; { const int q = nwg / 8, r = nwg % 8, xcd = wgid % 8, off = wgid / 8; wgid = (xcd < r ? xcd * (q + 1) : r * (q + 1) + (xcd - r) * q) + off; }
    const int nig = 8 * nN, gid = wgid / nig, fm = gid * 8, gsz = (nM - fm) < 8 ? (nM - fm) : 8;
    pm = fm + ((wgid % nig) % gsz); pn = (wgid % nig) / gsz; return true;
}

__device__ __forceinline__ void store_tile_bf16(const f32x4 (&acc)[2][2][4][2], bf16_t* base  , size_t ldc, int wr, int wc, int fr, int fq, int rows_valid) {
#pragma unroll
    for (int ai = 0; ai < 2; ++ai)
#pragma unroll
        for (int m = 0; m < 4; ++m) { const int r = ai * HALF + wr * 64 + m * 16 + fr; if (r < rows_valid) { bf16_t* rowp = base + (size_t)r * ldc + wc * 32 + 8 * fq;
#pragma unroll
            for (int bj = 0; bj < 2; ++bj) { const f32x4 v0 = acc[ai][bj][m][0], v1 = acc[ai][bj][m][1];
                u32x4 w; w.x = cvt_pk_bf16(v0[0], v0[1]); w.y = cvt_pk_bf16(v0[2], v0[3]); w.z = cvt_pk_bf16(v1[0], v1[1]); w.w = cvt_pk_bf16(v1[2], v1[3]);
                *(u32x4*)(rowp + bj * HALF) = w; } } }
}
}

namespace att {
constexpr int NW = 8, QBLK = 32, KVBLK = 64, DV = 128;
constexpr int SHM_V = KVBLK * DV * 2  , SHM_K = KVBLK * 128 * 2  , SHM_K2 = KVBLK * 64 * 2  ;
constexpr int OFF_V = 0, OFF_K = 2 * SHM_V, OFF_K2 = OFF_K + 2 * SHM_K, OFF_WS = OFF_K2 + 2 * SHM_K2, ATT_LDS = OFF_WS + NW * 64 * 4  , OFF_QR = ATT_LDS  ;
constexpr float THR = 8.f;
#define KSWZ(row, colB) ((row) * 256 + ((colB) ^ (((row) & 7) << 4)))
#define KSWZ64(row, colB) ((row) * 128 + ((colB) ^ ((((row) >> 1) & 7) << 4)))
#define SBAR() __builtin_amdgcn_sched_barrier(0)
__device__ __forceinline__ int crow(int r, int hi) { return (r & 3) + 8 * (r >> 2) + 4 * hi; }
__device__ __forceinline__ int v_st(int k, int c) { const int kk = (k & ~0xC) | ((k & 4) << 1) | ((k & 8) >> 1); return ((kk >> 3) * 4 + (c >> 5)) * 512 + ((kk & 7) * 32 + (c & 31)) * 2; }
__device__ __forceinline__ int v_rd_base(int lane) { return ((lane & 3) << 3) | (((lane >> 2) & 3) << 6) | (((lane >> 4) & 1) << 5) | (((lane >> 5) & 1) << 8); }
constexpr int v_rd_off(int d0, int ks, int half) { return d0 * 512 + ks * 4096 + half * 2048; }
template <int OFF> __device__ __forceinline__ s16x4 tr_read(int vb) {
    s16x4 r; asm volatile("ds_read_b64_tr_b16 %0, %1 offset:%2" : "=&v"(r) : "v"(vb), "i"(OFF) : "memory"); return r;
}
template <int D0> __device__ __forceinline__ void pv_one(f32x16& od, int vb, bf16x8 pa0, bf16x8 pa1, bf16x8 pa2, bf16x8 pa3) {
    const s16x4 l0 = tr_read<v_rd_off(D0, 0, 0)>(vb), h0 = tr_read<v_rd_off(D0, 0, 1)>(vb), l1 = tr_read<v_rd_off(D0, 1, 0)>(vb), h1 = tr_read<v_rd_off(D0, 1, 1)>(vb);
    const s16x4 l2 = tr_read<v_rd_off(D0, 2, 0)>(vb), h2 = tr_read<v_rd_off(D0, 2, 1)>(vb), l3 = tr_read<v_rd_off(D0, 3, 0)>(vb), h3 = tr_read<v_rd_off(D0, 3, 1)>(vb);
    asm volatile("s_waitcnt lgkmcnt(0)" ::: "memory"); SBAR();
#define PK(L, H) (bf16x8){L[0], L[1], L[2], L[3], H[0], H[1], H[2], H[3]}
    od = __builtin_amdgcn_mfma_f32_32x32x16_bf16(pa0, PK(l0, h0), od, 0, 0, 0);
    od = __builtin_amdgcn_mfma_f32_32x32x16_bf16(pa1, PK(l1, h1), od, 0, 0, 0);
    od = __builtin_amdgcn_mfma_f32_32x32x16_bf16(pa2, PK(l2, h2), od, 0, 0, 0);
    od = __builtin_amdgcn_mfma_f32_32x32x16_bf16(pa3, PK(l3, h3), od, 0, 0, 0);
#undef PK
}
__device__ __forceinline__ void pv_d0(f32x16* o, int vb, bf16x8 pa0, bf16x8 pa1, bf16x8 pa2, bf16x8 pa3) {
    pv_one<0>(o[0], vb, pa0, pa1, pa2, pa3); pv_one<1>(o[1], vb, pa0, pa1, pa2, pa3); pv_one<2>(o[2], vb, pa0, pa1, pa2, pa3); pv_one<3>(o[3], vb, pa0, pa1, pa2, pa3);
}
__device__ __forceinline__ void partialSM(f32x16& p0, f32x16& p1, float& m_reg, float& mn, float& alpha, float C, float thr_raw) {
    float pmax = p0[0];
#pragma unroll
    for (int r = 1; r < 16; ++r) pmax = fmaxf(pmax, p0[r]);
#pragma unroll
    for (int r = 0; r < 16; ++r) pmax = fmaxf(pmax, p1[r]);
    { auto rr = __builtin_amdgcn_permlane32_swap(__builtin_bit_cast(unsigned, pmax), __builtin_bit_cast(unsigned, pmax), false, false);
      pmax = fmaxf(__builtin_bit_cast(float, rr[0]), __builtin_bit_cast(float, rr[1])); }
    if (__builtin_expect(__all(pmax - m_reg <= thr_raw), 1)) { mn = m_reg; alpha = 1.f; }
    else { mn = fmaxf(m_reg, pmax); alpha = __builtin_amdgcn_exp2f((m_reg - mn) * C); m_reg = mn; }
    const float mnC = -mn * C;
#pragma unroll
    for (int r = 0; r < 16; ++r) p0[r] = fmaf(p0[r], C, mnC);
#pragma unroll
    for (int r = 0; r < 16; ++r) p1[r] = fmaf(p1[r], C, mnC);
#pragma unroll
    for (int r = 0; r < 16; ++r) p0[r] = __builtin_amdgcn_exp2f(p0[r]);
}
__device__ __forceinline__ void finishSM(f32x16& p0, f32x16& p1, float alpha, float& l_reg, bf16x8& pa0, bf16x8& pa1, bf16x8& pa2, bf16x8& pa3) {
#pragma unroll
    for (int r = 0; r < 16; ++r) p1[r] = __builtin_amdgcn_exp2f(p1[r]);
    float ps = 0;
#pragma unroll
    for (int r = 0; r < 16; ++r) ps += p0[r];
#pragma unroll
    for (int r = 0; r < 16; ++r) ps += p1[r];
    { auto rr = __builtin_amdgcn_permlane32_swap(__builtin_bit_cast(unsigned, ps), __builtin_bit_cast(unsigned, ps), false, false);
      ps = __builtin_bit_cast(float, rr[0]) + __builtin_bit_cast(float, rr[1]); }
    l_reg = l_reg * alpha + ps;
#define PK4(P, BASE, OUT) do { unsigned a0 = cvt_pk_bf16(P[BASE + 0], P[BASE + 1]), a1 = cvt_pk_bf16(P[BASE + 2], P[BASE + 3]);   \
    unsigned b0 = cvt_pk_bf16(P[BASE + 4], P[BASE + 5]), b1 = cvt_pk_bf16(P[BASE + 6], P[BASE + 7]);                              \
    auto r0 = __builtin_amdgcn_permlane32_swap(a0, b0, false, false); auto r1 = __builtin_amdgcn_permlane32_swap(a1, b1, false, false); \
    u32x4 w = {r0[0], r1[0], r0[1], r1[1]}; OUT = __builtin_bit_cast(bf16x8, w); } while (0)
    PK4(p0, 0, pa0); PK4(p0, 8, pa1); PK4(p1, 0, pa2); PK4(p1, 8, pa3);
#undef PK4
}
__device__ __forceinline__ bf16x8 rope8(bf16x8 v, const char* tabc, unsigned off) {
    const f32x4 c01 = *(const f32x4*)(tabc + off), c23 = *(const f32x4*)(tabc + off + 16);
    const u32x4 w = __builtin_bit_cast(u32x4, v); u32x4 o;
    { const float x1 = bflo(w[0]), x2 = bfhi(w[0]); o[0] = cvt_pk_bf16(x1 * c01[0] - x2 * c01[1], x1 * c01[1] + x2 * c01[0]); }
    { const float x1 = bflo(w[1]), x2 = bfhi(w[1]); o[1] = cvt_pk_bf16(x1 * c01[2] - x2 * c01[3], x1 * c01[3] + x2 * c01[2]); }
    { const float x1 = bflo(w[2]), x2 = bfhi(w[2]); o[2] = cvt_pk_bf16(x1 * c23[0] - x2 * c23[1], x1 * c23[1] + x2 * c23[0]); }
    { const float x1 = bflo(w[3]), x2 = bfhi(w[3]); o[3] = cvt_pk_bf16(x1 * c23[2] - x2 * c23[3], x1 * c23[3] + x2 * c23[2]); }
    return __builtin_bit_cast(bf16x8, o);
}

struct UnitDesc {
    const bf16_t* Q; int ldq;
    const bf16_t* K; int ldk;
    const bf16_t* K2; int ldk2;
    const bf16_t* V; int ldv;
    bf16_t* O; int ldo;
    int NT;
    float C;
    const f32x2* rope; int qtok0;
    int seg_tiles, seg2_row0;
    int ktok0;
    float sink_l2;
};
template <int MODE>
__device__ __forceinline__ void attn_unit(const UnitDesc& U, char* lds) {
    constexpr int DQK = MODE == 0 ? 64 : (MODE == 1 ? 192 : 128), NQ = DQK / 16, NQR = NQ;
    int tid_ = threadIdx.x; asm volatile("" : "+v"(tid_));
    const int tid = tid_, wid = tid >> 6, lane = tid & 63, r32 = lane & 31, hi = lane >> 5;
    constexpr int NBUF = (MODE == 0) ? 4 : 3;
    constexpr int oK = NBUF * SHM_V, oK2 = oK + NBUF * SHM_K, oWS = oK2 + (MODE == 1 ? NBUF * SHM_K2 : 0), oQR = oWS + NW * 64 * 4;
    static_assert(oQR <= 152 * 1024, "attention LDS map");
    char* V_lds = lds; char* K_lds = lds + oK; char* K2_lds = lds + oK2;
    float* ws = (float*)(lds + oWS) + wid * 64; float* li_l = ws; float* al_l = ws + 32;
    float m_reg = -1e30f, l_reg = 0; f32x16 o[4] = {}; bf16x8 qr[NQR];
    bf16x8* QRl = (bf16x8*)(lds + (MODE == 1 ? OFF_QR : 0)) + wid * 512 + lane;
    {   const bf16_t* Qw = U.Q + (size_t)(wid * QBLK + r32) * U.ldq + hi * 8;
        const int qt = U.qtok0 + wid * QBLK + r32, prow = qt >> 6, pcol = qt & 63;
        constexpr int RQ = (MODE == 2) ? 32 : 16;
        const unsigned orow = (unsigned)prow * RQ * 8 + hi * 32, ocol = (unsigned)pcol * RQ * 8 + hi * 32; const char* tabc = (const char*)U.rope;
#pragma unroll
        for (int d0 = 0; d0 < NQ; ++d0) { bf16x8 v = *reinterpret_cast<const bf16x8*>(Qw + d0 * 16);
            const int pi = (MODE == 1) ? (d0 - 8) * 8 : d0 * 8;
            if (MODE != 1 || d0 >= 8) { if (MODE != 0 || U.rope) v = rope8(v, tabc, (pi < RQ ? orow : ocol) + (unsigned)((pi < RQ ? pi : pi - RQ) * 8)); }
            if (MODE == 1 && d0 >= NQR) QRl[(d0 - NQR) * 64] = v; else qr[d0 < NQR ? d0 : 0] = v; }
    }
    const float thr_raw = THR * 1.4426950408889634f / U.C;
    const int sr = tid >> 4, sc = (tid & 15) * 8;
    const int vst0 = v_st(sr, sc), vst1 = v_st(32 + sr, sc);
    const int k64r = tid >> 3, k64c = (tid & 7) * 8;
    const int vb0 = (int)(uintptr_t)V_lds + v_rd_base(lane);
    constexpr int DEPTH = (MODE == 0) ? 2 : 1, SE = 0, SO = DEPTH - 1;
    bf16x8 sv0[DEPTH], sv1[DEPTH], sk0[DEPTH], sk1[DEPTH], sk2[DEPTH];
    auto krow = [&](int t) -> int { if (MODE == 2) return t < U.seg_tiles ? t * 64 : U.seg2_row0 + (t - U.seg_tiles) * 64; return t * 64; };
#define SLOAD(i, t) do { const int _r = krow(t); \
    sv0[i] = *reinterpret_cast<const bf16x8*>(U.V + (size_t)(_r + sr) * U.ldv + sc); sv1[i] = *reinterpret_cast<const bf16x8*>(U.V + (size_t)(_r + 32 + sr) * U.ldv + sc); \
    if (MODE == 0) { sk0[i] = *reinterpret_cast<const bf16x8*>(U.K + (size_t)(_r + k64r) * U.ldk + k64c); } \
    else { sk0[i] = *reinterpret_cast<const bf16x8*>(U.K + (size_t)(_r + sr) * U.ldk + sc); sk1[i] = *reinterpret_cast<const bf16x8*>(U.K + (size_t)(_r + 32 + sr) * U.ldk + sc); } \
    if (MODE == 1) { sk2[i] = *reinterpret_cast<const bf16x8*>(U.K2 + (size_t)(_r + k64r) * U.ldk2 + k64c); } } while (0)
#define SWRITE(b, i) do { *(bf16x8*)(V_lds + (b) * SHM_V + vst0) = sv0[i]; *(bf16x8*)(V_lds + (b) * SHM_V + vst1) = sv1[i]; \
    if (MODE == 0) { *(bf16x8*)(K_lds + (b) * SHM_K + KSWZ64(k64r, k64c * 2)) = sk0[i]; } \
    else { *(bf16x8*)(K_lds + (b) * SHM_K + KSWZ(sr, sc * 2)) = sk0[i]; *(bf16x8*)(K_lds + (b) * SHM_K + KSWZ(32 + sr, sc * 2)) = sk1[i]; } \
    if (MODE == 1) { *(bf16x8*)(K2_lds + (b) * SHM_K2 + KSWZ64(k64r, k64c * 2)) = sk2[i]; } } while (0)
#define SWAIT() do { if (MODE == 0) asm volatile("s_waitcnt vmcnt(3)" ::: "memory"); else asm volatile("s_waitcnt vmcnt(0)" ::: "memory"); } while (0)
    const int widu = __builtin_amdgcn_readfirstlane(wid);
    LAS unsigned char* ldsA = (LAS unsigned char*)lds;
    int dvo0, dvo1, dko;
    {   const int p = tid, kkv = ((p >> 7) << 3) | ((p >> 2) & 7), kv = (kkv & ~0xC) | ((kkv & 4) << 1) | ((kkv & 8) >> 1), cv = ((p >> 5) & 3) * 32 + (p & 3) * 8;
        dvo0 = kv * U.ldv + cv; dvo1 = (kv + 32) * U.ldv + cv;
        const int rk = p >> 3, ck = ((p & 7) ^ ((rk >> 1) & 7)) * 8; dko = rk * U.ldk + ck; }
    int dko1 = 0, dk2o = 0;
    if (MODE == 1) { const int p = tid, rk = p >> 4, ck = ((p & 15) ^ (rk & 7)) * 8; dko = rk * U.ldk + ck; dko1 = (rk + 32) * U.ldk + ck;
        const int r2 = p >> 3, c2 = ((p & 7) ^ ((r2 >> 1) & 7)) * 8; dk2o = r2 * U.ldk2 + c2; }
#define DMA_TILE1(t, b) do { const int _r = (t) * 64; const bf16_t* _v = U.V + (size_t)_r * U.ldv; const bf16_t* _k = U.K + (size_t)_r * U.ldk; const bf16_t* _k2 = U.K2 + (size_t)_r * U.ldk2; \
    __builtin_amdgcn_global_load_lds((const unsigned*)(_v + dvo0), (LAS unsigned*)(ldsA + (b) * SHM_V + widu * 1024), 16, 0, 0); \
    __builtin_amdgcn_global_load_lds((const unsigned*)(_v + dvo1), (LAS unsigned*)(ldsA + (b) * SHM_V + 8192 + widu * 1024), 16, 0, 0); \
    __builtin_amdgcn_global_load_lds((const unsigned*)(_k + dko), (LAS unsigned*)(ldsA + oK + (b) * SHM_K + widu * 1024), 16, 0, 0); \
    __builtin_amdgcn_global_load_lds((const unsigned*)(_k + dko1), (LAS unsigned*)(ldsA + oK + (b) * SHM_K + 8192 + widu * 1024), 16, 0, 0); \
    __builtin_amdgcn_global_load_lds((const unsigned*)(_k2 + dk2o), (LAS unsigned*)(ldsA + oK2 + (b) * SHM_K2 + widu * 1024), 16, 0, 0); } while (0)
#define DMA_TILE(t) do { const int _r = (t) * 64, _b = (t) & 3; const bf16_t* _v = U.V + (size_t)_r * U.ldv; const bf16_t* _k = U.K + (size_t)_r * U.ldk; \
    __builtin_amdgcn_global_load_lds((const unsigned*)(_v + dvo0), (LAS unsigned*)(ldsA + _b * SHM_V + widu * 1024), 16, 0, 0); \
    __builtin_amdgcn_global_load_lds((const unsigned*)(_v + dvo1), (LAS unsigned*)(ldsA + _b * SHM_V + 8192 + widu * 1024), 16, 0, 0); \
    __builtin_amdgcn_global_load_lds((const unsigned*)(_k + dko), (LAS unsigned*)(ldsA + oK + _b * SHM_K + widu * 1024), 16, 0, 0); } while (0)
#define VMW(n) asm volatile("s_waitcnt vmcnt(" #n ")" ::: "memory")
#define RESC(a) do { if (__any((a) < 1.f)) { if (hi == 0) al_l[r32] = (a); asm volatile("s_waitcnt lgkmcnt(0)" ::: "memory"); \
    _Pragma("unroll") for (int d = 0; d < 4; ++d) _Pragma("unroll") for (int r = 0; r < 16; ++r) o[d][r] *= al_l[crow(r, hi)]; } } while (0)
#define QKT(p0, p1, b) do { p0 = f32x16{}; p1 = f32x16{}; \
    if (MODE == 0) { _Pragma("unroll") for (int d0 = 0; d0 < 4; ++d0) { const int cb = (d0 * 16 + hi * 8) * 2; \
        const bf16x8 b0 = *reinterpret_cast<const bf16x8*>(K_lds + (b) * SHM_K + KSWZ64(r32, cb)); const bf16x8 b1 = *reinterpret_cast<const bf16x8*>(K_lds + (b) * SHM_K + KSWZ64(32 + r32, cb)); \
        p0 = __builtin_amdgcn_mfma_f32_32x32x16_bf16(b0, qr[d0], p0, 0, 0, 0); p1 = __builtin_amdgcn_mfma_f32_32x32x16_bf16(b1, qr[d0], p1, 0, 0, 0); } } \
    else { _Pragma("unroll") for (int d0 = 0; d0 < 8; ++d0) { const int cb = (d0 * 16 + hi * 8) * 2; \
        const bf16x8 b0 = *reinterpret_cast<const bf16x8*>(K_lds + (b) * SHM_K + KSWZ(r32, cb)); const bf16x8 b1 = *reinterpret_cast<const bf16x8*>(K_lds + (b) * SHM_K + KSWZ(32 + r32, cb)); \
        const bf16x8 qf = (MODE == 1 && d0 >= NQR) ? QRl[(d0 >= NQR ? d0 - NQR : 0) * 64] : qr[d0 < NQR ? d0 : 0]; \
        p0 = __builtin_amdgcn_mfma_f32_32x32x16_bf16(b0, qf, p0, 0, 0, 0); p1 = __builtin_amdgcn_mfma_f32_32x32x16_bf16(b1, qf, p1, 0, 0, 0); \
        if (MODE == 1 && (d0 == 3 || d0 == 7)) SBAR(); } \
      if (MODE == 1) { _Pragma("unroll") for (int d0 = 0; d0 < 4; ++d0) { const int cb = (d0 * 16 + hi * 8) * 2; \
        const bf16x8 b0 = *reinterpret_cast<const bf16x8*>(K2_lds + (b) * SHM_K2 + KSWZ64(r32, cb)); const bf16x8 b1 = *reinterpret_cast<const bf16x8*>(K2_lds + (b) * SHM_K2 + KSWZ64(32 + r32, cb)); \
        const bf16x8 qf = qr[(8 + d0) < NQR ? 8 + d0 : 0]; p0 = __builtin_amdgcn_mfma_f32_32x32x16_bf16(b0, qf, p0, 0, 0, 0); p1 = __builtin_amdgcn_mfma_f32_32x32x16_bf16(b1, qf, p1, 0, 0, 0); } } } } while (0)
#define MASK(p0, p1, t) do { if (MODE == 2) { if ((t) >= U.seg_tiles) { const int _d0 = U.ktok0 + ((t) - U.seg_tiles) * 64 - (U.qtok0 + wid * QBLK + r32); \
    _Pragma("unroll") for (int r = 0; r < 16; ++r) { const int _dk = _d0 + crow(r, hi); \
        if (_dk > 128 || _dk < -128) p0[r] = -1e30f; if (_dk + 32 > 128 || _dk + 32 < -128) p1[r] = -1e30f; } } } } while (0)
    f32x16 pA0, pA1, pB0, pB1; float mnA, mnB, alA, alB; bf16x8 pa0, pa1, pa2, pa3; const int NT = U.NT;
    if constexpr (MODE == 0) {
    DMA_TILE(0); DMA_TILE(1); if (2 < NT) DMA_TILE(2);
    if (2 < NT) VMW(6); else VMW(3);
    __syncthreads();
    QKT(pA0, pA1, 0); partialSM(pA0, pA1, m_reg, mnA, alA, U.C, thr_raw);
    if (2 < NT) VMW(3); else VMW(0);
    __syncthreads();
    for (int j = 1; j + 1 < NT; j += 2) {
        SBAR(); QKT(pB0, pB1, j & 3);
        finishSM(pA0, pA1, alA, l_reg, pa0, pa1, pa2, pa3); SBAR();
        DMA_TILE(j + 2); SBAR();
        pv_d0(o, vb0 + ((j - 1) & 3) * SHM_V, pa0, pa1, pa2, pa3); partialSM(pB0, pB1, m_reg, mnB, alB, U.C, thr_raw);
        VMW(3);
        RESC(alB); __syncthreads();
        SBAR(); QKT(pA0, pA1, (j + 1) & 3);
        finishSM(pB0, pB1, alB, l_reg, pa0, pa1, pa2, pa3); SBAR();
        if (j + 3 < NT) DMA_TILE(j + 3); SBAR();
        pv_d0(o, vb0 + (j & 3) * SHM_V, pa0, pa1, pa2, pa3); partialSM(pA0, pA1, m_reg, mnA, alA, U.C, thr_raw);
        if (j + 3 < NT) VMW(3); else VMW(0);
        RESC(alA); __syncthreads();
    }
    SBAR(); QKT(pB0, pB1, (NT - 1) & 3);
    finishSM(pA0, pA1, alA, l_reg, pa0, pa1, pa2, pa3); SBAR();
    pv_d0(o, vb0 + ((NT - 2) & 3) * SHM_V, pa0, pa1, pa2, pa3); partialSM(pB0, pB1, m_reg, mnB, alB, U.C, thr_raw);
    RESC(alB);
    finishSM(pB0, pB1, alB, l_reg, pa0, pa1, pa2, pa3); SBAR();
    pv_d0(o, vb0 + ((NT - 1) & 3) * SHM_V, pa0, pa1, pa2, pa3);
    } else if constexpr (MODE == 1) {
    DMA_TILE1(0, 0); DMA_TILE1(1, 1);
    VMW(5); __syncthreads();
    QKT(pA0, pA1, 0); partialSM(pA0, pA1, m_reg, mnA, alA, U.C, thr_raw);
    VMW(0); __syncthreads();
    int bm = 0, bc = 1, bn = 2;
    for (int j = 1; j + 1 < NT; j += 2) {
        DMA_TILE1(j + 1, bn);
        SBAR(); QKT(pB0, pB1, bc);
        finishSM(pA0, pA1, alA, l_reg, pa0, pa1, pa2, pa3); SBAR();
        pv_d0(o, vb0 + bm * SHM_V, pa0, pa1, pa2, pa3); partialSM(pB0, pB1, m_reg, mnB, alB, U.C, thr_raw);
        VMW(0); RESC(alB); __syncthreads();
        { const int t_ = bm; bm = bc; bc = bn; bn = t_; }
        if (j + 2 < NT) DMA_TILE1(j + 2, bn);
        SBAR(); QKT(pA0, pA1, bc);
        finishSM(pB0, pB1, alB, l_reg, pa0, pa1, pa2, pa3); SBAR();
        pv_d0(o, vb0 + bm * SHM_V, pa0, pa1, pa2, pa3); partialSM(pA0, pA1, m_reg, mnA, alA, U.C, thr_raw);
        VMW(0); RESC(alA); __syncthreads();
        { const int t_ = bm; bm = bc; bc = bn; bn = t_; }
    }
    SBAR(); QKT(pB0, pB1, bc);
    finishSM(pA0, pA1, alA, l_reg, pa0, pa1, pa2, pa3); SBAR();
    pv_d0(o, vb0 + bm * SHM_V, pa0, pa1, pa2, pa3); partialSM(pB0, pB1, m_reg, mnB, alB, U.C, thr_raw);
    RESC(alB);
    finishSM(pB0, pB1, alB, l_reg, pa0, pa1, pa2, pa3); SBAR();
    pv_d0(o, vb0 + bc * SHM_V, pa0, pa1, pa2, pa3);
    } else if constexpr (NBUF == 2) {
    SLOAD(SE, 0); asm volatile("s_waitcnt vmcnt(0)" ::: "memory"); SWRITE(0, SE); __syncthreads();
    QKT(pA0, pA1, 0); MASK(pA0, pA1, 0); partialSM(pA0, pA1, m_reg, mnA, alA, U.C, thr_raw);
    SLOAD(SO, 1); if (DEPTH == 2) { if (2 < NT) SLOAD(SE, 2); }
    if (DEPTH == 2 && 2 < NT) SWAIT(); else asm volatile("s_waitcnt vmcnt(0)" ::: "memory");
    SWRITE(1, SO); __syncthreads();
    for (int j = 1; j + 1 < NT; j += 2) {
        SBAR(); QKT(pB0, pB1, 1); MASK(pB0, pB1, j);
        finishSM(pA0, pA1, alA, l_reg, pa0, pa1, pa2, pa3); SBAR();
        SLOAD(SO, j + DEPTH); SBAR();
        pv_d0(o, vb0, pa0, pa1, pa2, pa3); partialSM(pB0, pB1, m_reg, mnB, alB, U.C, thr_raw);
        __syncthreads(); SWAIT(); SWRITE(0, SE);
        RESC(alB); __syncthreads();
        SBAR(); QKT(pA0, pA1, 0); MASK(pA0, pA1, j + 1);
        finishSM(pB0, pB1, alB, l_reg, pa0, pa1, pa2, pa3); SBAR();
        if (DEPTH == 1 || j + 3 < NT) SLOAD(SE, j + 1 + DEPTH); SBAR();
        pv_d0(o, vb0 + SHM_V, pa0, pa1, pa2, pa3); partialSM(pA0, pA1, m_reg, mnA, alA, U.C, thr_raw);
        __syncthreads(); if (DEPTH == 1 || j + 3 < NT) SWAIT(); else asm volatile("s_waitcnt vmcnt(0)" ::: "memory");
        SWRITE(1, SO);
        RESC(alA); __syncthreads();
    }
    SBAR(); QKT(pB0, pB1, 1); MASK(pB0, pB1, NT - 1);
    finishSM(pA0, pA1, alA, l_reg, pa0, pa1, pa2, pa3); SBAR();
    pv_d0(o, vb0, pa0, pa1, pa2, pa3); partialSM(pB0, pB1, m_reg, mnB, alB, U.C, thr_raw);
    __syncthreads(); RESC(alB);
    finishSM(pB0, pB1, alB, l_reg, pa0, pa1, pa2, pa3); SBAR();
    pv_d0(o, vb0 + SHM_V, pa0, pa1, pa2, pa3);
    } else {
    SLOAD(SE, 0); asm volatile("s_waitcnt vmcnt(0)" ::: "memory"); SWRITE(0, SE);
    SLOAD(SO, 1); if (DEPTH == 2) { if (2 < NT) SLOAD(SE, 2); }
    __syncthreads();
    QKT(pA0, pA1, 0); MASK(pA0, pA1, 0); partialSM(pA0, pA1, m_reg, mnA, alA, U.C, thr_raw);
    if (DEPTH == 2 && 2 < NT) SWAIT(); else asm volatile("s_waitcnt vmcnt(0)" ::: "memory");
    SWRITE(1, SO); __syncthreads();
    int bm = 0, bc = 1, bn = 2;
    for (int j = 1; j + 1 < NT; j += 2) {
        SBAR(); QKT(pB0, pB1, bc); MASK(pB0, pB1, j);
        finishSM(pA0, pA1, alA, l_reg, pa0, pa1, pa2, pa3); SBAR();
        SLOAD(SO, j + DEPTH); SBAR();
        pv_d0(o, vb0 + bm * SHM_V, pa0, pa1, pa2, pa3); partialSM(pB0, pB1, m_reg, mnB, alB, U.C, thr_raw);
        SWAIT(); SWRITE(bn, SE);
        RESC(alB); __syncthreads();
        { const int t_ = bm; bm = bc; bc = bn; bn = t_; }
        SBAR(); QKT(pA0, pA1, bc); MASK(pA0, pA1, j + 1);
        finishSM(pB0, pB1, alB, l_reg, pa0, pa1, pa2, pa3); SBAR();
        if (DEPTH == 1 || j + 3 < NT) SLOAD(SE, j + 1 + DEPTH); SBAR();
        pv_d0(o, vb0 + bm * SHM_V, pa0, pa1, pa2, pa3); partialSM(pA0, pA1, m_reg, mnA, alA, U.C, thr_raw);
        if (DEPTH == 1 || j + 3 < NT) SWAIT(); else asm volatile("s_waitcnt vmcnt(0)" ::: "memory");
        SWRITE(bn, SO);
        RESC(alA); __syncthreads();
        { const int t_ = bm; bm = bc; bc = bn; bn = t_; }
    }
    SBAR(); QKT(pB0, pB1, bc); MASK(pB0, pB1, NT - 1);
    finishSM(pA0, pA1, alA, l_reg, pa0, pa1, pa2, pa3); SBAR();
    pv_d0(o, vb0 + bm * SHM_V, pa0, pa1, pa2, pa3); partialSM(pB0, pB1, m_reg, mnB, alB, U.C, thr_raw);
    RESC(alB);
    finishSM(pB0, pB1, alB, l_reg, pa0, pa1, pa2, pa3); SBAR();
    pv_d0(o, vb0 + bc * SHM_V, pa0, pa1, pa2, pa3);
    }
    if (MODE == 2) l_reg += __builtin_amdgcn_exp2f(U.sink_l2 - m_reg * U.C);
    if (hi == 0) li_l[r32] = l_reg; asm volatile("s_waitcnt lgkmcnt(0)" ::: "memory");
    float rli[16];
#pragma unroll
    for (int r = 0; r < 16; ++r) rli[r] = __builtin_amdgcn_rcpf(li_l[crow(r, hi)]);
    int hio = hi, r32o = r32; asm volatile("" : "+v"(hio), "+v"(r32o));
    bf16_t* Ow = U.O + (size_t)(wid * QBLK + 4 * hio) * U.ldo + r32o;
#pragma unroll
    for (int r = 0; r < 16; ++r) { const int orow = (r & 3) + 8 * (r >> 2);
#pragma unroll
        for (int d0 = 0; d0 < 4; ++d0) Ow[(size_t)orow * U.ldo + d0 * 32] = (bf16_t)f2bf(o[d0][r] * rli[r]); }
    __syncthreads();
#undef SLOAD
#undef SWRITE
#undef SWAIT
#undef RESC
#undef DMA_TILE
#undef DMA_TILE1
#undef VMW
#undef QKT
#undef MASK
}
}

struct Args { const float* in[31]; float* out; unsigned char* ws; int ph_lo, ph_hi; };
enum { I_X = 0, I_C, I_CTX, I_CCTX, I_MODW, I_MODB, I_NMPRE, I_NMPOST, I_NFPRE, I_NFPOST, I_ABIN, I_ABOUT, I_DLAM, I_DNORM, I_MGB, I_MNORM, I_CDIN, I_CDOUT,
       I_QNORM, I_WUQ, I_KVNORM, I_WUKV, I_SINK, I_RW, I_RB, I_EG, I_EU, I_ED, I_SG, I_SU, I_SD };
struct Frame {
    LAS unsigned char* lds; char* ldsg;
    unsigned char* ws; const float* const* in; float* out;
    int tid, lane, wave, G, bid, gw, NGW;
};
__device__ __forceinline__ int row_batch(int r) { return r >= TPB ? 1 : 0; }
__device__ __forceinline__ const float* src_row(const Frame& F, int r) {
    const int b = row_batch(r), pos = r - b * TPB;
    return pos < CTXL ? F.in[I_CTX] + ((size_t)b * CTXL + pos) * DM : F.in[I_X] + ((size_t)b * SEQ + (pos - CTXL)) * DM;
}
__device__ __forceinline__ int row_variant(int r) { const int b = row_batch(r), pos = r - b * TPB; return pos < CTXL ? 2 : b; }

__device__ __forceinline__ void tr_item(const float* __restrict__ src, size_t ldsrc, bf16_t* __restrict__ dst, size_t ldd, LAS float* scr, int lane) {
    const int kk = lane >> 3, n4 = (lane & 7) * 4;
    f32x4 v[8];
#pragma unroll
    for (int i = 0; i < 8; ++i) v[i] = __builtin_nontemporal_load((const f32x4*)(src + (size_t)(8 * i + kk) * ldsrc + n4));
#pragma unroll
    for (int i = 0; i < 8; ++i) { LAS float* s = scr + (8 * i + kk) * 33 + n4; s[0] = v[i].x; s[1] = v[i].y; s[2] = v[i].z; s[3] = v[i].w; }
    LDS_WAIT(); asm volatile("" ::: "memory");
    const int c = lane & 7;
#pragma unroll
    for (int j = 0; j < 4; ++j) { const int n = (lane >> 3) + 8 * j; const LAS float* s = scr + (8 * c) * 33 + n;
        u32x4 o; o.x = cvt_pk_bf16(s[0 * 33], s[1 * 33]); o.y = cvt_pk_bf16(s[2 * 33], s[3 * 33]); o.z = cvt_pk_bf16(s[4 * 33], s[5 * 33]); o.w = cvt_pk_bf16(s[6 * 33], s[7 * 33]);
        __builtin_nontemporal_store(o, (u32x4*)(dst + (size_t)n * ldd + 8 * c)); }
    LDS_WAIT(); asm volatile("" ::: "memory");
}
__device__ __forceinline__ void tr_item8(const float* __restrict__ src, size_t ldsrc, unsigned char* __restrict__ dst, size_t ldd, float scale, LAS float* scr, int lane) {
    const int kk = lane >> 3, n4 = (lane & 7) * 4;
    f32x4 v[8];
#pragma unroll
    for (int i = 0; i < 8; ++i) v[i] = __builtin_nontemporal_load((const f32x4*)(src + (size_t)(8 * i + kk) * ldsrc + n4));
#pragma unroll
    for (int i = 0; i < 8; ++i) { LAS float* s = scr + (8 * i + kk) * 33 + n4; s[0] = v[i].x; s[1] = v[i].y; s[2] = v[i].z; s[3] = v[i].w; }
    LDS_WAIT(); asm volatile("" ::: "memory");
    const int c = lane & 7;
#pragma unroll
    for (int j = 0; j < 4; ++j) { const int n = (lane >> 3) + 8 * j; const LAS float* s = scr + (8 * c) * 33 + n;
        int w0 = __builtin_amdgcn_cvt_pk_fp8_f32(s[0 * 33] * scale, s[1 * 33] * scale, 0, false); w0 = __builtin_amdgcn_cvt_pk_fp8_f32(s[2 * 33] * scale, s[3 * 33] * scale, w0, true);
        int w1 = __builtin_amdgcn_cvt_pk_fp8_f32(s[4 * 33] * scale, s[5 * 33] * scale, 0, false); w1 = __builtin_amdgcn_cvt_pk_fp8_f32(s[6 * 33] * scale, s[7 * 33] * scale, w1, true);
        __builtin_nontemporal_store((u32x2){(unsigned)w0, (unsigned)w1}, (u32x2*)(dst + (size_t)n * ldd + 8 * c)); }
    LDS_WAIT(); asm volatile("" ::: "memory");
}
struct TrDesc { const float* src; size_t ldsrc; unsigned char* dst; size_t ldd; float scale; int fp8; int valid; };
constexpr int P0_J1 = 8 * 193, P0_J2 = 8 * 64, P0_J3 = 8 * 80, P0_J4 = 8 * 64, P0_J5 = 2 * 48, P0_J6 = 2 * 64, P0_JE = 2 * 64 * 128, P0_JS = 2 * 128;
constexpr int P0_NITEMS = P0_J1 + P0_J2 + P0_J3 + P0_J4 + P0_J5 + P0_J6 + 3 * P0_JE + 3 * P0_JS;
__device__ __forceinline__ TrDesc p0_decode(const Frame& F, int r, int sub) {
    unsigned char* ws = F.ws; TrDesc d; d.scale = 1.f; d.fp8 = 0; d.valid = 1;
    if (r < P0_J1) { const int kb = 4 * (r / 193) + sub, nb = r % 193; d.src = F.in[I_ABIN] + (size_t)kb * 64 * AB_IN + nb * 32; d.ldsrc = AB_IN; d.dst = ws + WS_WABIN + ((size_t)nb * 32 * DM + kb * 64) * 2; d.ldd = DM; return d; } r -= P0_J1;
    if (r < P0_J2) { const int kb = 4 * (r / 64) + sub, nb = r % 64; d.src = F.in[I_ABOUT] + (size_t)kb * 64 * DM + nb * 32; d.ldsrc = DM; d.dst = ws + WS_WABOUT + ((size_t)nb * 32 * DM + kb * 64) * 2; d.ldd = DM; return d; } r -= P0_J2;
    if (r < P0_J3) { const int kb = 4 * (r / 80) + sub, nb = r % 80; d.src = F.in[I_CDIN] + (size_t)kb * 64 * CD_IN + nb * 32; d.ldsrc = CD_IN; d.dst = ws + WS_WCDIN + ((size_t)nb * 32 * DM + kb * 64) * 2; d.ldd = DM; return d; } r -= P0_J3;
    if (r < P0_J4) { const int kb = 4 * (r / 64) + sub, nb = r % 64; d.src = F.in[I_CDOUT] + (size_t)kb * 64 * DM + nb * 32; d.ldsrc = DM; d.dst = ws + WS_WCDOUT + ((size_t)nb * 32 * DM + kb * 64) * 2; d.ldd = DM; return d; } r -= P0_J4;
    if (r < P0_J5) { const int kb = 4 * (r / 48) + sub, nb = r % 48; d.valid = kb < 7; const int kbc = kb < 7 ? kb : 6; d.src = F.in[I_WUQ] + (size_t)kbc * 64 * 1536 + nb * 32; d.ldsrc = 1536; d.dst = ws + WS_WUQ + ((size_t)nb * 32 * 512 + kbc * 64) * 2; d.ldd = 512; return d; } r -= P0_J5;
    if (r < P0_J6) { const int kb = 4 * (r / 64) + sub, nb = r % 64; d.src = F.in[I_WUKV] + (size_t)kb * 64 * 2048 + nb * 32; d.ldsrc = 2048; d.dst = ws + WS_WUKV + ((size_t)nb * 32 * 512 + kb * 64) * 2; d.ldd = 512; return d; } r -= P0_J6;
    d.fp8 = 1;
    if (r < 2 * P0_JE) { const int up = r >= P0_JE; if (up) r -= P0_JE; const int le = r / 128, q = r % 128, kb = 4 * (q / 16) + sub, nb = q % 16, l = le >> 6, e = le & 63; const int n0 = nb * 32;
        d.src = (up ? F.in[I_EU] : F.in[I_EG]) + ((size_t)le * DM + kb * 64) * EFF + n0; d.ldsrc = EFF; d.scale = 64.f;
        d.dst = ws + WS_WGU + ((size_t)(l * 65 + e) * 1024 + (n0 >> 7) * 256 + up * 128 + (n0 & 127)) * DM + kb * 64; d.ldd = DM; return d; } r -= 2 * P0_JE;
    if (r < P0_JE) { const int le = r / 128, q = r % 128, kb = 4 * (q / 64) + sub, nb = q % 64, l = le >> 6, e = le & 63;
        d.src = F.in[I_ED] + ((size_t)le * EFF + kb * 64) * DM + nb * 32; d.ldsrc = DM; d.scale = 32.f; d.dst = ws + WS_WDN + ((size_t)(l * 65 + e) * 2048 + nb * 32) * EFF + kb * 64; d.ldd = EFF; return d; } r -= P0_JE;
    if (r < 2 * P0_JS) { const int up = r >= P0_JS; if (up) r -= P0_JS; const int l = r / 128, q = r % 128, kb = 4 * (q / 16) + sub, nb = q % 16; const int n0 = nb * 32;
        d.src = (up ? F.in[I_SU] : F.in[I_SG]) + ((size_t)l * DM + kb * 64) * EFF + n0; d.ldsrc = EFF; d.scale = 64.f;
        d.dst = ws + WS_WGU + ((size_t)(l * 65 + 64) * 1024 + (n0 >> 7) * 256 + up * 128 + (n0 & 127)) * DM + kb * 64; d.ldd = DM; return d; } r -= 2 * P0_JS;
    {   const int l = r / 128, q = r % 128, kb = 4 * (q / 64) + sub, nb = q % 64;
        d.src = F.in[I_SD] + ((size_t)l * EFF + kb * 64) * DM + nb * 32; d.ldsrc = DM; d.scale = 32.f; d.dst = ws + WS_WDN + ((size_t)(l * 65 + 64) * 2048 + nb * 32) * EFF + kb * 64; d.ldd = EFF; return d; }
}
__device__ __forceinline__ void p0_prologue(Frame& F) {
    unsigned char* ws = F.ws;
    LAS float* sil = (LAS float*)(F.lds + LDS_AUX);
#pragma unroll
    for (int ii = 0; ii < 3 * DM / 512; ++ii) { const int i = F.tid + 512 * ii; const int v = i / DM, k = i % DM; const float c = v < 2 ? F.in[I_C][v * DM + k] : F.in[I_CCTX][k]; sil[i] = c / (1.f + __expf(-c)); }
    __syncthreads();
    if (F.gw < 2 * 16 * 48) {
        const int l = F.gw / 768, r = F.gw % 768, ks = r / 48, cg = r % 48;
        const float* W = F.in[I_MODW] + ((size_t)l * DM + ks * 128) * 12288 + cg * 256 + F.lane * 4;
        f32x4 a0 = {0, 0, 0, 0}, a1 = a0, a2 = a0;
#pragma unroll 8
        for (int k = 0; k < 128; ++k) { const f32x4 w = __builtin_nontemporal_load((const f32x4*)(W + (size_t)k * 12288)); const float s0 = sil[ks * 128 + k], s1 = sil[DM + ks * 128 + k], s2 = sil[2 * DM + ks * 128 + k];
            a0 += w * s0; a1 += w * s1; a2 += w * s2; }
        float* o = (float*)(ws + WS_MODP) + ((size_t)(l * 16 + ks) * 3) * 12288 + cg * 256 + F.lane * 4;
        *(f32x4*)(o) = a0; *(f32x4*)(o + 12288) = a1; *(f32x4*)(o + 2 * 12288) = a2;
    }
    if (F.bid == 0) {
        f32x2* t64 = (f32x2*)(ws + WS_ROPE); f32x2* t128 = (f32x2*)(ws + WS_ROPE + 65536);
        for (int i = F.tid; i < 128 * 16; i += 512) { const int pos = i >> 4, j = i & 15; const float inv = exp2f(-(float)j * (13.287712379549449f / 16.f)); const float a = (float)pos * inv * 0.15915494309189535f; t64[i] = (f32x2){__builtin_amdgcn_cosf(a), __builtin_amdgcn_sinf(a)}; }
        for (int i = F.tid; i < 128 * 32; i += 512) { const int pos = i >> 5, j = i & 31; const float inv = exp2f(-(float)j * (13.287712379549449f / 32.f)); const float a = (float)pos * inv * 0.15915494309189535f; t128[i] = (f32x2){__builtin_amdgcn_cosf(a), __builtin_amdgcn_sinf(a)}; }
    }
    for (int i = F.bid * 512 + F.tid; i < 2 * 256 * 512; i += F.G * 512) {
        const int k8 = i & 511, r = (i >> 9) & 255, l = i >> 17; const int k0 = k8 * 8;
        unsigned o[8];
#pragma unroll
        for (int j = 0; j < 8; ++j) { const int k = k0 + j; float val = 0.f;
            if (r < 128 && (r < 64 || k < 2048)) { const float w = F.in[I_RW][((size_t)l * DM + (k & 2047)) * 64 + (r & 63)]; const float h = bf2f(f2bf(w)); val = r < 64 ? h : (w - h); }
            o[j] = f2bf(val); }
        u32x4 w4 = {o[0] | (o[1] << 16), o[2] | (o[3] << 16), o[4] | (o[5] << 16), o[6] | (o[7] << 16)};
        *(u32x4*)((bf16_t*)(ws + WS_WRT) + ((size_t)(l * 256 + r) * 4096 + k0)) = w4;
    }
    for (int i = F.bid * 512 + F.tid; i < 224 * 256; i += F.G * 512) *(u32x4*)((bf16_t*)(ws + WS_WABIN) + (size_t)AB_IN * DM + (size_t)i * 8) = (u32x4){0, 0, 0, 0};
    for (int i = F.bid * 512 + F.tid; i < 1536 * 8; i += F.G * 512) *(u32x4*)((bf16_t*)(ws + WS_WUQ) + (size_t)(i >> 3) * 512 + 448 + (i & 7) * 8) = (u32x4){0, 0, 0, 0};
    LAS float* scr = (LAS float*)(F.lds + LDS_SCR + F.wave * 16384);
    const int kk = F.lane >> 3, n4 = (F.lane & 7) * 4;
    auto load8 = [&](const TrDesc& d, f32x4 (&v)[8]) {
#pragma unroll
        for (int i = 0; i < 8; ++i) v[i] = __builtin_nontemporal_load((const f32x4*)(d.src + (size_t)(8 * i + kk) * d.ldsrc + n4)); };
    auto finish = [&](const TrDesc& d, f32x4 (&v)[8]) {
#pragma unroll
        for (int i = 0; i < 8; ++i) { LAS float* q = scr + (8 * i + kk) * 33 + n4; q[0] = v[i].x; q[1] = v[i].y; q[2] = v[i].z; q[3] = v[i].w; }
        LDS_WAIT(); asm volatile("" ::: "memory");
        const int c = F.lane & 7;
        if (d.fp8) {
#pragma unroll
            for (int j = 0; j < 4; ++j) { const int n = (F.lane >> 3) + 8 * j; const LAS float* q = scr + (8 * c) * 33 + n; const float sc = d.scale;
                int w0 = __builtin_amdgcn_cvt_pk_fp8_f32(q[0 * 33] * sc, q[1 * 33] * sc, 0, false); w0 = __builtin_amdgcn_cvt_pk_fp8_f32(q[2 * 33] * sc, q[3 * 33] * sc, w0, true);
                int w1 = __builtin_amdgcn_cvt_pk_fp8_f32(q[4 * 33] * sc, q[5 * 33] * sc, 0, false); w1 = __builtin_amdgcn_cvt_pk_fp8_f32(q[6 * 33] * sc, q[7 * 33] * sc, w1, true);
                *(u32x2*)(d.dst + (size_t)n * d.ldd + 8 * c) = (u32x2){(unsigned)w0, (unsigned)w1}; }
        } else {
#pragma unroll
            for (int j = 0; j < 4; ++j) { const int n = (F.lane >> 3) + 8 * j; const LAS float* q = scr + (8 * c) * 33 + n;
                u32x4 o; o.x = cvt_pk_bf16(q[0 * 33], q[1 * 33]); o.y = cvt_pk_bf16(q[2 * 33], q[3 * 33]); o.z = cvt_pk_bf16(q[4 * 33], q[5 * 33]); o.w = cvt_pk_bf16(q[6 * 33], q[7 * 33]);
                *(u32x4*)(d.dst + ((size_t)n * d.ldd + 8 * c) * 2) = o; }
        }
        LDS_WAIT(); asm volatile("" ::: "memory"); };
    LAS unsigned char* scr8 = (LAS unsigned char*)scr;
    auto load8k = [&](const TrDesc& d, f32x4 (&v)[8]) {
#pragma unroll
        for (int i = 0; i < 8; ++i) v[i] = __builtin_nontemporal_load((const f32x4*)(d.src + (size_t)(32 * (i >> 2) + 4 * kk + (i & 3)) * d.ldsrc + n4)); };
    auto stage8 = [&](const TrDesc& d, f32x4 (&v)[8], int sblk) { const float sc = d.scale;
#pragma unroll
        for (int h = 0; h < 2; ++h) {
#pragma unroll
            for (int cmp = 0; cmp < 4; ++cmp) {
                int w = __builtin_amdgcn_cvt_pk_fp8_f32(v[4 * h][cmp] * sc, v[4 * h + 1][cmp] * sc, 0, false); w = __builtin_amdgcn_cvt_pk_fp8_f32(v[4 * h + 2][cmp] * sc, v[4 * h + 3][cmp] * sc, w, true);
                *(LAS int*)(scr8 + (n4 + cmp) * 272 + 64 * sblk + 32 * h + 4 * kk) = w; } } };
    f32x4 va[8], vb[8], vc[8], vd[8];
    for (int it = F.gw; it < P0_NITEMS; it += F.NGW) {
        const TrDesc da = p0_decode(F, it, 0), db = p0_decode(F, it, 1), dc = p0_decode(F, it, 2), dd = p0_decode(F, it, 3);
        if (da.fp8) {
            load8k(da, va); load8k(db, vb); load8k(dc, vc); load8k(dd, vd);
            stage8(da, va, 0); stage8(db, vb, 1); stage8(dc, vc, 2); stage8(dd, vd, 3);
            LDS_WAIT(); asm volatile("" ::: "memory");
#pragma unroll
            for (int i = 0; i < 8; ++i) { const int p = F.lane + 64 * i, row = p >> 4, cb = (p & 15) * 16;
                const u32x4 v = *(const LAS u32x4*)(scr8 + row * 272 + cb);
                __builtin_nontemporal_store(v, (u32x4*)(da.dst + (size_t)row * da.ldd + cb)); }
            LDS_WAIT(); asm volatile("" ::: "memory");
        } else {
            load8(da, va); load8(db, vb); load8(dc, vc); load8(dd, vd);
            finish(da, va); finish(db, vb); finish(dc, vc); if (dd.valid) finish(dd, vd);
        }
    }
}

__device__ __forceinline__ void load_row_f32(const float* p, int lane, f32x4 (&v)[8]) {
#pragma unroll
    for (int j = 0; j < 8; ++j) v[j] = __builtin_nontemporal_load((const f32x4*)(p + 4 * lane + 256 * j));
}
__device__ __forceinline__ void load_row_bf16(const bf16_t* p, int lane, f32x4 (&v)[8]) {
#pragma unroll
    for (int j = 0; j < 8; ++j) { const u32x2 w = __builtin_nontemporal_load((const u32x2*)(p + 4 * lane + 256 * j)); v[j] = (f32x4){bflo(w.x), bfhi(w.x), bflo(w.y), bfhi(w.y)}; }
}
__device__ __forceinline__ void load_row_fp8(const unsigned char* p, int lane, f32x4 (&v)[8]) {
#pragma unroll
    for (int j = 0; j < 8; ++j) { const int w = *(const int*)(p + 4 * lane + 256 * j); const f32x2 lo = __builtin_amdgcn_cvt_pk_f32_fp8(w, false), hi = __builtin_amdgcn_cvt_pk_f32_fp8(w, true); v[j] = (f32x4){lo.x, lo.y, hi.x, hi.y}; }
}
__device__ __forceinline__ float row_rstd(const f32x4 (&v)[8]) {
    float s = 0.f;
#pragma unroll
    for (int j = 0; j < 8; ++j) s += (v[j].x * v[j].x + v[j].y * v[j].y) + (v[j].z * v[j].z + v[j].w * v[j].w);
    return rsqrtf(wave_sum(s) * (1.f / DM) + NORM_EPS);
}
__device__ __forceinline__ void store_row_bf16(bf16_t* p, int lane, const f32x4 (&v)[8]) {
#pragma unroll
    for (int j = 0; j < 8; ++j) { u32x2 w; w.x = cvt_pk_bf16(v[j].x, v[j].y); w.y = cvt_pk_bf16(v[j].z, v[j].w); *(u32x2*)(p + 4 * lane + 256 * j) = w; }
}
__device__ __forceinline__ void store_row_bf16_nt(bf16_t* p, int lane, const f32x4 (&v)[8]) {
#pragma unroll
    for (int j = 0; j < 8; ++j) { u32x2 w; w.x = cvt_pk_bf16(v[j].x, v[j].y); w.y = cvt_pk_bf16(v[j].z, v[j].w); __builtin_nontemporal_store(w, (u32x2*)(p + 4 * lane + 256 * j)); }
}
#define LV4(tab, idx) (*(const LAS f32x4*)((tab) + (idx)))
__device__ __forceinline__ void lds_load_vec(Frame& F, LAS float* dst, const float* src) { for (int i = F.tid; i < DM / 4; i += 512) *(LAS f32x4*)(dst + 4 * i) = *(const f32x4*)(src + 4 * i); }

__device__ __forceinline__ void p1_norm0(Frame& F) {
    unsigned char* ws = F.ws;
    const float* modp = (const float*)(ws + WS_MODP); float* modf = (float*)(ws + WS_MODF);
    LAS float* T = (LAS float*)(F.lds + LDS_SCR);
#pragma unroll 6
    for (int i = F.tid; i < 6 * DM; i += 512) { const int t = i / DM, k = i % DM, ch = t / 3, v = t % 3; const int idx = ch * DM + k;
        float s = F.in[I_MODB][idx];
#pragma unroll
        for (int ks = 0; ks < 16; ++ks) s += modp[((size_t)(0 * 16 + ks) * 3 + v) * 12288 + idx];
        T[i] = s; }
    for (int i = F.tid; i < DM; i += 512) T[6 * DM + i] = F.in[I_NMPRE][i];
    if (F.bid < 36) { const int base = F.bid * 2048;
        for (int i = F.tid; i < 2048; i += 512) { const int g = base + i, l = g / 36864, rem = g % 36864, v = rem / 12288, idx = rem % 12288;
            float s = F.in[I_MODB][l * 12288 + idx];
#pragma unroll
            for (int ks = 0; ks < 16; ++ks) s += modp[((size_t)(l * 16 + ks) * 3 + v) * 12288 + idx];
            modf[g] = s; } }
    __syncthreads();
    bf16_t* HN = (bf16_t*)(ws + WS_HN);
    for (int r = F.gw; r < MROWS; r += F.NGW) {
        f32x4 v[8]; load_row_f32(src_row(F, r), F.lane, v); const float rs = row_rstd(v); const int var = row_variant(r);
#pragma unroll
        for (int j = 0; j < 8; ++j) { const int c = 4 * F.lane + 256 * j; const f32x4 g = LV4(T + 6 * DM, c), sh = LV4(T + var * DM, c), sc = LV4(T + (3 + var) * DM, c);
            v[j] = v[j] * rs * g * (sc + 1.f) + sh; }
        store_row_bf16(HN + (size_t)r * DM, F.lane, v);
    }
}

constexpr float YS_SCALE = 16.f, YS_INV = 1.f / 16.f;
constexpr int STASH_OFF = 2048, STASH_MAX = 21;
struct PolPlain {
    static constexpr bool PERM = true, GATHER = false, FP8 = false, PERM16 = false; static constexpr int scale_w = 0, scale_x = 0;
    const bf16_t* A; const bf16_t* Bt; bf16_t* C; unsigned lda, ldb; size_t ldc; int nt, nM, nN, G, c; bool lat; int pv;
    __device__ __forceinline__ bool next(int i, pg8::Unit& u) const { int pm, pn; if (!pg8::static_order(nM, nN, G, c, i, pm, pn)) return false; u.pm = lat ? pm + 1 + (pm >= 32) : pm; u.pn = pn; u.ex = 0; u.rows = 256; u.idx = 0; return true; }
    __device__ __forceinline__ const char* a_base(const pg8::Unit& u) const { return (const char*)A + (size_t)u.pm * 256 * lda; }
    __device__ __forceinline__ void a_off(const pg8::Unit&, int R0, int R1, int C0, int C1, unsigned (&o)[2][2]) const {
        o[0][0] = (unsigned)R0 * lda + C0 * 2; o[0][1] = (unsigned)R1 * lda + C1 * 2; o[1][0] = (unsigned)(R0 + 128) * lda + C0 * 2; o[1][1] = (unsigned)(R1 + 128) * lda + C1 * 2; }
    __device__ __forceinline__ const char* b_base(const pg8::Unit& u) const { return (const char*)Bt + (size_t)u.pn * 256 * ldb; }
    __device__ __forceinline__ void epi(const f32x4 (&acc)[2][2][4][2], const pg8::Unit& u, int wr, int wc, int fr, int fq) const {
        if (pv != 0) { float sum = 0.f;
#pragma unroll
            for (int ai = 0; ai < 2; ++ai)
#pragma unroll
                for (int m = 0; m < 4; ++m) sum += acc[ai][0][m][0][0] + acc[ai][1][m][1][3];
            if (sum == 12345.678f) C[0] = 0; return; }
        pg8::store_tile_bf16(acc, C + (size_t)u.pm * 256 * ldc + (size_t)u.pn * 256, ldc, wr, wc, fr, fq, 256); }
};
struct PolUqUkv {
    static constexpr bool PERM = true, GATHER = false, FP8 = false, PERM16 = false; static constexpr int scale_w = 0, scale_x = 0;
    const bf16_t *CKVN, *CQN, *Wukv, *Wuq; bf16_t *KV, *QB; unsigned ldb; int nt, G, c;
    __device__ __forceinline__ bool next(int i, pg8::Unit& u) const { const long L = (long)i * G + c; if (L >= 528 + 384) return false;
        if (L < 528) { u.ex = 0; u.pm = (int)L / 8; u.pn = (int)L % 8; } else { const int q = (int)L - 528; u.ex = 1; const int pm = q / 6; u.pm = pm + 1 + (pm >= 32); u.pn = q % 6; } u.rows = 256; u.idx = 0; return true; }
    __device__ __forceinline__ const char* a_base(const pg8::Unit& u) const { return (const char*)(u.ex ? CQN : CKVN) + (size_t)u.pm * 256 * 1024; }
    __device__ __forceinline__ void a_off(const pg8::Unit&, int R0, int R1, int C0, int C1, unsigned (&o)[2][2]) const {
        o[0][0] = (unsigned)R0 * 1024u + C0 * 2; o[0][1] = (unsigned)R1 * 1024u + C1 * 2; o[1][0] = (unsigned)(R0 + 128) * 1024u + C0 * 2; o[1][1] = (unsigned)(R1 + 128) * 1024u + C1 * 2; }
    __device__ __forceinline__ const char* b_base(const pg8::Unit& u) const { return (const char*)(u.ex ? Wuq : Wukv) + (size_t)u.pn * 256 * 1024; }
    __device__ __forceinline__ void epi(const f32x4 (&acc)[2][2][4][2], const pg8::Unit& u, int wr, int wc, int fr, int fq) const {
        const size_t ldc = u.ex ? 1536 : 2048; bf16_t* base = (u.ex ? QB : KV) + (size_t)u.pm * 256 * ldc + (size_t)u.pn * 256;
        pg8::store_tile_bf16(acc, base, ldc, wr, wc, fr, fq, 256); }
};
struct PolCtxSplit {
    static constexpr bool PERM = false, GATHER = false, FP8 = false, PERM16 = false; static constexpr int scale_w = 0, scale_x = 0;
    const bf16_t* A; const bf16_t* Bt; float* C; unsigned lda, ldb; int nt, G, c;
    __device__ __forceinline__ bool next(int i, pg8::Unit& u) const { if (i != 0 || c >= 128) return false; const int un = c >> 3; u.ex = c & 7; u.pn = un & 7; u.idx = un >> 3; u.pm = (un >> 3) * 33; u.rows = 256; return true; }
    __device__ __forceinline__ const char* a_base(const pg8::Unit& u) const { return (const char*)A + (size_t)u.pm * 256 * lda + (size_t)u.ex * 512; }
    __device__ __forceinline__ void a_off(const pg8::Unit&, int R0, int R1, int C0, int C1, unsigned (&o)[2][2]) const {
        o[0][0] = (unsigned)R0 * lda + C0 * 2; o[0][1] = (unsigned)R1 * lda + C1 * 2; o[1][0] = (unsigned)(R0 + 128) * lda + C0 * 2; o[1][1] = (unsigned)(R1 + 128) * lda + C1 * 2; }
    __device__ __forceinline__ const char* b_base(const pg8::Unit& u) const { return (const char*)Bt + (size_t)u.pn * 256 * ldb + (size_t)u.ex * 512; }
    __device__ __forceinline__ void epi(const f32x4 (&acc)[2][2][4][2], const pg8::Unit& u, int wr, int wc, int fr, int fq) const {
        float* base = C + ((size_t)u.ex * 512 + (size_t)u.idx * 256) * DM + (size_t)u.pn * 256;
#pragma unroll
        for (int ai = 0; ai < 2; ++ai)
#pragma unroll
            for (int m = 0; m < 4; ++m) { float* rowp = base + (size_t)(ai * 128 + wr * 64 + m * 16 + fr) * DM + wc * 32 + 4 * fq;
#pragma unroll
                for (int bj = 0; bj < 2; ++bj)
#pragma unroll
                    for (int n = 0; n < 2; ++n) *(f32x4*)(rowp + bj * 128 + n * 16) = acc[ai][bj][m][n]; }
    }
};
struct PolRouter {
    static constexpr bool PERM = false, GATHER = false, FP8 = false, PERM16 = false; static constexpr int scale_w = 0, scale_x = 0;
    const bf16_t* A; const bf16_t* Bt; float* C; unsigned ldb; int nt, nM, G, c; bool lat;
    __device__ __forceinline__ bool next(int i, pg8::Unit& u) const { int pm, pn; if (!pg8::static_order(nM, 4, G, c, i, pm, pn)) return false; u.pm = lat ? pm + 1 + (pm >= 32) : pm; u.pn = 0; u.ex = pn; u.rows = 256; u.idx = 0; return true; }
    __device__ __forceinline__ const char* a_base(const pg8::Unit& u) const { return (const char*)A + (size_t)u.pm * 256 * 8192 + (size_t)u.ex * 1024; }
    __device__ __forceinline__ void a_off(const pg8::Unit&, int R0, int R1, int C0, int C1, unsigned (&o)[2][2]) const {
        o[0][0] = (unsigned)R0 * 8192u + C0 * 2; o[0][1] = (unsigned)R1 * 8192u + C1 * 2; o[1][0] = (unsigned)(R0 + 128) * 8192u + C0 * 2; o[1][1] = (unsigned)(R1 + 128) * 8192u + C1 * 2; }
    __device__ __forceinline__ const char* b_base(const pg8::Unit& u) const { return (const char*)Bt + (size_t)u.ex * 1024; }
    __device__ __forceinline__ void epi(const f32x4 (&acc)[2][2][4][2], const pg8::Unit& u, int wr, int wc, int fr, int fq) const {
        float* base = C + ((size_t)u.ex * MROWS + (size_t)u.pm * 256) * 256;
#pragma unroll
        for (int ai = 0; ai < 2; ++ai)
#pragma unroll
            for (int m = 0; m < 4; ++m) { float* rowp = base + (size_t)(ai * 128 + wr * 64 + m * 16 + fr) * 256 + wc * 32 + 4 * fq;
#pragma unroll
                for (int n = 0; n < 2; ++n) *(f32x4*)(rowp + n * 16) = acc[ai][0][m][n]; }
    }
};
template <int NT_N>
__device__ __forceinline__ bool grouped_next(const LAS int* tab, int G, int c, int i, pg8::Unit& u) {
    const int nb = tab[48]; const long L = (long)i * nb + (c >> 3); const int total = tab[9] * NT_N; if (L >= total) return false;
    const int tile = (int)L / NT_N; u.pn = (int)L % NT_N;
    int it = 0;
#pragma unroll
    for (int k = 1; k < 9; ++k) it += (tab[k] <= tile) ? 1 : 0;
    u.ex = tab[16 + it]; u.pm = tile - tab[it] + tab[32 + it]; const int rem = tab[128 + u.ex] - u.pm * 256; u.rows = rem < 256 ? rem : 256; u.idx = i; return true;
}
__device__ __forceinline__ int slot_token(int slot) { return slot < NSLOT ? slot / TOPK : slot - NSLOT; }
struct PolGU {
    static constexpr bool PERM = true, GATHER = true, FP8 = true, PERM16 = false; static constexpr int scale_w = 0x79797979, scale_x = 0x7c7c7c7c;
    const unsigned char* FN2; const unsigned char* W; unsigned char* H; const LAS int* st; const LAS int* tab; unsigned ldb; int nt, G, c, ibase, pv;
    __device__ __forceinline__ bool next(int i, pg8::Unit& u) const { if (i >= STASH_MAX || !grouped_next<4>(tab, G, c, i + ibase, u)) return false; u.idx = i; return true; }
    __device__ __forceinline__ const char* a_base(const pg8::Unit&) const { return (const char*)FN2; }
    __device__ __forceinline__ void a_off(const pg8::Unit& u, int R0, int R1, int C0, int C1, unsigned (&o)[2][2]) const {
        if (pv == 2) { const unsigned b0 = (unsigned)((u.ex * 200 + u.pm * 256) % 16000); o[0][0] = (b0 + R0) * 2048u + C0 * 2; o[0][1] = (b0 + R1) * 2048u + C1 * 2; o[1][0] = (b0 + R0 + 128) * 2048u + C0 * 2; o[1][1] = (b0 + R1 + 128) * 2048u + C1 * 2; return; }
        const LAS int* lp = st + u.idx * 256; const int s00 = lp[R0], s01 = lp[R1], s10 = lp[R0 + 128], s11 = lp[R1 + 128];
        o[0][0] = (unsigned)slot_token(s00) * 2048u + C0 * 2; o[0][1] = (unsigned)slot_token(s01) * 2048u + C1 * 2; o[1][0] = (unsigned)slot_token(s10) * 2048u + C0 * 2; o[1][1] = (unsigned)slot_token(s11) * 2048u + C1 * 2; }
    __device__ __forceinline__ const char* b_base(const pg8::Unit& u) const { return (const char*)W + ((size_t)(pv == 1 ? 0 : u.ex) * 1024 + (size_t)u.pn * 256) * 2048; }
    __device__ __forceinline__ void epi(const f32x4 (&acc)[2][2][4][2], const pg8::Unit& u, int wr, int wc, int fr, int fq) const {
#pragma unroll
        for (int ai = 0; ai < 2; ++ai) { int slots[4];
#pragma unroll
            for (int m = 0; m < 4; ++m) slots[m] = st[u.idx * 256 + ai * 128 + wr * 64 + m * 16 + fr];
#pragma unroll
            for (int m = 0; m < 4; ++m) { const int r = ai * 128 + wr * 64 + m * 16 + fr; if (r < u.rows) { const int slot = slots[m];
                const f32x4 g0 = acc[ai][0][m][0], g1 = acc[ai][0][m][1], u0 = acc[ai][1][m][0], u1 = acc[ai][1][m][1]; float h[8];
#pragma unroll
                for (int j = 0; j < 4; ++j) { h[j] = g0[j] * u0[j] * __builtin_amdgcn_rcpf(1.f + __expf(-g0[j])); h[4 + j] = g1[j] * u1[j] * __builtin_amdgcn_rcpf(1.f + __expf(-g1[j])); }
#pragma unroll
                for (int j = 0; j < 8; ++j) h[j] = clamp8(h[j] * 4.f);
                int w0 = __builtin_amdgcn_cvt_pk_fp8_f32(h[0], h[1], 0, false); w0 = __builtin_amdgcn_cvt_pk_fp8_f32(h[2], h[3], w0, true);
                int w1 = __builtin_amdgcn_cvt_pk_fp8_f32(h[4], h[5], 0, false); w1 = __builtin_amdgcn_cvt_pk_fp8_f32(h[6], h[7], w1, true);
                *(u32x2*)(H + (size_t)slot * EFF + u.pn * 128 + wc * 32 + 8 * fq) = (u32x2){(unsigned)w0, (unsigned)w1}; } } }
    }
};
struct PolDN {
    static constexpr bool PERM = true, GATHER = true, FP8 = true, PERM16 = true; static constexpr int scale_w = 0x7a7a7a7a, scale_x = 0x7d7d7d7d;
    const unsigned char* H; const unsigned char* W; unsigned char* YS; const LAS int* st; const LAS int* tab; unsigned ldb; int nt, G, c, ibase; int pv;
    __device__ __forceinline__ bool next(int i, pg8::Unit& u) const { if (i >= STASH_MAX || !grouped_next<8>(tab, G, c, i + ibase, u)) return false; u.idx = i; return true; }
    __device__ __forceinline__ const char* a_base(const pg8::Unit&) const { return (const char*)H; }
    __device__ __forceinline__ void a_off(const pg8::Unit& u, int R0, int R1, int C0, int C1, unsigned (&o)[2][2]) const {
        const int r00 = R0, r01 = R1, r10 = R0 + 128, r11 = R1 + 128;
        if (pv == 2) { const unsigned b0 = (unsigned)(u.ex * 256 + u.pm * 256); o[0][0] = (b0 + r00) * 512u + C0 * 2; o[0][1] = (b0 + r01) * 512u + C1 * 2; o[1][0] = (b0 + r10) * 512u + C0 * 2; o[1][1] = (b0 + r11) * 512u + C1 * 2; return; }
        const LAS int* lp = st + u.idx * 256; o[0][0] = (unsigned)lp[r00] * 512u + C0 * 2; o[0][1] = (unsigned)lp[r01] * 512u + C1 * 2; o[1][0] = (unsigned)lp[r10] * 512u + C0 * 2; o[1][1] = (unsigned)lp[r11] * 512u + C1 * 2; }
    __device__ __forceinline__ const char* b_base(const pg8::Unit& u) const { return (const char*)W + ((size_t)u.ex * 2048 + (size_t)u.pn * 256) * 512; }
    __device__ __forceinline__ void epi(const f32x4 (&acc)[2][2][4][2], const pg8::Unit& u, int wr, int wc, int fr, int fq) const {
        if (pv != 0 && pv != 4) { float sum = 0.f;
#pragma unroll
            for (int ai = 0; ai < 2; ++ai)
#pragma unroll
                for (int m = 0; m < 4; ++m) sum += acc[ai][0][m][0][0] + acc[ai][1][m][1][3];
            if (sum == 12345.678f) YS[0] = 0; return; }
#pragma unroll
        for (int ai = 0; ai < 2; ++ai) { int slots[4];
#pragma unroll
            for (int m = 0; m < 4; ++m) slots[m] = st[u.idx * 256 + ai * 128 + wr * 64 + m * 16 + fr];
#pragma unroll
            for (int m = 0; m < 4; ++m) { const int r = ai * 128 + wr * 64 + m * 16 + fr; if (r < u.rows) { const int slot = (pv == 4) ? (122880 + (slots[m] & 1023)) : slots[m];     unsigned char* rowp = (unsigned char*)YS + (size_t)slot * DM + u.pn * 256 + wc * 64 + 16 * fq;
                unsigned w[4];
#pragma unroll
                for (int bj = 0; bj < 2; ++bj) { const f32x4 v0 = acc[ai][bj][m][0] * YS_SCALE, v1 = acc[ai][bj][m][1] * YS_SCALE;
                    int w0 = __builtin_amdgcn_cvt_pk_fp8_f32(clamp8(v0[0]), clamp8(v0[1]), 0, false); w0 = __builtin_amdgcn_cvt_pk_fp8_f32(clamp8(v0[2]), clamp8(v0[3]), w0, true);
                    int w1 = __builtin_amdgcn_cvt_pk_fp8_f32(clamp8(v1[0]), clamp8(v1[1]), 0, false); w1 = __builtin_amdgcn_cvt_pk_fp8_f32(clamp8(v1[2]), clamp8(v1[3]), w1, true);
                    w[2 * bj] = (unsigned)w0; w[2 * bj + 1] = (unsigned)w1; }
                *(u32x4*)rowp = (u32x4){w[0], w[1], w[2], w[3]}; } } }
    }
};
__device__ __forceinline__ void build_group_table(Frame& F, const unsigned* cnt) {
    LAS int* tab = (LAS int*)(F.lds + LDS_AUX);
    const int x = F.bid & 7;
    if (F.tid < 64) {
        const int c = (int)cnt[F.tid]; tab[128 + F.tid] = c; int v = (c + 255) >> 8; const int tiles = v;
        v += __shfl_xor(v, 8); v += __shfl_xor(v, 16); v += __shfl_xor(v, 32);
        if (F.tid < 8) tab[64 + F.tid] = v;
        tab[200 + F.tid] = tiles;
        if (F.tid == 0) tab[128 + 64] = (int)cnt[64];
    }
    __syncthreads();
    if (F.tid == 0) {
        const int S = (tab[128 + 64] + 255) >> 8; int tot = S; for (int y = 0; y < 8; ++y) tot += tab[64 + y];
        const int target = (tot + 7) >> 3; int rem = S, start = 0, mys = 0, mystart = 0;
        for (int y = 0; y < 8; ++y) { int sy = target - tab[64 + y]; sy = sy < 0 ? 0 : sy; sy = sy > rem ? rem : sy; if (y == 7) sy = rem; if (y == x) { mys = sy; mystart = start; } start += sy; rem -= sy; }
        int acc = 0;
        for (int k = 0; k < 8; ++k) { const int e = x + 8 * k; tab[k] = acc; tab[16 + k] = e; tab[32 + k] = 0; acc += tab[200 + e]; }
        tab[8] = acc; tab[16 + 8] = 64; tab[32 + 8] = mystart; acc += mys; tab[9] = acc;
        tab[48] = (F.G - x + 7) >> 3;
    }
    __syncthreads();
}

template <int NT_N> __device__ __forceinline__ int group_units(Frame& F) { const LAS int* tab = (const LAS int*)(F.lds + LDS_AUX); const int nb = tab[48], total = tab[9] * NT_N, rank = F.bid >> 3; return total > rank ? (total - rank + nb - 1) / nb : 0; }
template <int NT_N>
__device__ __forceinline__ void stash_lists(Frame& F, const int* list, int ibase) {
    const LAS int* tab = (const LAS int*)(F.lds + LDS_AUX); LAS int* st = (LAS int*)(F.lds + LDS_AUX + STASH_OFF);
    const int t = F.tid & 255, par = F.tid >> 8;
    __syncthreads();
    for (int i = par; i < STASH_MAX; i += 2) { pg8::Unit u; if (!grouped_next<NT_N>(tab, F.G, F.bid, i + ibase, u)) break;
        st[i * 256 + t] = list[(size_t)u.ex * MROWS + u.pm * 256 + (t < u.rows ? t : u.rows - 1)]; }
    __syncthreads();
}

__device__ __forceinline__ f32x16 mma32(f32x16 acc, const LAS unsigned char* A, int pa, const LAS unsigned char* B, int pb, int ksteps, int r32, int hi) {
    const LAS unsigned char* ap = A + r32 * pa + hi * 16; const LAS unsigned char* bp = B + r32 * pb + hi * 16;
    for (int ks = 0; ks < ksteps; ++ks) { const bf16x8 a = *(const LAS bf16x8*)(ap + ks * 32), b = *(const LAS bf16x8*)(bp + ks * 32);
        acc = __builtin_amdgcn_mfma_f32_32x32x16_bf16(a, b, acc, 0, 0, 0); }
    return acc;
}
constexpr int ML_VT = 0, ML_QS = 34816, ML_KS = 53248, ML_PM = 71680, ML_QD = 106496, ML_HS = 53248;
constexpr int P64 = 144, P128 = 272;
constexpr int AX_IF = 0, AX_LF = 128, AX_IB = 256, AX_LB = 384, AX_WF = 512, AX_WB = 640, AX_AF = 768, AX_MF = 896, AX_WIF = 1024, AX_EMF = 1152, AX_AB = 1280, AX_MB = 1408, AX_WIB = 1536, AX_EMB = 1664,
              AX_DEN = 1792, AX_NST = 1920  , AX_SC = 2048  ;

__device__ __forceinline__ void ml_load_gates(Frame& F, const bf16_t* Prow0, int h, LAS float* ax) {
    const int t = F.tid & 127, ty = F.tid >> 7;
    const float v = bf2f(Prow0[(size_t)t * AB_INP + C_GT + ty * 8 + h]) + F.in[I_MGB][ty * 8 + h];
    ax[ty * 128 + t] = (ty & 1) ? logsigmoidf_(v) : v;
}
__device__ __forceinline__ void ml_load_vt(Frame& F, const bf16_t* Prow0, int h) {
    const int t = F.tid >> 2, vq = F.tid & 3; const bf16_t* src = Prow0 + (size_t)t * AB_INP + C_MV + h * 128 + vq * 32;
    LAS bf16_t* VT = (LAS bf16_t*)(F.lds + ML_VT);
    bf16x8 x[4];
#pragma unroll
    for (int i = 0; i < 4; ++i) x[i] = *(const bf16x8*)(src + i * 8);
    __builtin_amdgcn_sched_barrier(0);
#pragma unroll
    for (int i = 0; i < 4; ++i) {
#pragma unroll
        for (int j = 0; j < 8; ++j) VT[(vq * 32 + i * 8 + j) * (P128 / 2) + t] = (bf16_t)x[i][j]; }
}
__device__ __forceinline__ float scan_psum(float v, int lane) {
#pragma unroll
    for (int d = 1; d < 64; d <<= 1) { const float t = __shfl_up(v, d); if (lane >= d) v += t; } return v; }
__device__ __forceinline__ float scan_ssum(float v, int lane) {
#pragma unroll
    for (int d = 1; d < 64; d <<= 1) { const float t = __shfl_down(v, d); if (lane + d < 64) v += t; } return v; }
__device__ __forceinline__ float scan_pmax(float v, int lane) {
#pragma unroll
    for (int d = 1; d < 64; d <<= 1) { const float t = __shfl_up(v, d); if (lane >= d) v = fmaxf(v, t); } return v; }
__device__ __forceinline__ float scan_smax(float v, int lane) {
#pragma unroll
    for (int d = 1; d < 64; d <<= 1) { const float t = __shfl_down(v, d); if (lane + d < 64) v = fmaxf(v, t); } return v; }
__device__ __forceinline__ void mlstm_a_item(Frame& F, int b, int h, int g) {
    unsigned char* ws = F.ws; const bf16_t* Prow0 = (const bf16_t*)(ws + WS_P) + (size_t)(b * TPB + g * 128) * AB_INP;
    LAS float* ax = (LAS float*)(F.lds + LDS_AUX);
    const int r32 = F.lane & 31, hi = F.lane >> 5;
    ml_load_gates(F, Prow0, h, ax);
    ml_load_vt(F, Prow0, h);
    __syncthreads();
    if (F.wave == 0) {
        const int l = F.lane; const float x0 = ax[AX_LF + 2 * l], x1 = ax[AX_LF + 2 * l + 1], i0 = ax[AX_IF + 2 * l], i1 = ax[AX_IF + 2 * l + 1];
        const float inc = scan_ssum(x0 + x1, l), exc = inc - (x0 + x1); const float w1 = exc + i1, w0 = exc + x1 + i0;
        const float mx = wave_max(fmaxf(w0, w1)); ax[AX_WF + 2 * l] = __expf(w0 - mx); ax[AX_WF + 2 * l + 1] = __expf(w1 - mx);
        if (l == 0) { ax[AX_SC + 0] = inc; ax[AX_SC + 1] = mx; } }
    if (F.wave == 1) {
        const int l = F.lane; const float x0 = ax[AX_LB + 2 * l], x1 = ax[AX_LB + 2 * l + 1], i0 = ax[AX_IB + 2 * l], i1 = ax[AX_IB + 2 * l + 1];
        const float inc = scan_psum(x0 + x1, l), exc = inc - (x0 + x1); const float w0 = exc + i0, w1 = exc + x0 + i1;
        const float mx = wave_max(fmaxf(w0, w1)); ax[AX_WB + 2 * l] = __expf(w0 - mx); ax[AX_WB + 2 * l + 1] = __expf(w1 - mx);
        if (l == 63) ax[AX_SC + 2] = inc; if (l == 0) ax[AX_SC + 3] = mx; }
    __syncthreads();
    {
        const int t = F.tid >> 2, dq = F.tid & 3; const bf16_t* src = Prow0 + (size_t)t * AB_INP + C_MK + h * 64 + dq * 16;
        LAS bf16_t* KTf = (LAS bf16_t*)(F.lds + ML_QS); LAS bf16_t* KTb = (LAS bf16_t*)(F.lds + ML_KS);
        const float wf = ax[AX_WF + t] * 0.125f, wb = ax[AX_WB + t] * 0.125f;
        bf16x8 x[2];
#pragma unroll
        for (int i = 0; i < 2; ++i) x[i] = *(const bf16x8*)(src + i * 8);
        __builtin_amdgcn_sched_barrier(0);
#pragma unroll
        for (int i = 0; i < 2; ++i) {
#pragma unroll
            for (int j = 0; j < 8; ++j) { const float k = bf2f((unsigned short)x[i][j]); const int d = dq * 16 + i * 8 + j;
                KTf[d * (P128 / 2) + t] = (bf16_t)f2bf(k * wf); KTb[d * (P128 / 2) + t] = (bf16_t)f2bf(k * wb); } }
    }
    __syncthreads();
    const int vb = F.wave >> 1, db = F.wave & 1;
    f32x16 cf = {}, cb = {};
    cf = mma32(cf, F.lds + ML_VT + vb * 32 * P128, P128, F.lds + ML_QS + db * 32 * P128, P128, 8, r32, hi);
    cb = mma32(cb, F.lds + ML_VT + vb * 32 * P128, P128, F.lds + ML_KS + db * 32 * P128, P128, 8, r32, hi);
    const int chf = (b * 8 + h) * 2, chb = chf + 1;
    float* dCf = (float*)(ws + WS_MDC) + ((size_t)chf * 66 + g) * 8192; float* dCb = (float*)(ws + WS_MDC) + ((size_t)chb * 66 + g) * 8192;
#pragma unroll
    for (int r = 0; r < 16; ++r) { const int v = vb * 32 + att::crow(r, hi), d = db * 32 + r32; dCf[v * 64 + d] = cf[r]; dCb[v * 64 + d] = cb[r]; }
    if (F.tid < 128) { const int dir = F.tid >> 6, d = F.tid & 63; const LAS bf16_t* kt = (const LAS bf16_t*)(F.lds + (dir ? ML_KS : ML_QS)) + d * (P128 / 2);
        float s = 0.f; for (int t = 0; t < 128; ++t) s += bf2f(kt[t]);
        ((float*)(ws + WS_MSM + MSM_DN))[((size_t)(chf + dir) * 66 + g) * 64 + d] = s; }
    if (F.tid < 2) { ((float*)(ws + WS_MSM + MSM_BTOT))[(chf + F.tid) * 66 + g] = ax[AX_SC + 2 * F.tid]; ((float*)(ws + WS_MSM + MSM_MLOC))[(chf + F.tid) * 66 + g] = ax[AX_SC + 2 * F.tid + 1]; }
    __syncthreads();
}
__device__ __forceinline__ int chain_chunk(int dir, int j) { return dir == 0 ? j : (j == 0 ? 1 : (j == 1 ? 0 : 67 - j)); }
__device__ __forceinline__ void mlstm_scan_item(Frame& F, int chain, int slice) {
    unsigned char* ws = F.ws; const int dir = chain & 1;
    const float* dC = (const float*)(ws + WS_MDC) + (size_t)chain * 66 * 8192 + slice * 1024 + F.tid * 2;
    bf16_t* cst = (bf16_t*)(ws + WS_MCST) + (size_t)chain * 66 * 8192 + slice * 1024 + F.tid * 2;
    const float* btot = (const float*)(ws + WS_MSM + MSM_BTOT) + chain * 66; const float* mloc = (const float*)(ws + WS_MSM + MSM_MLOC) + chain * 66;
    const float* dn = (const float*)(ws + WS_MSM + MSM_DN) + (size_t)chain * 66 * 64; float* nst = (float*)(ws + WS_MSM + MSM_NST) + (size_t)chain * 66 * 64; float* mst = (float*)(ws + WS_MSM + MSM_MST) + chain * 66;
    float c0 = 0.f, c1 = 0.f, n = 0.f, m = 0.f; const bool don = (slice == 0 && F.tid < 64);
    f32x2 dv[66];
#pragma unroll
    for (int j = 0; j < 66; ++j) dv[j] = __builtin_nontemporal_load((const f32x2*)(dC + (size_t)j * 8192));
    LAS float* sb = (LAS float*)(F.lds + LDS_SCR);
    {   const int tc = F.tid < 66 ? F.tid : 65; const float b_ = btot[tc], m_ = mloc[tc]; float dnv[9];
#pragma unroll
        for (int k = 0; k < 9; ++k) { const int i = F.tid + 512 * k; dnv[k] = dn[i < 66 * 64 ? i : 66 * 64 - 1]; }
        if (F.tid < 66) { sb[F.tid] = b_; sb[128 + F.tid] = m_; }
#pragma unroll
        for (int k = 0; k < 9; ++k) { const int i = F.tid + 512 * k; if (i < 66 * 64) sb[256 + i] = dnv[k]; } }
    __syncthreads();
#pragma unroll
    for (int j = 0; j < 66; ++j) { const int g = chain_chunk(dir, j);
        const f32x2 d = dir == 0 ? dv[j] : dv[j == 0 ? 1 : (j == 1 ? 0 : 67 - j)]; const float bt = sb[g], ml = sb[128 + g];
        *(unsigned*)(cst + (size_t)g * 8192) = cvt_pk_bf16(c0, c1);
        if (don) { nst[g * 64 + F.tid] = n; if (F.tid == 0) mst[g] = m; }
        const float mn = fmaxf(bt + m, ml), dec = __expf(bt + m - mn), sc = __expf(ml - mn);
        c0 = dec * c0 + sc * d.x; c1 = dec * c1 + sc * d.y;
        if (don) n = dec * n + sc * sb[256 + g * 64 + F.tid];
        m = mn; }
    __syncthreads();
}
__device__ __forceinline__ void mlstm_c_item(Frame& F, int b, int h, int g) {
    unsigned char* ws = F.ws; const int row0 = b * TPB + g * 128; const bf16_t* Prow0 = (const bf16_t*)(ws + WS_P) + (size_t)row0 * AB_INP;
    LAS float* ax = (LAS float*)(F.lds + LDS_AUX);
    const int r32 = F.lane & 31, hi = F.lane >> 5; const int chf = (b * 8 + h) * 2;
    ml_load_gates(F, Prow0, h, ax);
    ml_load_vt(F, Prow0, h);
    {
        const int t = F.tid >> 2, dq = F.tid & 3;
        const bf16_t* qs = Prow0 + (size_t)t * AB_INP + C_MQ + h * 64 + dq * 16; const bf16_t* ks = Prow0 + (size_t)t * AB_INP + C_MK + h * 64 + dq * 16;
        bf16x8 qv[2], kv[2];
#pragma unroll
        for (int i = 0; i < 2; ++i) { qv[i] = *(const bf16x8*)(qs + i * 8); kv[i] = *(const bf16x8*)(ks + i * 8); }
        __builtin_amdgcn_sched_barrier(0);
#pragma unroll
        for (int i = 0; i < 2; ++i) { *(LAS bf16x8*)(F.lds + ML_QS + t * P64 + (dq * 16 + i * 8) * 2) = qv[i];
            const bf16x8 x = kv[i]; u32x4 o;
#pragma unroll
            for (int j = 0; j < 4; ++j) o[j] = cvt_pk_bf16(bf2f((unsigned short)x[2 * j]) * 0.125f, bf2f((unsigned short)x[2 * j + 1]) * 0.125f);
            *(LAS u32x4*)(F.lds + ML_KS + t * P64 + (dq * 16 + i * 8) * 2) = o; }
    }
    if (F.tid < 128) ax[AX_NST + F.tid] = ((const float*)(ws + WS_MSM + MSM_NST))[((size_t)(chf + (F.tid >> 6)) * 66 + g) * 64 + (F.tid & 63)];
    __syncthreads();
    if (F.wave == 0) {
        const int l = F.lane; const float mst = ((const float*)(ws + WS_MSM + MSM_MST))[chf * 66 + g];
        const float x0 = ax[AX_LF + 2 * l], x1 = ax[AX_LF + 2 * l + 1], i0 = ax[AX_IF + 2 * l], i1 = ax[AX_IF + 2 * l + 1];
        const float exc = scan_psum(x0 + x1, l) - (x0 + x1); const float c0 = exc + x0, c1 = c0 + x1, a0 = i0 - c0, a1 = i1 - c1;
        const float pin = scan_pmax(fmaxf(a0, a1), l); float pex = __shfl_up(pin, 1); if (l == 0) pex = -1e30f;
        const float M0 = fmaxf(mst, fmaxf(pex, a0)), M1 = fmaxf(mst, fmaxf(pex, fmaxf(a0, a1)));
        ax[AX_AF + 2 * l] = a0; ax[AX_AF + 2 * l + 1] = a1; ax[AX_MF + 2 * l] = M0; ax[AX_MF + 2 * l + 1] = M1;
        ax[AX_WIF + 2 * l] = __expf(mst - M0); ax[AX_WIF + 2 * l + 1] = __expf(mst - M1); ax[AX_EMF + 2 * l] = __expf(-(c0 + M0)); ax[AX_EMF + 2 * l + 1] = __expf(-(c1 + M1)); }
    if (F.wave == 1) {
        const int l = F.lane; const float mst = ((const float*)(ws + WS_MSM + MSM_MST))[(chf + 1) * 66 + g];
        const float x0 = ax[AX_LB + 2 * l], x1 = ax[AX_LB + 2 * l + 1], i0 = ax[AX_IB + 2 * l], i1 = ax[AX_IB + 2 * l + 1];
        const float exc = scan_ssum(x0 + x1, l) - (x0 + x1); const float c1 = exc + x1, c0 = c1 + x0, a0 = i0 - c0, a1 = i1 - c1;
        const float sin_ = scan_smax(fmaxf(a0, a1), l); float sex = __shfl_down(sin_, 1); if (l == 63) sex = -1e30f;
        const float M1 = fmaxf(mst, fmaxf(sex, a1)), M0 = fmaxf(mst, fmaxf(sex, fmaxf(a0, a1)));
        ax[AX_AB + 2 * l] = a0; ax[AX_AB + 2 * l + 1] = a1; ax[AX_MB + 2 * l] = M0; ax[AX_MB + 2 * l + 1] = M1;
        ax[AX_WIB + 2 * l] = __expf(mst - M0); ax[AX_WIB + 2 * l + 1] = __expf(mst - M1); ax[AX_EMB + 2 * l] = __expf(-(c0 + M0)); ax[AX_EMB + 2 * l + 1] = __expf(-(c1 + M1)); }
    const int qb = F.wave >> 1, sb0 = (F.wave & 1) * 2;
    f32x16 S0 = {}, S1 = {};
    S0 = mma32(S0, F.lds + ML_KS + (sb0 * 32) * P64, P64, F.lds + ML_QS + qb * 32 * P64, P64, 4, r32, hi);
    S1 = mma32(S1, F.lds + ML_KS + (sb0 * 32 + 32) * P64, P64, F.lds + ML_QS + qb * 32 * P64, P64, 4, r32, hi);
    __syncthreads();
    f32x16 H0 = {}, H1 = {};
    const int qb2 = F.wave >> 1, vb0 = (F.wave & 1) * 2;
#pragma unroll 1
    for (int dir = 0; dir < 2; ++dir) {
        const LAS float* A_ = ax + (dir ? AX_AB : AX_AF); const LAS float* M_ = ax + (dir ? AX_MB : AX_MF); const LAS float* WI_ = ax + (dir ? AX_WIB : AX_WIF); const LAS float* EM_ = ax + (dir ? AX_EMB : AX_EMF);
        {
            const int q = qb * 32 + r32; const float Mq = M_[q];
#pragma unroll
            for (int i = 0; i < 2; ++i) { const f32x16& S = i ? S1 : S0; const int sbase = (sb0 + i) * 32;
#pragma unroll
                for (int gq = 0; gq < 4; ++gq) { float p[4];
#pragma unroll
                    for (int j = 0; j < 4; ++j) { const int s = sbase + 8 * gq + 4 * hi + j; const bool keep = dir ? (s >= q) : (s <= q); p[j] = keep ? S[gq * 4 + j] * __expf(A_[s] - Mq) : 0.f; }
                    u32x2 w; w.x = cvt_pk_bf16(p[0], p[1]); w.y = cvt_pk_bf16(p[2], p[3]);
                    *(LAS u32x2*)(F.lds + ML_PM + q * P128 + (sbase + 8 * gq + 4 * hi) * 2) = w; } }
        }
        {
            const int t = F.tid >> 2, dq = F.tid & 3; const float wi = WI_[t];
            const bf16_t* cs = (const bf16_t*)(ws + WS_MCST) + ((size_t)(chf + dir) * 66 + g) * 8192 + t * 64 + dq * 16;
            bf16x8 cv[2];
#pragma unroll
            for (int i = 0; i < 2; ++i) cv[i] = *(const bf16x8*)(cs + i * 8);
            __builtin_amdgcn_sched_barrier(0);
#pragma unroll
            for (int i = 0; i < 2; ++i) { const bf16x8 x = *(const LAS bf16x8*)(F.lds + ML_QS + t * P64 + (dq * 16 + i * 8) * 2); u32x4 o;
#pragma unroll
                for (int j = 0; j < 4; ++j) o[j] = cvt_pk_bf16(bf2f((unsigned short)x[2 * j]) * wi, bf2f((unsigned short)x[2 * j + 1]) * wi);
                *(LAS u32x4*)(F.lds + ML_QD + t * P64 + (dq * 16 + i * 8) * 2) = o;
                *(LAS bf16x8*)(F.lds + ML_KS + t * P64 + (dq * 16 + i * 8) * 2) = cv[i]; }
        }
        __syncthreads();
        {
            const int q = F.tid >> 2, part = F.tid & 3; float s = 0.f;
            const LAS bf16_t* pr = (const LAS bf16_t*)(F.lds + ML_PM + q * P128) + part * 32;
#pragma unroll
            for (int j = 0; j < 32; ++j) s += bf2f(pr[j]);
            const LAS bf16_t* qd = (const LAS bf16_t*)(F.lds + ML_QD + q * P64) + part * 16; const LAS float* nn = ax + AX_NST + dir * 64 + part * 16;
#pragma unroll
            for (int j = 0; j < 16; ++j) s += bf2f(qd[j]) * nn[j];
            s += __shfl_xor(s, 1); s += __shfl_xor(s, 2);
            if (part == 0) ax[AX_DEN + q] = fmaxf(fabsf(s), EM_[q]);
        }
        f32x16 N0 = {}, N1 = {};
        N0 = mma32(N0, F.lds + ML_PM + qb2 * 32 * P128, P128, F.lds + ML_VT + (vb0 * 32) * P128, P128, 8, r32, hi);
        N0 = mma32(N0, F.lds + ML_QD + qb2 * 32 * P64, P64, F.lds + ML_KS + (vb0 * 32) * P64, P64, 4, r32, hi);
        N1 = mma32(N1, F.lds + ML_PM + qb2 * 32 * P128, P128, F.lds + ML_VT + (vb0 * 32 + 32) * P128, P128, 8, r32, hi);
        N1 = mma32(N1, F.lds + ML_QD + qb2 * 32 * P64, P64, F.lds + ML_KS + (vb0 * 32 + 32) * P64, P64, 4, r32, hi);
        __syncthreads();
#pragma unroll
        for (int r = 0; r < 16; ++r) { const float inv = 1.f / ax[AX_DEN + qb2 * 32 + att::crow(r, hi)]; H0[r] += N0[r] * inv; H1[r] += N1[r] * inv; }
        __syncthreads();
    }
    {   LAS float* HS = (LAS float*)(F.lds + ML_HS);
#pragma unroll
        for (int r = 0; r < 16; ++r) { const int q = qb2 * 32 + att::crow(r, hi); HS[q * 128 + vb0 * 32 + r32] = H0[r]; HS[q * 128 + vb0 * 32 + 32 + r32] = H1[r]; } }
    __syncthreads();
    {   const LAS float* HS = (const LAS float*)(F.lds + ML_HS); bf16_t* CC = (bf16_t*)(ws + WS_CC);
        const float g0 = F.in[I_MNORM][2 * F.lane], g1 = F.in[I_MNORM][2 * F.lane + 1];
        for (int i = 0; i < 16; ++i) { const int q = F.wave * 16 + i; const float x0 = HS[q * 128 + 2 * F.lane], x1 = HS[q * 128 + 2 * F.lane + 1];
            const float rs = rsqrtf(wave_sum(x0 * x0 + x1 * x1) * (1.f / 128.f) + NORM_EPS);
            const unsigned mo = *(const unsigned*)(Prow0 + (size_t)q * AB_INP + C_MO + h * 128 + 2 * F.lane);
            *(unsigned*)(CC + (size_t)(row0 + q) * DM + 1024 + h * 128 + 2 * F.lane) = cvt_pk_bf16(x0 * rs * g0 * sigmoidf_(bflo(mo)), x1 * rs * g1 * sigmoidf_(bfhi(mo))); }
    }
    __syncthreads();
}
__device__ __forceinline__ void diff_combine_row(Frame& F, int r, float lam, float oml, const float (&dnw)[16]) {
    const bf16_t* AO = (const bf16_t*)(F.ws + WS_AO) + (size_t)r * DM; bf16_t* CC = (bf16_t*)(F.ws + WS_CC) + (size_t)r * DM;
    const int h = F.lane >> 3, v0 = (F.lane & 7) * 16; float a[16]; float ss = 0.f;
#pragma unroll
    for (int i = 0; i < 2; ++i) { const u32x4 x1 = *(const u32x4*)(AO + (2 * h) * 128 + v0 + i * 8), x2 = *(const u32x4*)(AO + (2 * h + 1) * 128 + v0 + i * 8);
#pragma unroll
        for (int j = 0; j < 4; ++j) { a[i * 8 + 2 * j] = bflo(x1[j]) - lam * bflo(x2[j]); a[i * 8 + 2 * j + 1] = bfhi(x1[j]) - lam * bfhi(x2[j]); } }
#pragma unroll
    for (int j = 0; j < 16; ++j) ss += a[j] * a[j];
    ss += __shfl_xor(ss, 1); ss += __shfl_xor(ss, 2); ss += __shfl_xor(ss, 4);
    const float rs = rsqrtf(ss * (1.f / 128.f) + NORM_EPS) * oml;
#pragma unroll
    for (int i = 0; i < 2; ++i) { u32x4 o;
#pragma unroll
        for (int j = 0; j < 4; ++j) o[j] = cvt_pk_bf16(a[i * 8 + 2 * j] * rs * dnw[i * 8 + 2 * j], a[i * 8 + 2 * j + 1] * rs * dnw[i * 8 + 2 * j + 1]);
        *(u32x4*)(CC + h * 128 + v0 + i * 8) = o; }
}

template <int Q> __device__ __forceinline__ u32x4 rope_w4(u32x4 w, const f32x2* __restrict__ tab, int prow, int pcol, int i0) {
    u32x4 o;
#pragma unroll
    for (int q = 0; q < 4; ++q) { const int i = i0 + q; const f32x2 cs = (i < Q) ? tab[prow * Q + i] : tab[pcol * Q + (i - Q)];
        const float x1 = bflo(w[q]), x2 = bfhi(w[q]); o[q] = cvt_pk_bf16(x1 * cs.x - x2 * cs.y, x1 * cs.y + x2 * cs.x); }
    return o;
}
__device__ __forceinline__ void rope_dk_row(Frame& F, int r) {
    const int b = row_batch(r), pos = r - b * TPB; if (pos < CTXL) return; const int tok = pos - CTXL, prow = tok >> 6, pcol = tok & 63;
    bf16_t* p = (bf16_t*)(F.ws + WS_P) + (size_t)r * AB_INP + C_DK; const f32x2* tab = (const f32x2*)(F.ws + WS_ROPE);
    u32x4 w[2]; f32x2 cs[2][4];
#pragma unroll
    for (int j = 0; j < 2; ++j) { const int e = (F.lane + 64 * j) * 8, i0 = (e & 63) >> 1; w[j] = *(const u32x4*)(p + e);
#pragma unroll
        for (int q = 0; q < 4; ++q) { const int i = i0 + q; cs[j][q] = (i < 16) ? tab[prow * 16 + i] : tab[pcol * 16 + (i - 16)]; } }
    __builtin_amdgcn_sched_barrier(0);
#pragma unroll
    for (int j = 0; j < 2; ++j) { const int e = (F.lane + 64 * j) * 8; u32x4 o;
#pragma unroll
        for (int q = 0; q < 4; ++q) { const float x1 = bflo(w[j][q]), x2 = bfhi(w[j][q]); o[q] = cvt_pk_bf16(x1 * cs[j][q].x - x2 * cs[j][q].y, x1 * cs[j][q].y + x2 * cs[j][q].x); }
        *(u32x4*)(p + e) = o; }
}
__device__ __forceinline__ void post1_row(Frame& F, int r, const float (&qn)[8], const float (&kvn)[8]) {
    unsigned char* ws = F.ws; const bf16_t* p = (const bf16_t*)(ws + WS_P) + (size_t)r * CD_IN;
    const int b = row_batch(r), pos = r - b * TPB; const bool lat = pos >= CTXL; const int tok = pos - CTXL, prow = tok >> 6, pcol = tok & 63;
    const u32x4 wq_ = *(const u32x4*)(p + C_CQ + (F.lane < 56 ? F.lane : 55) * 8), wkv_ = *(const u32x4*)(p + C_CKV + F.lane * 8), wkr_ = *(const u32x4*)(p + C_KR + (F.lane & 7) * 8), wsk_ = *(const u32x4*)(p + C_SK + (F.lane & 31) * 8);
    f32x2 ckr[4], csk[4];
    {   const int tokc = lat ? tok : 0, pr = tokc >> 6, pc = tokc & 63; const f32x2* t64 = (const f32x2*)(ws + WS_ROPE); const f32x2* t128 = (const f32x2*)(ws + WS_ROPE + 65536);
        const int i0k = (F.lane & 7) * 4, i0s = (((F.lane & 31) * 8) & 127) >> 1;
#pragma unroll
        for (int q = 0; q < 4; ++q) { const int ik = i0k + q, is = i0s + q; ckr[q] = ik < 16 ? t64[pr * 16 + ik] : t64[pc * 16 + (ik - 16)]; csk[q] = is < 32 ? t128[pr * 32 + is] : t128[pc * 32 + (is - 32)]; } }
    __builtin_amdgcn_sched_barrier(0);
    {   float x[8]; float ss = 0.f; const bool act = F.lane < 56;
        if (act) { const u32x4 w = wq_;
#pragma unroll
            for (int j = 0; j < 4; ++j) { x[2 * j] = bflo(w[j]); x[2 * j + 1] = bfhi(w[j]); ss += x[2 * j] * x[2 * j] + x[2 * j + 1] * x[2 * j + 1]; } }
        const float rs = rsqrtf(wave_sum(ss) * (1.f / 448.f) + NORM_EPS); u32x4 o = {0, 0, 0, 0};
        if (act) {
#pragma unroll
            for (int j = 0; j < 4; ++j) o[j] = cvt_pk_bf16(x[2 * j] * rs * qn[2 * j], x[2 * j + 1] * rs * qn[2 * j + 1]); }
        *(u32x4*)((bf16_t*)(ws + WS_CQN) + (size_t)r * 512 + F.lane * 8) = o;
    }
    {   float x[8]; float ss = 0.f; const u32x4 w = wkv_;
#pragma unroll
        for (int j = 0; j < 4; ++j) { x[2 * j] = bflo(w[j]); x[2 * j + 1] = bfhi(w[j]); ss += x[2 * j] * x[2 * j] + x[2 * j + 1] * x[2 * j + 1]; }
        const float rs = rsqrtf(wave_sum(ss) * (1.f / 512.f) + NORM_EPS); u32x4 o;
#pragma unroll
        for (int j = 0; j < 4; ++j) o[j] = cvt_pk_bf16(x[2 * j] * rs * kvn[2 * j], x[2 * j + 1] * rs * kvn[2 * j + 1]);
        *(u32x4*)((bf16_t*)(ws + WS_CKVN) + (size_t)r * 512 + F.lane * 8) = o;
    }
    if (F.lane < 8) { u32x4 w = wkr_; if (lat) {
#pragma unroll
            for (int q = 0; q < 4; ++q) { const float x1 = bflo(w[q]), x2 = bfhi(w[q]); w[q] = cvt_pk_bf16(x1 * ckr[q].x - x2 * ckr[q].y, x1 * ckr[q].y + x2 * ckr[q].x); } }
        *(u32x4*)((bf16_t*)(ws + WS_KR) + (size_t)r * 64 + F.lane * 8) = w; }
    if (lat && F.lane >= 32) { const int l2 = F.lane - 32; bf16_t* sk = (bf16_t*)(ws + WS_P) + (size_t)r * CD_IN + C_SK + l2 * 8;
        u32x4 w = wsk_;
#pragma unroll
        for (int q = 0; q < 4; ++q) { const float x1 = bflo(w[q]), x2 = bfhi(w[q]); w[q] = cvt_pk_bf16(x1 * csk[q].x - x2 * csk[q].y, x1 * csk[q].y + x2 * csk[q].x); }
        *(u32x4*)sk = w; }
}
constexpr int TB = DM;
__device__ __forceinline__ const float* modf_vec(const Frame& F, int l, int v, int ch) { return (const float*)(F.ws + WS_MODF) + ((size_t)l * 3 + v) * 12288 + ch * DM; }
__device__ __forceinline__ void row_phase(Frame& F, int l) {
    LAS float* T = (LAS float*)(F.lds + LDS_SCR);
    {
        f32x4 tv[11]; const int o4 = 4 * F.tid;
        tv[0] = *(const f32x4*)(F.in[I_NMPOST] + l * DM + o4); tv[1] = *(const f32x4*)(F.in[I_NFPRE] + l * DM + o4);
#pragma unroll
        for (int v = 0; v < 3; ++v) { tv[2 + v] = *(const f32x4*)(modf_vec(F, l, v, 2) + o4); tv[5 + v] = *(const f32x4*)(modf_vec(F, l, v, 3) + o4); tv[8 + v] = *(const f32x4*)(modf_vec(F, l, v, 4) + o4); }
        __builtin_amdgcn_sched_barrier(0);
#pragma unroll
        for (int k = 0; k < 11; ++k) *(LAS f32x4*)(T + k * TB + o4) = tv[k]; }
    __syncthreads();
    const bf16_t* Y2 = (const bf16_t*)(F.ws + WS_Y2); bf16_t* XR = (bf16_t*)(F.ws + WS_XR); bf16_t* FN2 = (bf16_t*)(F.ws + WS_FN2);
    auto finish_row = [&](int r, int var, f32x4 (&y)[8]) {
        f32x4 x[8]; if (l == 0) load_row_f32(src_row(F, r), F.lane, x); else load_row_bf16(XR + (size_t)r * DM, F.lane, x);
        const float rs = row_rstd(y);
#pragma unroll
        for (int j = 0; j < 8; ++j) { const int c = 4 * F.lane + 256 * j; x[j] = x[j] + LV4(T + (2 + var) * TB, c) * (y[j] * rs * LV4(T, c)); }
        store_row_bf16_nt(XR + (size_t)r * DM, F.lane, x);
        const float rs2 = row_rstd(x);
#pragma unroll
        for (int j = 0; j < 8; ++j) { const int c = 4 * F.lane + 256 * j; const f32x4 f = x[j] * rs2 * LV4(T + TB, c) * (LV4(T + (8 + var) * TB, c) + 1.f) + LV4(T + (5 + var) * TB, c);
            u32x2 hw; hw.x = cvt_pk_bf16(f.x, f.y); hw.y = cvt_pk_bf16(f.z, f.w);
            *(u32x2*)(FN2 + (size_t)r * 4096 + c) = hw;
            int q = __builtin_amdgcn_cvt_pk_fp8_f32(clamp8(f.x * 8.f), clamp8(f.y * 8.f), 0, false); q = __builtin_amdgcn_cvt_pk_fp8_f32(clamp8(f.z * 8.f), clamp8(f.w * 8.f), q, true);
            *(int*)((unsigned char*)(F.ws + WS_FN8) + (size_t)r * DM + c) = q; } };
    for (int r = F.gw; r < MROWS; r += F.NGW) {
        const int var = row_variant(r); if (var == 2) continue;
        f32x4 y[8]; load_row_bf16(Y2 + (size_t)r * DM, F.lane, y); finish_row(r, var, y);
    }
    if (l == 0) {
        for (int i = F.gw; i < 4 * NB * CTXL; i += F.NGW) { if (i & 3) continue;
            const int ci = i >> 2, b = ci / CTXL, pos = ci % CTXL, r = b * TPB + pos; const float* pp = (const float*)(F.ws + WS_PART) + (size_t)ci * DM;
            f32x4 y[8];
#pragma unroll
            for (int j = 0; j < 8; ++j) y[j] = (f32x4){0.f, 0.f, 0.f, 0.f};
#pragma unroll 1
            for (int kb = 0; kb < 8; kb += 4) { f32x4 t[4][8];
#pragma unroll
                for (int q = 0; q < 4; ++q) load_row_f32(pp + (size_t)(kb + q) * (NB * CTXL) * DM, F.lane, t[q]);
#pragma unroll
                for (int j = 0; j < 8; ++j) y[j] += (t[0][j] + t[1][j]) + (t[2][j] + t[3][j]); }
            finish_row(r, 2, y);
        }
    }
}
__device__ __forceinline__ void routing_phase(Frame& F, int l) {
    unsigned char* ws = F.ws; const float* LOG4 = (const float*)(ws + WS_LOG4); int* list = (int*)(ws + WS_LIST); float* GATE = (float*)(ws + WS_GATE);
    unsigned* cnt = (unsigned*)(ws + WS_CTL) + CW_CNT + l * 128;
    LAS int* L = (LAS int*)(F.lds + LDS_SCR);
    const int chunk = (MROWS + F.G - 1) / F.G; const int r0 = F.bid * chunk, r1 = (r0 + chunk < MROWS) ? r0 + chunk : MROWS;
    LAS int* sel_e = L + 128; LAS int* sel_r = L + 128 + chunk * 6;
    if (F.tid < 128) L[F.tid] = 0;
    __syncthreads();
    const float rb = F.in[I_RB][l * 64 + F.lane];
    LAS float* lgs = (LAS float*)(L + 128 + chunk * 12) + F.wave * (9 * 64);
    for (int rb0 = r0; rb0 < r1; rb0 += 72) {
#pragma unroll
    for (int i = 0; i < 9; ++i) { const int r = rb0 + F.wave + 8 * i, rc = r < MROWS ? r : MROWS - 1; float lg = 0.f;
#pragma unroll
        for (int s = 0; s < 4; ++s) { const float* p = LOG4 + ((size_t)s * MROWS + rc) * 256; lg += p[F.lane] + p[64 + F.lane]; }
        lgs[i * 64 + F.lane] = lg; }
    LDS_WAIT(); asm volatile("" ::: "memory");
#pragma unroll 1
    for (int i = 0; i < 9; ++i) { const int r = rb0 + F.wave + 8 * i; if (r >= r1) break;
        const int var = row_variant(r); const int tl = r - r0;
        if (l == 1 && var == 2) { if (F.lane < 6) sel_e[tl * 6 + F.lane] = -1; continue; }
        const float lg = lgs[i * 64 + F.lane];
        const float score = 1.f / (1.f + __expf(-lg)); const float choice = score + rb;
        float m1 = choice; m1 = fmaxf(m1, __shfl_xor(m1, 1)); m1 = fmaxf(m1, __shfl_xor(m1, 2)); m1 = fmaxf(m1, __shfl_xor(m1, 4));
        const unsigned long long bm = __ballot(choice == m1); const int grp = F.lane >> 3; const unsigned gb = (unsigned)(bm >> (grp * 8)) & 0xffu; const int first = __builtin_ctz(gb);
        float c2 = ((F.lane & 7) == first) ? -1e30f : choice; c2 = fmaxf(c2, __shfl_xor(c2, 1)); c2 = fmaxf(c2, __shfl_xor(c2, 2)); c2 = fmaxf(c2, __shfl_xor(c2, 4));
        const float gs = m1 + c2; int rank = 0;
#pragma unroll
        for (int j = 0; j < 8; ++j) { const float gj = __shfl(gs, j * 8); rank += (gj > gs || (gj == gs && j < grp)) ? 1 : 0; }
        float masked = rank < 4 ? choice : -1e30f;
        int myk = -1; float ssum = 0.f; float sk_[6]; int ek_[6];
#pragma unroll
        for (int k = 0; k < 6; ++k) { const float mx = wave_max(masked); const unsigned long long bb = __ballot(masked == mx); const int e = __builtin_ctzll(bb);
            if (F.lane == e) masked = -1e30f; const float sc = __shfl(score, e); sk_[k] = sc; ek_[k] = e; ssum += sc; }
        (void)myk;
        if (F.lane < 6) { float gsel = 0.f; int esel = 0;
#pragma unroll
            for (int k = 0; k < 6; ++k) if (F.lane == k) { gsel = sk_[k]; esel = ek_[k]; }
            GATE[(size_t)r * 6 + F.lane] = gsel / ssum * 2.5f;
            const int rk = atomicAdd((int*)&L[esel], 1); sel_e[tl * 6 + F.lane] = esel; sel_r[tl * 6 + F.lane] = rk; }
    }
    LDS_WAIT(); asm volatile("" ::: "memory");
    }
    __syncthreads();
    if (F.tid < 64) L[64 + F.tid] = (int)atomicAdd(&cnt[F.tid], (unsigned)L[F.tid]);
    if (F.bid == 0 && F.tid == 64) cnt[64] = (l == 0) ? MROWS : NB * SEQ;
    __syncthreads();
    for (int i = F.tid; i < (r1 - r0) * 6; i += 512) { const int e = sel_e[i]; if (e >= 0) list[(size_t)e * MROWS + L[64 + e] + sel_r[i]] = (r0 + i / 6) * 6 + (i % 6); }
    for (int r = r0 + F.tid; r < r1; r += 512) { const int b = row_batch(r), pos = r - b * TPB;
        if (l == 0) list[(size_t)64 * MROWS + r] = NSLOT + r; else if (pos >= CTXL) list[(size_t)64 * MROWS + b * SEQ + (pos - CTXL)] = NSLOT + r; }
}
__device__ __forceinline__ void combine_phase(Frame& F, int l) {
    LAS float* T = (LAS float*)(F.lds + LDS_SCR);
    lds_load_vec(F, T, F.in[I_NFPOST] + l * DM);
    for (int v = 0; v < 3; ++v) lds_load_vec(F, T + (1 + v) * TB, modf_vec(F, l, v, 5));
    if (l == 0) { lds_load_vec(F, T + 4 * TB, F.in[I_NMPRE] + DM); for (int v = 0; v < 3; ++v) { lds_load_vec(F, T + (5 + v) * TB, modf_vec(F, 1, v, 0)); lds_load_vec(F, T + (8 + v) * TB, modf_vec(F, 1, v, 1)); } }
    __syncthreads();
    const unsigned char* YS = (const unsigned char*)(F.ws + WS_YS); const float* GATE = (const float*)(F.ws + WS_GATE); bf16_t* XR = (bf16_t*)(F.ws + WS_XR); bf16_t* HN = (bf16_t*)(F.ws + WS_HN);
    for (int r = F.gw; r < MROWS; r += F.NGW) {
        const int var = row_variant(r); if (l == 1 && var == 2) continue;
        f32x4 f[8], t[8];
#pragma unroll
        for (int j = 0; j < 8; ++j) f[j] = (f32x4){0.f, 0.f, 0.f, 0.f};
#pragma unroll
        for (int kb = 0; kb < 8; kb += 4) { int yw[4][8]; float gk[4];
#pragma unroll
            for (int kk = 0; kk < 4; ++kk) { const int k = kb + kk; if (k < 7) { const unsigned char* p = YS + (k < 6 ? ((size_t)r * 6 + k) : (size_t)(NSLOT + r)) * DM + 4 * F.lane;
#pragma unroll
                for (int j = 0; j < 8; ++j) yw[kk][j] = __builtin_nontemporal_load((const int*)(p + 256 * j));
                gk[kk] = (k < 6 ? GATE[(size_t)r * 6 + (k < 6 ? k : 0)] : 1.f) * YS_INV; } }
            if (kb == 0) load_row_bf16(XR + (size_t)r * DM, F.lane, t);
#pragma unroll
            for (int kk = 0; kk < 4; ++kk) { if (kb + kk < 7) {
#pragma unroll
                for (int j = 0; j < 8; ++j) { const f32x2 lo = __builtin_amdgcn_cvt_pk_f32_fp8(yw[kk][j], false), hi = __builtin_amdgcn_cvt_pk_f32_fp8(yw[kk][j], true); f[j] += (f32x4){lo.x, lo.y, hi.x, hi.y} * gk[kk]; } } }
        }
        const float rs = row_rstd(f);
#pragma unroll
        for (int j = 0; j < 8; ++j) { const int c = 4 * F.lane + 256 * j; t[j] = t[j] + LV4(T + (1 + var) * TB, c) * (f[j] * rs * LV4(T, c)); }
        if (l == 0) {
#pragma unroll
            for (int j = 0; j < 8; ++j) { u32x2 w; w.x = cvt_pk_bf16(t[j].x, t[j].y); w.y = cvt_pk_bf16(t[j].z, t[j].w); __builtin_nontemporal_store(w, (u32x2*)(XR + (size_t)r * DM + 4 * F.lane + 256 * j)); }
            const float rs2 = row_rstd(t);
#pragma unroll
            for (int j = 0; j < 8; ++j) { const int c = 4 * F.lane + 256 * j; t[j] = t[j] * rs2 * LV4(T + 4 * TB, c) * (LV4(T + (8 + var) * TB, c) + 1.f) + LV4(T + (5 + var) * TB, c); }
            store_row_bf16(HN + (size_t)r * DM, F.lane, t);
        } else {
            const int b = row_batch(r), pos = r - b * TPB; float* o = F.out + ((size_t)b * SEQ + (pos - CTXL)) * DM;
#pragma unroll
            for (int j = 0; j < 8; ++j) __builtin_nontemporal_store(t[j], (f32x4*)(o + 4 * F.lane + 256 * j));
        }
    }
}

__device__ __attribute__((noinline)) void combine_outlined(unsigned char* ws, const float* const* in, float* out, int G, int bid, int l) {
    extern __shared__ __attribute__((aligned(16))) unsigned char lds_raw2[];
    Frame F; F.lds = (LAS unsigned char*)lds_raw2; F.ldsg = (char*)lds_raw2; F.ws = ws; F.in = in; F.out = out; F.G = G; F.bid = bid; F.NGW = G * 8;
    int t_ = threadIdx.x; asm volatile("" : "+v"(t_)); F.tid = t_; F.lane = t_ & 63; F.wave = __builtin_amdgcn_readfirstlane(t_ >> 6); F.gw = bid * 8 + F.wave;
    combine_phase(F, l);
}

constexpr float LOG2E = 1.4426950408889634f;
__device__ __forceinline__ void diff_attn_units(Frame& F) {
    const bf16_t* P = (const bf16_t*)(F.ws + WS_P); bf16_t* AO = (bf16_t*)(F.ws + WS_AO); const f32x2* tab = (const f32x2*)(F.ws + WS_ROPE);
    for (long L = F.bid; L < 1024 + 32; L += F.G) {
        att::UnitDesc U{}; int hh, u; const bool ctxq = L >= 1024;
        if (!ctxq) { hh = (int)(L / 256) * 8 + (int)(L % 8); u = (int)(L % 256) / 8; } else { hh = (int)L - 1024; u = 0; }
        const int b = hh >> 4, vh = hh & 15; const size_t krow0 = (size_t)b * TPB, qrow0 = ctxq ? krow0 : krow0 + CTXL + 256 * u;
        U.Q = P + qrow0 * AB_INP + C_DQ + vh * 64; U.ldq = AB_INP; U.K = P + krow0 * AB_INP + C_DK + vh * 64; U.ldk = AB_INP; U.K2 = nullptr; U.ldk2 = 0;
        U.V = P + krow0 * AB_INP + C_DV + (vh >> 1) * 128; U.ldv = AB_INP; U.O = AO + qrow0 * DM + vh * 128; U.ldo = DM;
        U.NT = ctxq ? 4 : 132; U.C = 0.125f * LOG2E; U.rope = ctxq ? nullptr : tab; U.qtok0 = 256 * u; U.seg_tiles = 0; U.seg2_row0 = 0; U.ktok0 = 0; U.sink_l2 = 0.f;
        att::attn_unit<0>(U, F.ldsg + LDS_SCR);
    }
}
__device__ __forceinline__ void mla_units(Frame& F) {
    const bf16_t* QB = (const bf16_t*)(F.ws + WS_QB); const bf16_t* KV = (const bf16_t*)(F.ws + WS_KV); const bf16_t* KR = (const bf16_t*)(F.ws + WS_KR); bf16_t* CC = (bf16_t*)(F.ws + WS_CC);
    const f32x2* tab = (const f32x2*)(F.ws + WS_ROPE);
    for (long L = F.bid; L < 512; L += F.G) {
        att::UnitDesc U{}; const int hh = (int)(L / 256) * 8 + (int)(L % 8), u = (int)(L % 256) / 8; const int b = hh >> 3, h = hh & 7;
        const size_t krow0 = (size_t)b * TPB, qrow0 = krow0 + CTXL + 256 * u;
        U.Q = QB + qrow0 * 1536 + h * 192; U.ldq = 1536; U.K = KV + krow0 * 2048 + h * 256; U.ldk = 2048; U.K2 = KR + krow0 * 64; U.ldk2 = 64;
        U.V = KV + krow0 * 2048 + h * 256 + 128; U.ldv = 2048; U.O = CC + qrow0 * DM + h * 128; U.ldo = DM;
        U.NT = 132; U.C = 0.07216878364870322f * LOG2E; U.rope = tab; U.qtok0 = 256 * u; U.seg_tiles = 0; U.seg2_row0 = 0; U.ktok0 = 0; U.sink_l2 = 0.f;
        att::attn_unit<1>(U, F.ldsg + LDS_SCR);
    }
}
__device__ __forceinline__ void swa_units(Frame& F) {
    const bf16_t* P1 = (const bf16_t*)(F.ws + WS_P); bf16_t* CC = (bf16_t*)(F.ws + WS_CC); const f32x2* tab = (const f32x2*)(F.ws + WS_ROPE + 65536);
    for (long L = F.bid; L < 512; L += F.G) {
        att::UnitDesc U{}; const int hh = (int)(L / 256) * 8 + (int)(L % 8), u = (int)(L % 256) / 8; const int b = hh >> 3, h = hh & 7, g = h >> 2;
        const size_t krow0 = (size_t)b * TPB, qrow0 = krow0 + CTXL + 256 * u;
        const int tok0 = (256 * u - 128) > 0 ? (256 * u - 128) : 0, tok1 = (256 * u + 384) < SEQ ? (256 * u + 384) : SEQ;
        U.Q = P1 + qrow0 * CD_IN + C_SQ + h * 128; U.ldq = CD_IN; U.K = P1 + krow0 * CD_IN + C_SK + g * 128; U.ldk = CD_IN; U.K2 = nullptr; U.ldk2 = 0;
        U.V = P1 + krow0 * CD_IN + C_SV + g * 128; U.ldv = CD_IN; U.O = CC + qrow0 * DM + 1024 + h * 128; U.ldo = DM;
        U.NT = 4 + (tok1 - tok0) / 64; U.C = 0.08838834764831845f * LOG2E; U.rope = tab; U.qtok0 = 256 * u; U.seg_tiles = 4; U.seg2_row0 = CTXL + tok0; U.ktok0 = tok0; U.sink_l2 = F.in[I_SINK][h] * LOG2E;
        att::attn_unit<2>(U, F.ldsg + LDS_SCR);
    }
}

constexpr int N_PHASES = 24;
__global__ void __launch_bounds__(512, 2) mk_fwd(Args args) {
    extern __shared__ __attribute__((aligned(16))) unsigned char lds_raw[];
    Frame F;
    F.lds = (LAS unsigned char*)lds_raw; F.ldsg = (char*)lds_raw; F.ws = args.ws; F.in = (const float* const*)__builtin_amdgcn_kernarg_segment_ptr()  ; F.out = args.out;
    F.tid = threadIdx.x; F.lane = F.tid & 63; F.wave = __builtin_amdgcn_readfirstlane(F.tid >> 6); F.G = gridDim.x; F.bid = blockIdx.x; F.gw = F.bid * 8 + F.wave; F.NGW = F.G * 8;
    unsigned* ctl = (unsigned*)(F.ws + WS_CTL);
    for (int u = F.tid; u < (LDS_BYTES - LDS_CTL) / 4; u += 512) ((LAS unsigned*)(F.lds + LDS_CTL))[u] = 0u;
    __syncthreads();
    XcdBarrier bar; bar.bar = ctl + CW_BAR; bar.x = 0; bar.st = nullptr;
    const bool one = (args.ph_hi - args.ph_lo) > 1;
    if (one) bar = xcd_barrier_post(ctl + CW_BAR, (volatile LAS unsigned*)(F.lds + LDS_CTL));
    const int lo = args.ph_lo, hi = args.ph_hi;
#ifndef ONLY
#define ONLY -1
#endif
#ifndef PROBE_PH
#define PROBE_PH -1
#endif
#ifndef PROBE_VAR
#define PROBE_VAR 0
#endif
#define REP(k) for (int rep_ = 0; rep_ < ((PROBE_PH == (k)) ? 2 : 1); ++rep_)
#define IN(k) ((ONLY < 0 || ONLY == (k)) && lo <= (k) && (k) < hi)
#define INM(j) ((ONLY < 0 || ONLY == 7 + (j)) && lo <= (pb + (j)) && (pb + (j)) < hi)
#define FREF() do { int t_ = threadIdx.x; asm volatile("" : "+v"(t_)); F.tid = t_; F.lane = t_ & 63; F.wave = __builtin_amdgcn_readfirstlane(t_ >> 6); F.gw = F.bid * 8 + F.wave; } while (0)
#define SEAM(k) do { if (lo <= (k) && (k) + 1 < hi) xcd_barrier(bar); } while (0)
    unsigned char* ws = F.ws;
    if (IN(0)) REP(0) { asm volatile("; PHASE_MARK 0"); FREF(); p0_prologue(F); } SEAM(0);
    if (IN(1)) REP(1) { asm volatile("; PHASE_MARK 1"); FREF(); p1_norm0(F); } SEAM(1);
#define MOE_LAYER(l, pb) do { \
        if (INM(0)) REP(100 + (l) * 10 + 0) { asm volatile("; PHASE_MARK M0"); FREF(); row_phase(F, l); } SEAM(pb); \
        if (INM(1)) REP(100 + (l) * 10 + 1) { asm volatile("; PHASE_MARK M1"); FREF(); PolRouter p{(const bf16_t*)(ws + WS_FN2), (const bf16_t*)(ws + WS_WRT) + (size_t)(l) * 256 * 4096, (float*)(ws + WS_LOG4), 8192, 8, (l) == 0 ? NTILE_M : 64, F.G, F.bid, (l) == 1}; \
            pg8::gemm_phase(F.lds + LDS_SCR, p); } SEAM(pb + 1); \
        if (INM(2)) REP(100 + (l) * 10 + 2) { asm volatile("; PHASE_MARK M2"); FREF(); routing_phase(F, l); } SEAM(pb + 2); \
        if (INM(3)) REP(100 + (l) * 10 + 3) { asm volatile("; PHASE_MARK M3"); FREF(); build_group_table(F, ctl + CW_CNT + (l) * 128); \
            for (int ib = 0; ib == 0 || ib < group_units<4>(F); ib += STASH_MAX) { stash_lists<4>(F, (const int*)(ws + WS_LIST), ib); \
            PolGU p{(const unsigned char*)(ws + WS_FN8), (const unsigned char*)(ws + WS_WGU) + (size_t)(l) * 65 * 1024 * 2048, (unsigned char*)(ws + WS_H), (const LAS int*)(F.lds + LDS_AUX + STASH_OFF), (const LAS int*)(F.lds + LDS_AUX), 2048, 16, F.G, F.bid, ib, (PROBE_PH == 100 + (l) * 10 + 3 && rep_ == 0) ? PROBE_VAR : 0}; \
            pg8::gemm_phase(F.lds + LDS_SCR, p); } } SEAM(pb + 3); \
        if (INM(4)) REP(100 + (l) * 10 + 4) { asm volatile("; PHASE_MARK M4"); FREF(); build_group_table(F, ctl + CW_CNT + (l) * 128); \
            for (int ib = 0; ib == 0 || ib < group_units<8>(F); ib += STASH_MAX) { stash_lists<8>(F, (const int*)(ws + WS_LIST), ib); \
            PolDN p{(const unsigned char*)(ws + WS_H), (const unsigned char*)(ws + WS_WDN) + (size_t)(l) * 65 * 2048 * 512, (unsigned char*)(ws + WS_YS), (const LAS int*)(F.lds + LDS_AUX + STASH_OFF), (const LAS int*)(F.lds + LDS_AUX), 512, 4, F.G, F.bid, ib, (rep_ > 0) ? PROBE_VAR : 0}; \
            pg8::gemm_phase(F.lds + LDS_SCR, p); } } SEAM(pb + 4); \
        if (INM(5)) REP(100 + (l) * 10 + 5) { asm volatile("; PHASE_MARK M5"); combine_outlined(F.ws, F.in, F.out, F.G, F.bid, l); } } while (0)
    if (IN(2)) REP(2) { asm volatile("; PHASE_MARK 2"); FREF(); PolPlain p{(const bf16_t*)(ws + WS_HN), (const bf16_t*)(ws + WS_WABIN), (bf16_t*)(ws + WS_P), DM * 2, DM * 2, AB_INP, DM / 64, NTILE_M, AB_INP / 256, F.G, F.bid, false, (rep_ > 0) ? PROBE_VAR : 0};
        pg8::gemm_phase(F.lds + LDS_SCR, p); } SEAM(2);
    if (IN(3)) { asm volatile("; PHASE_MARK 3"); FREF(); for (int r = F.gw; r < MROWS; r += F.NGW) rope_dk_row(F, r);
        REP(3) for (int it = F.bid; it < NB * 8 * 66; it += F.G) { const int g = it % 66, bh = it / 66; mlstm_a_item(F, bh >> 3, bh & 7, g); } } SEAM(3);
    if (IN(4)) REP(4) { asm volatile("; PHASE_MARK 4"); FREF(); for (int it = F.bid; it < 32 * 8; it += F.G) mlstm_scan_item(F, it >> 3, it & 7);
        diff_attn_units(F); } SEAM(4);
    if (IN(5)) REP(5) { asm volatile("; PHASE_MARK 5"); FREF(); const float* lv = F.in[I_DLAM]; float s01 = 0.f, s23 = 0.f; for (int i = 0; i < 64; ++i) { s01 += lv[i] * lv[64 + i]; s23 += lv[128 + i] * lv[192 + i]; }
        const float lam_init = 0.2f, lam = __expf(s01) - __expf(s23) + lam_init;
        {
            const int nit = NB * 8 * 66, extra = nit % F.G, nbusy = (extra > 0 && extra < F.G) ? extra : 0, nhelp = F.G - nbusy;
            if (F.bid >= nbusy) { float dnw[16];
#pragma unroll
                for (int j = 0; j < 16; ++j) dnw[j] = F.in[I_DNORM][(F.lane & 7) * 16 + j];
                for (int r = (F.bid - nbusy) * 8 + F.wave; r < MROWS; r += nhelp * 8) diff_combine_row(F, r, lam, 1.f - lam_init, dnw); } }
        for (int it = F.bid; it < NB * 8 * 66; it += F.G) { const int g = it % 66, bh = it / 66; mlstm_c_item(F, bh >> 3, bh & 7, g); } } SEAM(5);
    if (IN(6)) REP(6) { asm volatile("; PHASE_MARK 6"); FREF(); PolPlain p{(const bf16_t*)(ws + WS_CC), (const bf16_t*)(ws + WS_WABOUT), (bf16_t*)(ws + WS_Y2), DM * 2, DM * 2, DM, DM / 64, 64, DM / 256, F.G, F.bid, true, 0};
        pg8::gemm_phase(F.lds + LDS_SCR, p);
        PolCtxSplit q{(const bf16_t*)(ws + WS_CC), (const bf16_t*)(ws + WS_WABOUT), (float*)(ws + WS_PART), DM * 2, DM * 2, 4, F.G, F.bid};
        pg8::gemm_phase(F.lds + LDS_SCR, q); } SEAM(6);
    { constexpr int pb = 7; MOE_LAYER(0, pb); } SEAM(12);
    if (IN(13)) REP(13) { asm volatile("; PHASE_MARK 13"); FREF(); PolPlain p{(const bf16_t*)(ws + WS_HN), (const bf16_t*)(ws + WS_WCDIN), (bf16_t*)(ws + WS_P), DM * 2, DM * 2, CD_IN, DM / 64, NTILE_M, CD_IN / 256, F.G, F.bid, false, 0};
        pg8::gemm_phase(F.lds + LDS_SCR, p); } SEAM(13);
    if (IN(14)) REP(14) { asm volatile("; PHASE_MARK 14"); FREF(); { float qn[8], kvn[8];
#pragma unroll
            for (int j = 0; j < 8; ++j) { qn[j] = F.in[I_QNORM][(F.lane < 56 ? F.lane : 55) * 8 + j]; kvn[j] = F.in[I_KVNORM][F.lane * 8 + j]; }
            for (int r = F.gw; r < MROWS; r += F.NGW) post1_row(F, r, qn, kvn); } } SEAM(14);
    if (IN(15)) REP(15) { asm volatile("; PHASE_MARK 15"); FREF(); PolUqUkv p{(const bf16_t*)(ws + WS_CKVN), (const bf16_t*)(ws + WS_CQN), (const bf16_t*)(ws + WS_WUKV), (const bf16_t*)(ws + WS_WUQ), (bf16_t*)(ws + WS_KV), (bf16_t*)(ws + WS_QB), 1024, 8, F.G, F.bid};
        pg8::gemm_phase(F.lds + LDS_SCR, p); } SEAM(15);
    if (IN(16)) REP(16) { asm volatile("; PHASE_MARK 16"); FREF();
#ifndef NO_MLA
        mla_units(F);
#endif
#ifndef NO_SWA
        swa_units(F);
#endif
    } SEAM(16);
    if (IN(17)) REP(17) { asm volatile("; PHASE_MARK 17"); FREF(); PolPlain p{(const bf16_t*)(ws + WS_CC), (const bf16_t*)(ws + WS_WCDOUT), (bf16_t*)(ws + WS_Y2), DM * 2, DM * 2, DM, DM / 64, 64, DM / 256, F.G, F.bid, true, 0};
        pg8::gemm_phase(F.lds + LDS_SCR, p); } SEAM(17);
    { constexpr int pb = 18; MOE_LAYER(1, pb); }
#undef IN
#undef INM
#undef SEAM
#undef MOE_LAYER
#undef FREF
}

extern "C" void kernel_launch(void* const* d_in, const int* in_sizes, int n_in, void* d_out, int out_size, void* d_ws, size_t ws_size, hipStream_t stream) {
    static int grid = 0;
    if (grid == 0) {
        if (n_in != 31 || ws_size < WS_END) { fprintf(stderr, "kernel_launch: unexpected n_in %d or ws_size %zu (< %zu)\n", n_in, ws_size, (size_t)WS_END); grid = -1; return; }
        int dev = 0, cus = 0, per_cu = 0;
        if (hipGetDevice(&dev) != hipSuccess || hipDeviceGetAttribute(&cus, hipDeviceAttributeMultiprocessorCount, dev) != hipSuccess) { grid = -1; return; }
        if (hipFuncSetAttribute((const void*)mk_fwd, hipFuncAttributeMaxDynamicSharedMemorySize, LDS_BYTES) != hipSuccess) { fprintf(stderr, "kernel_launch: hipFuncSetAttribute failed\n"); grid = -1; return; }
        if (hipOccupancyMaxActiveBlocksPerMultiprocessor(&per_cu, (const void*)mk_fwd, 512, LDS_BYTES) != hipSuccess || per_cu < 1) { fprintf(stderr, "kernel_launch: occupancy query says %d\n", per_cu); }
        (void)hipGetLastError();
        grid = cus;
    }
    if (grid < 0) return;
    (void)hipMemsetAsync((char*)d_ws + WS_CTL, 0, CTL_ZERO_BYTES, stream);
    Args a{};
    for (int i = 0; i < 31; ++i) a.in[i] = (const float*)d_in[i];
    a.out = (float*)d_out; a.ws = (unsigned char*)d_ws;
#if MK_N_LAUNCHES == 1
    a.ph_lo = 0; a.ph_hi = N_PHASES;
    hipLaunchKernelGGL(mk_fwd, dim3(grid), dim3(512), LDS_BYTES, stream, a);
#else
    for (int k = 0; k < N_PHASES; ++k) { a.ph_lo = k; a.ph_hi = k + 1; hipLaunchKernelGGL(mk_fwd, dim3(grid), dim3(512), LDS_BYTES, stream, a); }
#endif
    const hipError_t le = hipPeekAtLastError();
    if (le != hipSuccess) fprintf(stderr, "kernel_launch: launch failed: %s\n", hipGetErrorName(le));
}
```

```cpp
#include <hip/hip_runtime.h>
#include <stdint.h>
#include <stdio.h>

#define LAS __attribute__((address_space(3)))
#define GAS __attribute__((address_space(1)))
#ifndef GEMM_STAGGER_US
#define GEMM_STAGGER_US 0
#endif
#ifndef MK_N_LAUNCHES
#define MK_N_LAUNCHES 1
#endif

typedef unsigned short bf16_t;
typedef short bf16x8 __attribute__((ext_vector_type(8)));
typedef short s16x4 __attribute__((ext_vector_type(4)));
typedef float f32x2 __attribute__((ext_vector_type(2)));
typedef float f32x4 __attribute__((ext_vector_type(4)));
typedef float f32x16 __attribute__((ext_vector_type(16)));
typedef unsigned u32x4 __attribute__((ext_vector_type(4)));
typedef unsigned u32x2 __attribute__((ext_vector_type(2)));
typedef int v4i_t __attribute__((ext_vector_type(4)));
typedef int v8i_t __attribute__((ext_vector_type(8)));

constexpr int DM = 2048, NB = 2, SEQ = 8192, CTXL = 256, TPB = CTXL + SEQ  , MROWS = NB * TPB  ;
constexpr int NTILE_M = MROWS / 256;
constexpr int AB_IN = 6176, AB_INP = 6400, CD_IN = 2560;
constexpr int NEXP = 64, TOPK = 6, EFF = 512;
constexpr int NSLOT = MROWS * TOPK;
constexpr int NSLOT_ALL = NSLOT + MROWS;
constexpr float NORM_EPS = 1e-6f;
constexpr int C_DQ = 0, C_DK = 1024, C_DV = 2048, C_MQ = 3072, C_MK = 3584, C_MV = 4096, C_MO = 5120, C_GT = 6144;
constexpr int C_CQ = 0, C_CKV = 448, C_KR = 960, C_SQ = 1024, C_SK = 2048, C_SV = 2304;

constexpr size_t MiB = 1u << 20;
constexpr size_t WS_CTL = 0, CTL_ZERO_BYTES = 128 * 1024;
constexpr size_t WS_MODP = 1930 * MiB;
constexpr size_t WS_MODF = 4 * MiB;
constexpr size_t WS_ROPE = 5 * MiB;
constexpr size_t WS_WABIN = 6 * MiB, WS_WABOUT = 31 * MiB, WS_WCDIN = 39 * MiB, WS_WCDOUT = 49 * MiB, WS_WUQ = 57 * MiB, WS_WUKV = 59 * MiB, WS_WRT = 61 * MiB;
constexpr size_t WS_WGU = 65 * MiB;
constexpr size_t WS_WDN = 585 * MiB;
constexpr size_t WS_XR = 845 * MiB;
constexpr size_t WS_HN = 977 * MiB;
constexpr size_t WS_Y2 = 1043 * MiB;
constexpr size_t WS_REG = 1109 * MiB;
constexpr size_t WS_P = WS_REG;
constexpr size_t WS_AO = WS_P + 207 * MiB;
constexpr size_t WS_CC = WS_AO + 66 * MiB;
constexpr size_t WS_MDC = WS_CC + 66 * MiB;
constexpr size_t WS_MCST = WS_MDC + 66 * MiB;
constexpr size_t WS_MSM = WS_MCST + 33 * MiB;
constexpr size_t WS_QB = WS_MSM + 2 * MiB;
constexpr size_t WS_KV = WS_QB + 50 * MiB;
constexpr size_t WS_CQN = WS_KV + 66 * MiB;
constexpr size_t WS_CKVN = WS_CQN + 17 * MiB;
constexpr size_t WS_KR = WS_CKVN + 17 * MiB;
constexpr size_t WS_A_END = WS_KR + 3 * MiB;
constexpr size_t WS_PART = WS_REG + 560 * MiB;
constexpr size_t WS_FN2 = WS_REG;
constexpr size_t WS_LOG4 = WS_FN2 + 132 * MiB;
constexpr size_t WS_LIST = WS_LOG4 + 66 * MiB;
constexpr size_t WS_GATE = WS_LIST + 5 * MiB;
constexpr size_t WS_H = WS_GATE + 1 * MiB;
constexpr size_t WS_YS = WS_H + 116 * MiB;
constexpr size_t WS_FN8 = WS_YS + 462 * MiB;
constexpr size_t WS_B_END = WS_FN8 + 33 * MiB;
constexpr size_t WS_END = 1936 * MiB;
static_assert(WS_A_END <= 1930 * MiB && WS_B_END <= 1930 * MiB, "stage regions below the modulation partials");
constexpr size_t MSM_DN = 0;
constexpr size_t MSM_NST = 32 * 66 * 64 * 4;
constexpr size_t MSM_MLOC = 2 * 32 * 66 * 64 * 4;
constexpr size_t MSM_BTOT = MSM_MLOC + 32 * 66 * 4;
constexpr size_t MSM_MST = MSM_BTOT + 32 * 66 * 4;

constexpr int CW_TMO = 0;
constexpr int CW_BAR = 4096;
constexpr int CW_CNT = 16384;

constexpr int LDS_SCR = 0;
constexpr int LDS_AUX = 131072;
constexpr int LDS_CTL = 155648;
constexpr int LDS_BYTES = 155904;

__device__ __forceinline__ unsigned cvt_pk_bf16(float lo, float hi) { unsigned r; asm volatile("v_cvt_pk_bf16_f32 %0, %1, %2" : "=v"(r) : "v"(lo), "v"(hi)); return r; }
__device__ __forceinline__ unsigned f2bf(float f) { unsigned u = __builtin_bit_cast(unsigned, f); return (u + 0x7fffu + ((u >> 16) & 1u)) >> 16; }
__device__ __forceinline__ float bf2f(unsigned b) { return __builtin_bit_cast(float, b << 16); }
__device__ __forceinline__ float bflo(unsigned w) { return __builtin_bit_cast(float, w << 16); }
__device__ __forceinline__ float bfhi(unsigned w) { return __builtin_bit_cast(float, w & 0xffff0000u); }
__device__ __forceinline__ float wave_sum(float v) {
#pragma unroll
    for (int o = 1; o < 64; o <<= 1) v += __shfl_xor(v, o);
    return v;
}
__device__ __forceinline__ float wave_max(float v) {
#pragma unroll
    for (int o = 1; o < 64; o <<= 1) v = fmaxf(v, __shfl_xor(v, o));
    return v;
}
__device__ __forceinline__ float clamp8(float x) { return __builtin_amdgcn_fmed3f(x, -448.f, 448.f); }
__device__ __forceinline__ float sigmoidf_(float x) { return 1.f / (1.f + __expf(-x)); }
__device__ __forceinline__ float logsigmoidf_(float x) { return fminf(x, 0.f) - log1pf(__expf(-fabsf(x))); }
#define LDS_WAIT() asm volatile("s_waitcnt lgkmcnt(0)" ::: "memory")
#define VM_WAIT() asm volatile("s_waitcnt vmcnt(0)" ::: "memory")

#define XB_TMO      128
#define XB_XCNT(j)  (256  + 64 * (j))
#define XB_XSUB(j)  (1280 + 64 * (j))
#define XB_XGEN(j)  (2304 + 64 * (j))
#define XB_TOP      3328
#define XB_TOPGEN   3392
#define XCD_BAR_WORDS 3456
#define XB_SPIN_CAP (1u << 20)
__device__ __forceinline__ unsigned xb_ld(unsigned* p)              { return __hip_atomic_load(p, __ATOMIC_RELAXED, __HIP_MEMORY_SCOPE_AGENT); }
__device__ __forceinline__ unsigned xb_add(unsigned* p, unsigned v) { return __hip_atomic_fetch_add(p, v, __ATOMIC_RELAXED, __HIP_MEMORY_SCOPE_AGENT); }
__device__ __forceinline__ unsigned xb_xcc_id() { return (unsigned)__builtin_amdgcn_s_getreg((3 << 11) | 20) & 0xFu; }
#define XB_SPIN(cond, bar) do { unsigned _sp = 0; while (cond) { __builtin_amdgcn_s_sleep(1); \
    if ((++_sp & 255u) == 0u) { if (xb_ld(&(bar)[XB_TMO])) break; if (_sp > XB_SPIN_CAP) { atomicAdd(&(bar)[XB_TMO], 1u); break; } } } } while (0)
struct XcdBarrier { unsigned* bar; unsigned x; volatile LAS unsigned* st; };
__device__ __forceinline__ XcdBarrier xcd_barrier_post(unsigned* bar, volatile LAS unsigned* st) {
    XcdBarrier b; b.bar = bar; b.x = xb_xcc_id(); b.st = st;
    if (threadIdx.x == 0) (void)xb_add(&bar[XB_XCNT(b.x)], 1u);
    return b;
}
__device__ __forceinline__ void xcd_barrier_complete(unsigned* bar, unsigned x, unsigned& nloc, unsigned& nx) {
    const unsigned G = gridDim.x * gridDim.y * gridDim.z;
    unsigned sum, cnt, mine, sp = 0u;
    for (;;) {
        sum = 0u; cnt = 0u; mine = 0u;
#pragma unroll
        for (unsigned j = 0; j < 16; ++j) { const unsigned c = xb_ld(&bar[XB_XCNT(j)]); sum += c; cnt += (c > 0u) ? 1u : 0u; mine = (j == x) ? c : mine; }
        if (sum == G) break;
        __builtin_amdgcn_s_sleep(1);
        if ((++sp & 255u) == 0u) { if (xb_ld(&bar[XB_TMO])) break; if (sp > XB_SPIN_CAP) { atomicAdd(&bar[XB_TMO], 1u); break; } }
    }
    nloc = mine > 0u ? mine : 1u; nx = cnt > 0u ? cnt : 1u;
}
__device__ __forceinline__ void xcd_barrier(const XcdBarrier& b) {
    asm volatile("s_waitcnt vmcnt(0)" ::: "memory");
    __syncthreads();
    if (threadIdx.x == 0) {
        unsigned* bar = b.bar;
        __builtin_amdgcn_s_waitcnt(0);
        unsigned nloc = b.st[0], nx = b.st[1];
        if (nloc == 0u) { xcd_barrier_complete(bar, b.x, nloc, nx); b.st[0] = nloc; b.st[1] = nx; }
        const unsigned old = xb_add(&bar[XB_XSUB(b.x)], 1u);
        const unsigned gen = old / nloc;
        if (old + 1u == (gen + 1u) * nloc) {
            __builtin_amdgcn_fence(__ATOMIC_RELEASE, "agent");
            asm volatile("s_waitcnt vmcnt(0)" ::: "memory");
            const unsigned og = xb_add(&bar[XB_TOP], 1u);
            const unsigned tg = og / nx;
            if (og + 1u == (tg + 1u) * nx) xb_add(&bar[XB_TOPGEN], 1u);
            else XB_SPIN(xb_ld(&bar[XB_TOPGEN]) == tg, bar);
            __builtin_amdgcn_fence(__ATOMIC_ACQUIRE, "agent");
            xb_add(&bar[XB_XGEN(b.x)], 1u);
            asm volatile("s_waitcnt vmcnt(0)" ::: "memory");
        } else {
            XB_SPIN(xb_ld(&bar[XB_XGEN(b.x)]) == gen, bar);
            __builtin_amdgcn_fence(__ATOMIC_ACQUIRE, "agent");
            asm volatile("s_waitcnt vmcnt(0)" ::: "memory");
        }
    }
    __syncthreads();
}

#ifndef GEMM_SP2_
#define GEMM_SP2_ true
#endif
#ifndef GEMM_ALIGN_
#define GEMM_ALIGN_ true
#endif
namespace pg8 {
constexpr bool GEMM_SP2 = GEMM_SP2_, GEMM_ALIGN = GEMM_ALIGN_;
constexpr int BM = 256, BK = 64, HALF = 128, HTB = HALF * BK * 2, STAGE_BYTES = 8 * HTB;
__host__ __device__ __forceinline__ int lds_byte(int r, int c) { const int st = (r >> 4) * 2 + (c >> 5), rr = r & 15, cc = c & 31, ob = rr * 64 + cc * 2; return st * 1024 + (ob ^ (((ob >> 9) & 1) << 5)); }
__host__ __device__ __forceinline__ void stage_rc(int b, int& R, int& C) { const int st = b / 1024, sb = b % 1024, swz = sb ^ (((sb >> 9) & 1) << 5); R = (st >> 1) * 16 + swz / 64; C = (st & 1) * 32 + (swz % 64) / 2; }
__host__ __device__ __forceinline__ int perm32(int rho) { const int n = rho >> 4, i = rho & 15; return 8 * (i >> 2) + 4 * n + (i & 3); }
__host__ __device__ __forceinline__ int perm64(int rho) { const int n = rho >> 4, i = rho & 15; return 16 * (i >> 2) + 4 * n + (i & 3); }

struct Unit { int pm, pn, ex, rows, idx; };

template <class P>
__device__ __forceinline__ void gemm_phase(LAS unsigned char* lds, const P& pol) {
    int tid_ = threadIdx.x; asm volatile("" : "+v"(tid_));
    const int tid = tid_, wid = __builtin_amdgcn_readfirstlane(tid >> 6), lane = tid & 63, wr = wid >> 2, wc = wid & 3, fr = lane & 15, fq = lane >> 4;
    const int nt = pol.nt;
    int R0, C0, R1, C1; stage_rc(tid * 16, R0, C0); stage_rc(tid * 16 + 8192, R1, C1);
    unsigned voffB[2];
    { const int Rb0 = P::PERM16 ? (64 * (R0 >> 5) + perm64(R0 & 31)) : P::PERM ? ((R0 & ~31) + perm32(R0 & 31)) : R0, Rb1 = P::PERM16 ? (64 * (R1 >> 5) + perm64(R1 & 31)) : P::PERM ? ((R1 & ~31) + perm32(R1 & 31)) : R1;
      voffB[0] = (unsigned)Rb0 * pol.ldb + (unsigned)C0 * 2u; voffB[1] = (unsigned)Rb1 * pol.ldb + (unsigned)C1 * 2u; }
    const size_t kstep = (size_t)(BK * 2);
    const size_t hstepB = (size_t)(P::PERM16 ? 8 : HALF) * pol.ldb;
    const unsigned ldsw = (unsigned)wid * 1024u;
    const int aoff = lds_byte(wr * 64 + fr, fq * 8), boff = lds_byte(wc * 32 + fr, fq * 8);
#define PG8_SA(b, h) (((b) * 2 + (h)) * HTB)
#define PG8_SB(b, h) ((4 + (b) * 2 + (h)) * HTB)
#define PG8_STAGEB(bufoff, gbase) do { _Pragma("unroll") for (int _i = 0; _i < 2; ++_i) \
        __builtin_amdgcn_global_load_lds((const unsigned*)((const char*)(gbase) + voffB[_i]), (LAS unsigned*)(lds + (bufoff) + ldsw + _i * 8192), 16, 0, 0); } while (0)
#define PG8_STAGEA(bufoff, gbase, o0, o1) do { \
        __builtin_amdgcn_global_load_lds((const unsigned*)((const char*)(gbase) + (o0)), (LAS unsigned*)(lds + (bufoff) + ldsw), 16, 0, 0); \
        __builtin_amdgcn_global_load_lds((const unsigned*)((const char*)(gbase) + (o1)), (LAS unsigned*)(lds + (bufoff) + ldsw + 8192), 16, 0, 0); } while (0)
#define PG8_LDA(dst, b, h) do { _Pragma("unroll") for (int m = 0; m < 4; ++m) _Pragma("unroll") for (int k = 0; k < 2; ++k) dst[m][k] = *(const LAS bf16x8*)(lds + PG8_SA(b, h) + aoff + m * 2048 + k * 1024); } while (0)
#define PG8_LDB(dst, b, h) do { _Pragma("unroll") for (int n = 0; n < 2; ++n) _Pragma("unroll") for (int k = 0; k < 2; ++k) dst[n][k] = *(const LAS bf16x8*)(lds + PG8_SB(b, h) + boff + n * 2048 + k * 1024); } while (0)
#define PG8_CAT(x) __builtin_shufflevector(__builtin_bit_cast(v4i_t, (x)[0]), __builtin_bit_cast(v4i_t, (x)[1]), 0, 1, 2, 3, 4, 5, 6, 7)
#define PG8_MMA(ai, bj, At, Bt) do { __builtin_amdgcn_s_setprio(1); \
        if constexpr (P::FP8) {   \
            _Pragma("unroll") for (int m = 0; m < 4; ++m) _Pragma("unroll") for (int n = 0; n < 2; ++n) { const v8i_t bq = PG8_CAT(Bt[n]), aq = PG8_CAT(At[m]); \
                  \
                asm volatile("v_mfma_scale_f32_16x16x128_f8f6f4 %0, %1, %2, %0, %3, %4 op_sel_hi:[0,0,0]" : "+v"(acc[ai][bj][m][n]) : "v"(bq), "v"(aq), "v"(sc_w), "v"(sc_x)); } } \
        else { _Pragma("unroll") for (int m = 0; m < 4; ++m) _Pragma("unroll") for (int n = 0; n < 2; ++n) _Pragma("unroll") for (int k = 0; k < 2; ++k) \
            acc[ai][bj][m][n] = __builtin_amdgcn_mfma_f32_16x16x32_bf16(Bt[n][k], At[m][k], acc[ai][bj][m][n], 0, 0, 0); } \
        __builtin_amdgcn_s_setprio(0); } while (0)
#define PG8_WAIT_V(n) asm volatile("s_waitcnt vmcnt(" #n ")" ::: "memory")
#define PG8_WAIT_L(n) asm volatile("s_waitcnt lgkmcnt(" #n ")" ::: "memory")
#define PG8_BAR __builtin_amdgcn_s_barrier()
#define PG8_SCHED __builtin_amdgcn_sched_barrier(0)
    Unit cur, nxt; int ui = 0;
    if (!pol.next(0, cur)) return;
#if GEMM_STAGGER_US > 0
    {
        const unsigned long long t0 = __builtin_amdgcn_s_memrealtime(); const unsigned long long d = (unsigned long long)((blockIdx.x >> 3) & 7) * (GEMM_STAGGER_US * 100);
        while (__builtin_amdgcn_s_memrealtime() - t0 < d) __builtin_amdgcn_s_sleep(8);
    }
#endif
    f32x4 acc[2][2][4][2];
#pragma unroll
    for (int a = 0; a < 2; ++a)
#pragma unroll
        for (int b = 0; b < 2; ++b)
#pragma unroll
            for (int m = 0; m < 4; ++m)
#pragma unroll
                for (int n = 0; n < 2; ++n) acc[a][b][m][n] = (f32x4){0.f, 0.f, 0.f, 0.f};
    bf16x8 At[4][2], B0[2][2], B1[2][2];
    int sc_w = P::scale_w, sc_x = P::scale_x; if constexpr (P::FP8) asm volatile("" : "+v"(sc_w), "+v"(sc_x));
    unsigned oA[2][2], oN[2][2] = {{0u, 0u}, {0u, 0u}};
    pol.a_off(cur, R0, R1, C0, C1, oA);
    const char* cA = pol.a_base(cur); const char* cB = pol.b_base(cur);
    if constexpr (GEMM_SP2) {
        PG8_STAGEB(PG8_SB(0, 0), cB); PG8_STAGEB(PG8_SB(0, 1), cB + hstepB); PG8_STAGEA(PG8_SA(0, 0), cA, oA[0][0], oA[0][1]); PG8_STAGEA(PG8_SA(0, 1), cA, oA[1][0], oA[1][1]);
        if (wr == 1) PG8_BAR;
        PG8_WAIT_V(2); PG8_BAR;
        PG8_STAGEB(PG8_SB(1, 0), cB + kstep); PG8_STAGEA(PG8_SA(1, 0), cA + kstep, oA[0][0], oA[0][1]); PG8_STAGEB(PG8_SB(1, 1), cB + hstepB + kstep);
        PG8_WAIT_V(6); PG8_BAR;
    } else {
    PG8_STAGEB(PG8_SB(0, 0), cB); PG8_STAGEA(PG8_SA(0, 0), cA, oA[0][0], oA[0][1]); PG8_STAGEB(PG8_SB(0, 1), cB + hstepB); PG8_STAGEA(PG8_SA(0, 1), cA, oA[1][0], oA[1][1]);
    if (wr == 1) PG8_BAR;
    PG8_WAIT_V(4); PG8_BAR;
    PG8_STAGEB(PG8_SB(1, 0), cB + kstep); PG8_STAGEA(PG8_SA(1, 0), cA + kstep, oA[0][0], oA[0][1]); PG8_STAGEB(PG8_SB(1, 1), cB + hstepB + kstep);
    PG8_WAIT_V(6); PG8_BAR;
    }
    for (;;) {
        const bool has_next = pol.next(ui + 1, nxt);
        const char* nA; const char* nB;
        if (has_next) { if constexpr (P::GATHER) pol.a_off(nxt, R0, R1, C0, C1, oN); nA = pol.a_base(nxt); nB = pol.b_base(nxt); }
        else { if constexpr (P::GATHER) { oN[0][0] = oA[0][0]; oN[0][1] = oA[0][1]; oN[1][0] = oA[1][0]; oN[1][1] = oA[1][1]; } nA = cA; nB = cB; }
        for (int t = 0; t < nt; t += 2) {
            const bool last = (t == nt - 2);
            const char* a1 = cA + (size_t)(t + 1) * kstep;
            const char* a2 = last ? nA : cA + (size_t)(t + 2) * kstep; const char* b2 = last ? nB : cB + (size_t)(t + 2) * kstep;
            const char* a3 = a2 + kstep; const char* b3 = b2 + kstep;
            const unsigned s00 = (P::GATHER && last) ? oN[0][0] : oA[0][0], s01 = (P::GATHER && last) ? oN[0][1] : oA[0][1], s10 = (P::GATHER && last) ? oN[1][0] : oA[1][0], s11 = (P::GATHER && last) ? oN[1][1] : oA[1][1];
            if constexpr (GEMM_SP2) {
            PG8_LDB(B0, 0, 0); PG8_LDB(B1, 0, 1); PG8_SCHED; PG8_LDA(At, 0, 0); PG8_STAGEA(PG8_SA(1, 1), a1, oA[1][0], oA[1][1]);
            PG8_WAIT_V(8); PG8_WAIT_L(0); PG8_BAR; PG8_MMA(0, 0, At, B0); PG8_MMA(0, 1, At, B1); PG8_BAR; PG8_SCHED;
            PG8_LDA(At, 0, 1); PG8_STAGEB(PG8_SB(0, 0), b2); PG8_STAGEB(PG8_SB(0, 1), b2 + hstepB); PG8_STAGEA(PG8_SA(0, 0), a2, s00, s01);
            PG8_WAIT_V(8); PG8_WAIT_L(0); PG8_BAR; PG8_MMA(1, 0, At, B0); PG8_MMA(1, 1, At, B1); PG8_BAR; PG8_SCHED;
            PG8_LDB(B0, 1, 0); PG8_LDB(B1, 1, 1); PG8_SCHED; PG8_LDA(At, 1, 0); PG8_STAGEA(PG8_SA(0, 1), a2, s10, s11);
            PG8_WAIT_V(8); PG8_WAIT_L(0); PG8_BAR; PG8_MMA(0, 0, At, B0); PG8_MMA(0, 1, At, B1); PG8_BAR; PG8_SCHED;
            PG8_LDA(At, 1, 1); PG8_STAGEB(PG8_SB(1, 0), b3); PG8_STAGEB(PG8_SB(1, 1), b3 + hstepB); PG8_STAGEA(PG8_SA(1, 0), a3, s00, s01);
            PG8_WAIT_V(8); PG8_WAIT_L(0); PG8_BAR; PG8_MMA(1, 0, At, B0); PG8_MMA(1, 1, At, B1); PG8_BAR; PG8_SCHED;
            } else {
            PG8_LDB(B0, 0, 0); PG8_SCHED; PG8_LDA(At, 0, 0); PG8_STAGEA(PG8_SA(1, 1), a1, oA[1][0], oA[1][1]);
            PG8_WAIT_L(8); PG8_BAR; PG8_WAIT_L(0); PG8_MMA(0, 0, At, B0); PG8_BAR; PG8_SCHED;
            PG8_LDB(B1, 0, 1); PG8_STAGEB(PG8_SB(0, 0), b2);
            PG8_BAR; PG8_WAIT_L(0); PG8_MMA(0, 1, At, B1); PG8_BAR;
            PG8_LDA(At, 0, 1); PG8_STAGEA(PG8_SA(0, 0), a2, s00, s01);
            PG8_BAR; PG8_WAIT_L(0); PG8_MMA(1, 0, At, B0); PG8_BAR; PG8_SCHED;
            PG8_STAGEB(PG8_SB(0, 1), b2 + hstepB);
            PG8_WAIT_V(6); PG8_BAR; PG8_MMA(1, 1, At, B1); PG8_BAR;
            PG8_LDB(B0, 1, 0); PG8_SCHED; PG8_LDA(At, 1, 0); PG8_STAGEA(PG8_SA(0, 1), a2, s10, s11);
            PG8_WAIT_L(8); PG8_BAR; PG8_WAIT_L(0); PG8_MMA(0, 0, At, B0); PG8_BAR; PG8_SCHED;
            PG8_LDB(B1, 1, 1); PG8_STAGEB(PG8_SB(1, 0), b3);
            PG8_BAR; PG8_WAIT_L(0); PG8_MMA(0, 1, At, B1); PG8_BAR;
            PG8_LDA(At, 1, 1); PG8_STAGEA(PG8_SA(1, 0), a3, s00, s01);
            PG8_BAR; PG8_WAIT_L(0); PG8_MMA(1, 0, At, B0); PG8_BAR; PG8_SCHED;
            PG8_STAGEB(PG8_SB(1, 1), b3 + hstepB);
            PG8_WAIT_V(6); PG8_BAR; PG8_MMA(1, 1, At, B1); PG8_BAR;
            }
        }
        if constexpr (GEMM_ALIGN) { if (wr == 0) PG8_BAR; }
        if constexpr (P::FP8) asm volatile("s_nop 15\n\ts_nop 15" ::: "memory");
        pol.epi(acc, cur, wr, wc, fr, fq);
        if (!has_next) break;
#pragma unroll
        for (int a = 0; a < 2; ++a)
#pragma unroll
            for (int b = 0; b < 2; ++b)
#pragma unroll
                for (int m = 0; m < 4; ++m)
#pragma unroll
                    for (int n = 0; n < 2; ++n) acc[a][b][m][n] = (f32x4){0.f, 0.f, 0.f, 0.f};
        cur = nxt; cA = nA; cB = nB; ++ui;
        if constexpr (P::GATHER) { oA[0][0] = oN[0][0]; oA[0][1] = oN[0][1]; oA[1][0] = oN[1][0]; oA[1][1] = oN[1][1]; }
        if constexpr (GEMM_ALIGN) { if (wr == 1) PG8_BAR; }
    }
    PG8_WAIT_V(0);
    if constexpr (!GEMM_ALIGN) { if (wr == 0) PG8_BAR; }
    PG8_BAR;
#undef PG8_SA
#undef PG8_SB
#undef PG8_STAGEA
#undef PG8_STAGEB
#undef PG8_LDA
#undef PG8_LDB
#undef PG8_MMA
#undef PG8_CAT
#undef PG8_WAIT_V
#undef PG8_WAIT_L
#undef PG8_BAR
#undef PG8_SCHED
}

__device__ __forceinline__ bool static_order(int nM, int nN, int G, int c, int i, int& pm, int& pn) {
    const int nwg = nM * nN; const long L = (long)i * G + c; if (L >= nwg) return false;
    int wgid = (int)L; { const int q = nwg / 8, r = nwg % 8, xcd = wgid % 8, off = wgid / 8; wgid = (xcd < r ? xcd * (q + 1) : r * (q + 1) + (xcd - r) * q) + off; }
    const int nig = 8 * nN, gid = wgid / nig, fm = gid * 8, gsz = (nM - fm) < 8 ? (nM - fm) : 8;
    pm = fm + ((wgid % nig) % gsz); pn = (wgid % nig) / gsz; return true;
}

__device__ __forceinline__ void store_tile_bf16(const f32x4 (&acc)[2][2][4][2], bf16_t* base  , size_t ldc, int wr, int wc, int fr, int fq, int rows_valid) {
#pragma unroll
    for (int ai = 0; ai < 2; ++ai)
#pragma unroll
        for (int m = 0; m < 4; ++m) { const int r = ai * HALF + wr * 64 + m * 16 + fr; if (r < rows_valid) { bf16_t* rowp = base + (size_t)r * ldc + wc * 32 + 8 * fq;
#pragma unroll
            for (int bj = 0; bj < 2; ++bj) { const f32x4 v0 = acc[ai][bj][m][0], v1 = acc[ai][bj][m][1];
                u32x4 w; w.x = cvt_pk_bf16(v0[0], v0[1]); w.y = cvt_pk_bf16(v0[2], v0[3]); w.z = cvt_pk_bf16(v1[0], v1[1]); w.w = cvt_pk_bf16(v1[2], v1[3]);
                *(u32x4*)(rowp + bj * HALF) = w; } } }
}
}

namespace att {
constexpr int NW = 8, QBLK = 32, KVBLK = 64, DV = 128;
constexpr int SHM_V = KVBLK * DV * 2  , SHM_K = KVBLK * 128 * 2  , SHM_K2 = KVBLK * 64 * 2  ;
constexpr int OFF_V = 0, OFF_K = 2 * SHM_V, OFF_K2 = OFF_K + 2 * SHM_K, OFF_WS = OFF_K2 + 2 * SHM_K2, ATT_LDS = OFF_WS + NW * 64 * 4  , OFF_QR = ATT_LDS  ;
constexpr float THR = 8.f;
#define KSWZ(row, colB) ((row) * 256 + ((colB) ^ (((row) & 7) << 4)))
#define KSWZ64(row, colB) ((row) * 128 + ((colB) ^ ((((row) >> 1) & 7) << 4)))
#define SBAR() __builtin_amdgcn_sched_barrier(0)
__device__ __forceinline__ int crow(int r, int hi) { return (r & 3) + 8 * (r >> 2) + 4 * hi; }
__device__ __forceinline__ int v_st(int k, int c) { const int kk = (k & ~0xC) | ((k & 4) << 1) | ((k & 8) >> 1); return ((kk >> 3) * 4 + (c >> 5)) * 512 + ((kk & 7) * 32 + (c & 31)) * 2; }
__device__ __forceinline__ int v_rd_base(int lane) { return ((lane & 3) << 3) | (((lane >> 2) & 3) << 6) | (((lane >> 4) & 1) << 5) | (((lane >> 5) & 1) << 8); }
constexpr int v_rd_off(int d0, int ks, int half) { return d0 * 512 + ks * 4096 + half * 2048; }
template <int OFF> __device__ __forceinline__ s16x4 tr_read(int vb) {
    s16x4 r; asm volatile("ds_read_b64_tr_b16 %0, %1 offset:%2" : "=&v"(r) : "v"(vb), "i"(OFF) : "memory"); return r;
}
template <int D0> __device__ __forceinline__ void pv_one(f32x16& od, int vb, bf16x8 pa0, bf16x8 pa1, bf16x8 pa2, bf16x8 pa3) {
    const s16x4 l0 = tr_read<v_rd_off(D0, 0, 0)>(vb), h0 = tr_read<v_rd_off(D0, 0, 1)>(vb), l1 = tr_read<v_rd_off(D0, 1, 0)>(vb), h1 = tr_read<v_rd_off(D0, 1, 1)>(vb);
    const s16x4 l2 = tr_read<v_rd_off(D0, 2, 0)>(vb), h2 = tr_read<v_rd_off(D0, 2, 1)>(vb), l3 = tr_read<v_rd_off(D0, 3, 0)>(vb), h3 = tr_read<v_rd_off(D0, 3, 1)>(vb);
    asm volatile("s_waitcnt lgkmcnt(0)" ::: "memory"); SBAR();
#define PK(L, H) (bf16x8){L[0], L[1], L[2], L[3], H[0], H[1], H[2], H[3]}
    od = __builtin_amdgcn_mfma_f32_32x32x16_bf16(pa0, PK(l0, h0), od, 0, 0, 0);
    od = __builtin_amdgcn_mfma_f32_32x32x16_bf16(pa1, PK(l1, h1), od, 0, 0, 0);
    od = __builtin_amdgcn_mfma_f32_32x32x16_bf16(pa2, PK(l2, h2), od, 0, 0, 0);
    od = __builtin_amdgcn_mfma_f32_32x32x16_bf16(pa3, PK(l3, h3), od, 0, 0, 0);
#undef PK
}
__device__ __forceinline__ void pv_d0(f32x16* o, int vb, bf16x8 pa0, bf16x8 pa1, bf16x8 pa2, bf16x8 pa3) {
    pv_one<0>(o[0], vb, pa0, pa1, pa2, pa3); pv_one<1>(o[1], vb, pa0, pa1, pa2, pa3); pv_one<2>(o[2], vb, pa0, pa1, pa2, pa3); pv_one<3>(o[3], vb, pa0, pa1, pa2, pa3);
}
__device__ __forceinline__ void partialSM(f32x16& p0, f32x16& p1, float& m_reg, float& mn, float& alpha, float C, float thr_raw) {
    float pmax = p0[0];
#pragma unroll
    for (int r = 1; r < 16; ++r) pmax = fmaxf(pmax, p0[r]);
#pragma unroll
    for (int r = 0; r < 16; ++r) pmax = fmaxf(pmax, p1[r]);
    { auto rr = __builtin_amdgcn_permlane32_swap(__builtin_bit_cast(unsigned, pmax), __builtin_bit_cast(unsigned, pmax), false, false);
      pmax = fmaxf(__builtin_bit_cast(float, rr[0]), __builtin_bit_cast(float, rr[1])); }
    if (__builtin_expect(__all(pmax - m_reg <= thr_raw), 1)) { mn = m_reg; alpha = 1.f; }
    else { mn = fmaxf(m_reg, pmax); alpha = __builtin_amdgcn_exp2f((m_reg - mn) * C); m_reg = mn; }
    const float mnC = -mn * C;
#pragma unroll
    for (int r = 0; r < 16; ++r) p0[r] = fmaf(p0[r], C, mnC);
#pragma unroll
    for (int r = 0; r < 16; ++r) p1[r] = fmaf(p1[r], C, mnC);
#pragma unroll
    for (int r = 0; r < 16; ++r) p0[r] = __builtin_amdgcn_exp2f(p0[r]);
}
__device__ __forceinline__ void finishSM(f32x16& p0, f32x16& p1, float alpha, float& l_reg, bf16x8& pa0, bf16x8& pa1, bf16x8& pa2, bf16x8& pa3) {
#pragma unroll
    for (int r = 0; r < 16; ++r) p1[r] = __builtin_amdgcn_exp2f(p1[r]);
    float ps = 0;
#pragma unroll
    for (int r = 0; r < 16; ++r) ps += p0[r];
#pragma unroll
    for (int r = 0; r < 16; ++r) ps += p1[r];
    { auto rr = __builtin_amdgcn_permlane32_swap(__builtin_bit_cast(unsigned, ps), __builtin_bit_cast(unsigned, ps), false, false);
      ps = __builtin_bit_cast(float, rr[0]) + __builtin_bit_cast(float, rr[1]); }
    l_reg = l_reg * alpha + ps;
#define PK4(P, BASE, OUT) do { unsigned a0 = cvt_pk_bf16(P[BASE + 0], P[BASE + 1]), a1 = cvt_pk_bf16(P[BASE + 2], P[BASE + 3]);   \
    unsigned b0 = cvt_pk_bf16(P[BASE + 4], P[BASE + 5]), b1 = cvt_pk_bf16(P[BASE + 6], P[BASE + 7]);                              \
    auto r0 = __builtin_amdgcn_permlane32_swap(a0, b0, false, false); auto r1 = __builtin_amdgcn_permlane32_swap(a1, b1, false, false); \
    u32x4 w = {r0[0], r1[0], r0[1], r1[1]}; OUT = __builtin_bit_cast(bf16x8, w); } while (0)
    PK4(p0, 0, pa0); PK4(p0, 8, pa1); PK4(p1, 0, pa2); PK4(p1, 8, pa3);
#undef PK4
}
__device__ __forceinline__ bf16x8 rope8(bf16x8 v, const char* tabc, unsigned off) {
    const f32x4 c01 = *(const f32x4*)(tabc + off), c23 = *(const f32x4*)(tabc + off + 16);
    const u32x4 w = __builtin_bit_cast(u32x4, v); u32x4 o;
    { const float x1 = bflo(w[0]), x2 = bfhi(w[0]); o[0] = cvt_pk_bf16(x1 * c01[0] - x2 * c01[1], x1 * c01[1] + x2 * c01[0]); }
    { const float x1 = bflo(w[1]), x2 = bfhi(w[1]); o[1] = cvt_pk_bf16(x1 * c01[2] - x2 * c01[3], x1 * c01[3] + x2 * c01[2]); }
    { const float x1 = bflo(w[2]), x2 = bfhi(w[2]); o[2] = cvt_pk_bf16(x1 * c23[0] - x2 * c23[1], x1 * c23[1] + x2 * c23[0]); }
    { const float x1 = bflo(w[3]), x2 = bfhi(w[3]); o[3] = cvt_pk_bf16(x1 * c23[2] - x2 * c23[3], x1 * c23[3] + x2 * c23[2]); }
    return __builtin_bit_cast(bf16x8, o);
}

struct UnitDesc {
    const bf16_t* Q; int ldq;
    const bf16_t* K; int ldk;
    const bf16_t* K2; int ldk2;
    const bf16_t* V; int ldv;
    bf16_t* O; int ldo;
    int NT;
    float C;
    const f32x2* rope; int qtok0;
    int seg_tiles, seg2_row0;
    int ktok0;
    float sink_l2;
};
template <int MODE>
__device__ __forceinline__ void attn_unit(const UnitDesc& U, char* lds) {
    constexpr int DQK = MODE == 0 ? 64 : (MODE == 1 ? 192 : 128), NQ = DQK / 16, NQR = NQ;
    int tid_ = threadIdx.x; asm volatile("" : "+v"(tid_));
    const int tid = tid_, wid = tid >> 6, lane = tid & 63, r32 = lane & 31, hi = lane >> 5;
    constexpr int NBUF = (MODE == 0) ? 4 : 3;
    constexpr int oK = NBUF * SHM_V, oK2 = oK + NBUF * SHM_K, oWS = oK2 + (MODE == 1 ? NBUF * SHM_K2 : 0), oQR = oWS + NW * 64 * 4;
    static_assert(oQR <= 152 * 1024, "attention LDS map");
    char* V_lds = lds; char* K_lds = lds + oK; char* K2_lds = lds + oK2;
    float* ws = (float*)(lds + oWS) + wid * 64; float* li_l = ws; float* al_l = ws + 32;
    float m_reg = -1e30f, l_reg = 0; f32x16 o[4] = {}; bf16x8 qr[NQR];
    bf16x8* QRl = (bf16x8*)(lds + (MODE == 1 ? OFF_QR : 0)) + wid * 512 + lane;
    {   const bf16_t* Qw = U.Q + (size_t)(wid * QBLK + r32) * U.ldq + hi * 8;
        const int qt = U.qtok0 + wid * QBLK + r32, prow = qt >> 6, pcol = qt & 63;
        constexpr int RQ = (MODE == 2) ? 32 : 16;
        const unsigned orow = (unsigned)prow * RQ * 8 + hi * 32, ocol = (unsigned)pcol * RQ * 8 + hi * 32; const char* tabc = (const char*)U.rope;
#pragma unroll
        for (int d0 = 0; d0 < NQ; ++d0) { bf16x8 v = *reinterpret_cast<const bf16x8*>(Qw + d0 * 16);
            const int pi = (MODE == 1) ? (d0 - 8) * 8 : d0 * 8;
            if (MODE != 1 || d0 >= 8) { if (MODE != 0 || U.rope) v = rope8(v, tabc, (pi < RQ ? orow : ocol) + (unsigned)((pi < RQ ? pi : pi - RQ) * 8)); }
            if (MODE == 1 && d0 >= NQR) QRl[(d0 - NQR) * 64] = v; else qr[d0 < NQR ? d0 : 0] = v; }
    }
    const float thr_raw = THR * 1.4426950408889634f / U.C;
    const int sr = tid >> 4, sc = (tid & 15) * 8;
    const int vst0 = v_st(sr, sc), vst1 = v_st(32 + sr, sc);
    const int k64r = tid >> 3, k64c = (tid & 7) * 8;
    const int vb0 = (int)(uintptr_t)V_lds + v_rd_base(lane);
    constexpr int DEPTH = (MODE == 0) ? 2 : 1, SE = 0, SO = DEPTH - 1;
    bf16x8 sv0[DEPTH], sv1[DEPTH], sk0[DEPTH], sk1[DEPTH], sk2[DEPTH];
    auto krow = [&](int t) -> int { if (MODE == 2) return t < U.seg_tiles ? t * 64 : U.seg2_row0 + (t - U.seg_tiles) * 64; return t * 64; };
#define SLOAD(i, t) do { const int _r = krow(t); \
    sv0[i] = *reinterpret_cast<const bf16x8*>(U.V + (size_t)(_r + sr) * U.ldv + sc); sv1[i] = *reinterpret_cast<const bf16x8*>(U.V + (size_t)(_r + 32 + sr) * U.ldv + sc); \
    if (MODE == 0) { sk0[i] = *reinterpret_cast<const bf16x8*>(U.K + (size_t)(_r + k64r) * U.ldk + k64c); } \
    else { sk0[i] = *reinterpret_cast<const bf16x8*>(U.K + (size_t)(_r + sr) * U.ldk + sc); sk1[i] = *reinterpret_cast<const bf16x8*>(U.K + (size_t)(_r + 32 + sr) * U.ldk + sc); } \
    if (MODE == 1) { sk2[i] = *reinterpret_cast<const bf16x8*>(U.K2 + (size_t)(_r + k64r) * U.ldk2 + k64c); } } while (0)
#define SWRITE(b, i) do { *(bf16x8*)(V_lds + (b) * SHM_V + vst0) = sv0[i]; *(bf16x8*)(V_lds + (b) * SHM_V + vst1) = sv1[i]; \
    if (MODE == 0) { *(bf16x8*)(K_lds + (b) * SHM_K + KSWZ64(k64r, k64c * 2)) = sk0[i]; } \
    else { *(bf16x8*)(K_lds + (b) * SHM_K + KSWZ(sr, sc * 2)) = sk0[i]; *(bf16x8*)(K_lds + (b) * SHM_K + KSWZ(32 + sr, sc * 2)) = sk1[i]; } \
    if (MODE == 1) { *(bf16x8*)(K2_lds + (b) * SHM_K2 + KSWZ64(k64r, k64c * 2)) = sk2[i]; } } while (0)
#define SWAIT() do { if (MODE == 0) asm volatile("s_waitcnt vmcnt(3)" ::: "memory"); else asm volatile("s_waitcnt vmcnt(0)" ::: "memory"); } while (0)
    const int widu = __builtin_amdgcn_readfirstlane(wid);
    LAS unsigned char* ldsA = (LAS unsigned char*)lds;
    int dvo0, dvo1, dko;
    {   const int p = tid, kkv = ((p >> 7) << 3) | ((p >> 2) & 7), kv = (kkv & ~0xC) | ((kkv & 4) << 1) | ((kkv & 8) >> 1), cv = ((p >> 5) & 3) * 32 + (p & 3) * 8;
        dvo0 = kv * U.ldv + cv; dvo1 = (kv + 32) * U.ldv + cv;
        const int rk = p >> 3, ck = ((p & 7) ^ ((rk >> 1) & 7)) * 8; dko = rk * U.ldk + ck; }
    int dko1 = 0, dk2o = 0;
    if (MODE == 1) { const int p = tid, rk = p >> 4, ck = ((p & 15) ^ (rk & 7)) * 8; dko = rk * U.ldk + ck; dko1 = (rk + 32) * U.ldk + ck;
        const int r2 = p >> 3, c2 = ((p & 7) ^ ((r2 >> 1) & 7)) * 8; dk2o = r2 * U.ldk2 + c2; }
#define DMA_TILE1(t, b) do { const int _r = (t) * 64; const bf16_t* _v = U.V + (size_t)_r * U.ldv; const bf16_t* _k = U.K + (size_t)_r * U.ldk; const bf16_t* _k2 = U.K2 + (size_t)_r * U.ldk2; \
    __builtin_amdgcn_global_load_lds((const unsigned*)(_v + dvo0), (LAS unsigned*)(ldsA + (b) * SHM_V + widu * 1024), 16, 0, 0); \
    __builtin_amdgcn_global_load_lds((const unsigned*)(_v + dvo1), (LAS unsigned*)(ldsA + (b) * SHM_V + 8192 + widu * 1024), 16, 0, 0); \
    __builtin_amdgcn_global_load_lds((const unsigned*)(_k + dko), (LAS unsigned*)(ldsA + oK + (b) * SHM_K + widu * 1024), 16, 0, 0); \
    __builtin_amdgcn_global_load_lds((const unsigned*)(_k + dko1), (LAS unsigned*)(ldsA + oK + (b) * SHM_K + 8192 + widu * 1024), 16, 0, 0); \
    __builtin_amdgcn_global_load_lds((const unsigned*)(_k2 + dk2o), (LAS unsigned*)(ldsA + oK2 + (b) * SHM_K2 + widu * 1024), 16, 0, 0); } while (0)
#define DMA_TILE(t) do { const int _r = (t) * 64, _b = (t) & 3; const bf16_t* _v = U.V + (size_t)_r * U.ldv; const bf16_t* _k = U.K + (size_t)_r * U.ldk; \
    __builtin_amdgcn_global_load_lds((const unsigned*)(_v + dvo0), (LAS unsigned*)(ldsA + _b * SHM_V + widu * 1024), 16, 0, 0); \
    __builtin_amdgcn_global_load_lds((const unsigned*)(_v + dvo1), (LAS unsigned*)(ldsA + _b * SHM_V + 8192 + widu * 1024), 16, 0, 0); \
    __builtin_amdgcn_global_load_lds((const unsigned*)(_k + dko), (LAS unsigned*)(ldsA + oK + _b * SHM_K + widu * 1024), 16, 0, 0); } while (0)
#define VMW(n) asm volatile("s_waitcnt vmcnt(" #n ")" ::: "memory")
#define RESC(a) do { if (__any((a) < 1.f)) { if (hi == 0) al_l[r32] = (a); asm volatile("s_waitcnt lgkmcnt(0)" ::: "memory"); \
    _Pragma("unroll") for (int d = 0; d < 4; ++d) _Pragma("unroll") for (int r = 0; r < 16; ++r) o[d][r] *= al_l[crow(r, hi)]; } } while (0)
#define QKT(p0, p1, b) do { p0 = f32x16{}; p1 = f32x16{}; \
    if (MODE == 0) { _Pragma("unroll") for (int d0 = 0; d0 < 4; ++d0) { const int cb = (d0 * 16 + hi * 8) * 2; \
        const bf16x8 b0 = *reinterpret_cast<const bf16x8*>(K_lds + (b) * SHM_K + KSWZ64(r32, cb)); const bf16x8 b1 = *reinterpret_cast<const bf16x8*>(K_lds + (b) * SHM_K + KSWZ64(32 + r32, cb)); \
        p0 = __builtin_amdgcn_mfma_f32_32x32x16_bf16(b0, qr[d0], p0, 0, 0, 0); p1 = __builtin_amdgcn_mfma_f32_32x32x16_bf16(b1, qr[d0], p1, 0, 0, 0); } } \
    else { _Pragma("unroll") for (int d0 = 0; d0 < 8; ++d0) { const int cb = (d0 * 16 + hi * 8) * 2; \
        const bf16x8 b0 = *reinterpret_cast<const bf16x8*>(K_lds + (b) * SHM_K + KSWZ(r32, cb)); const bf16x8 b1 = *reinterpret_cast<const bf16x8*>(K_lds + (b) * SHM_K + KSWZ(32 + r32, cb)); \
        const bf16x8 qf = (MODE == 1 && d0 >= NQR) ? QRl[(d0 >= NQR ? d0 - NQR : 0) * 64] : qr[d0 < NQR ? d0 : 0]; \
        p0 = __builtin_amdgcn_mfma_f32_32x32x16_bf16(b0, qf, p0, 0, 0, 0); p1 = __builtin_amdgcn_mfma_f32_32x32x16_bf16(b1, qf, p1, 0, 0, 0); \
        if (MODE == 1 && (d0 == 3 || d0 == 7)) SBAR(); } \
      if (MODE == 1) { _Pragma("unroll") for (int d0 = 0; d0 < 4; ++d0) { const int cb = (d0 * 16 + hi * 8) * 2; \
        const bf16x8 b0 = *reinterpret_cast<const bf16x8*>(K2_lds + (b) * SHM_K2 + KSWZ64(r32, cb)); const bf16x8 b1 = *reinterpret_cast<const bf16x8*>(K2_lds + (b) * SHM_K2 + KSWZ64(32 + r32, cb)); \
        const bf16x8 qf = qr[(8 + d0) < NQR ? 8 + d0 : 0]; p0 = __builtin_amdgcn_mfma_f32_32x32x16_bf16(b0, qf, p0, 0, 0, 0); p1 = __builtin_amdgcn_mfma_f32_32x32x16_bf16(b1, qf, p1, 0, 0, 0); } } } } while (0)
#define MASK(p0, p1, t) do { if (MODE == 2) { if ((t) >= U.seg_tiles) { const int _d0 = U.ktok0 + ((t) - U.seg_tiles) * 64 - (U.qtok0 + wid * QBLK + r32); \
    _Pragma("unroll") for (int r = 0; r < 16; ++r) { const int _dk = _d0 + crow(r, hi); \
        if (_dk > 128 || _dk < -128) p0[r] = -1e30f; if (_dk + 32 > 128 || _dk + 32 < -128) p1[r] = -1e30f; } } } } while (0)
    f32x16 pA0, pA1, pB0, pB1; float mnA, mnB, alA, alB; bf16x8 pa0, pa1, pa2, pa3; const int NT = U.NT;
    if constexpr (MODE == 0) {
    DMA_TILE(0); DMA_TILE(1); if (2 < NT) DMA_TILE(2);
    if (2 < NT) VMW(6); else VMW(3);
    __syncthreads();
    QKT(pA0, pA1, 0); partialSM(pA0, pA1, m_reg, mnA, alA, U.C, thr_raw);
    if (2 < NT) VMW(3); else VMW(0);
    __syncthreads();
    for (int j = 1; j + 1 < NT; j += 2) {
        SBAR(); QKT(pB0, pB1, j & 3);
        finishSM(pA0, pA1, alA, l_reg, pa0, pa1, pa2, pa3); SBAR();
        DMA_TILE(j + 2); SBAR();
        pv_d0(o, vb0 + ((j - 1) & 3) * SHM_V, pa0, pa1, pa2, pa3); partialSM(pB0, pB1, m_reg, mnB, alB, U.C, thr_raw);
        VMW(3);
        RESC(alB); __syncthreads();
        SBAR(); QKT(pA0, pA1, (j + 1) & 3);
        finishSM(pB0, pB1, alB, l_reg, pa0, pa1, pa2, pa3); SBAR();
        if (j + 3 < NT) DMA_TILE(j + 3); SBAR();
        pv_d0(o, vb0 + (j & 3) * SHM_V, pa0, pa1, pa2, pa3); partialSM(pA0, pA1, m_reg, mnA, alA, U.C, thr_raw);
        if (j + 3 < NT) VMW(3); else VMW(0);
        RESC(alA); __syncthreads();
    }
    SBAR(); QKT(pB0, pB1, (NT - 1) & 3);
    finishSM(pA0, pA1, alA, l_reg, pa0, pa1, pa2, pa3); SBAR();
    pv_d0(o, vb0 + ((NT - 2) & 3) * SHM_V, pa0, pa1, pa2, pa3); partialSM(pB0, pB1, m_reg, mnB, alB, U.C, thr_raw);
    RESC(alB);
    finishSM(pB0, pB1, alB, l_reg, pa0, pa1, pa2, pa3); SBAR();
    pv_d0(o, vb0 + ((NT - 1) & 3) * SHM_V, pa0, pa1, pa2, pa3);
    } else if constexpr (MODE == 1) {
    DMA_TILE1(0, 0); DMA_TILE1(1, 1);
    VMW(5); __syncthreads();
    QKT(pA0, pA1, 0); partialSM(pA0, pA1, m_reg, mnA, alA, U.C, thr_raw);
    VMW(0); __syncthreads();
    int bm = 0, bc = 1, bn = 2;
    for (int j = 1; j + 1 < NT; j += 2) {
        DMA_TILE1(j + 1, bn);
        SBAR(); QKT(pB0, pB1, bc);
        finishSM(pA0, pA1, alA, l_reg, pa0, pa1, pa2, pa3); SBAR();
        pv_d0(o, vb0 + bm * SHM_V, pa0, pa1, pa2, pa3); partialSM(pB0, pB1, m_reg, mnB, alB, U.C, thr_raw);
        VMW(0); RESC(alB); __syncthreads();
        { const int t_ = bm; bm = bc; bc = bn; bn = t_; }
        if (j + 2 < NT) DMA_TILE1(j + 2, bn);
        SBAR(); QKT(pA0, pA1, bc);
        finishSM(pB0, pB1, alB, l_reg, pa0, pa1, pa2, pa3); SBAR();
        pv_d0(o, vb0 + bm * SHM_V, pa0, pa1, pa2, pa3); partialSM(pA0, pA1, m_reg, mnA, alA, U.C, thr_raw);
        VMW(0); RESC(alA); __syncthreads();
        { const int t_ = bm; bm = bc; bc = bn; bn = t_; }
    }
    SBAR(); QKT(pB0, pB1, bc);
    finishSM(pA0, pA1, alA, l_reg, pa0, pa1, pa2, pa3); SBAR();
    pv_d0(o, vb0 + bm * SHM_V, pa0, pa1, pa2, pa3); partialSM(pB0, pB1, m_reg, mnB, alB, U.C, thr_raw);
    RESC(alB);
    finishSM(pB0, pB1, alB, l_reg, pa0, pa1, pa2, pa3); SBAR();
    pv_d0(o, vb0 + bc * SHM_V, pa0, pa1, pa2, pa3);
    } else if constexpr (NBUF == 2) {
    SLOAD(SE, 0); asm volatile("s_waitcnt vmcnt(0)" ::: "memory"); SWRITE(0, SE); __syncthreads();
    QKT(pA0, pA1, 0); MASK(pA0, pA1, 0); partialSM(pA0, pA1, m_reg, mnA, alA, U.C, thr_raw);
    SLOAD(SO, 1); if (DEPTH == 2) { if (2 < NT) SLOAD(SE, 2); }
    if (DEPTH == 2 && 2 < NT) SWAIT(); else asm volatile("s_waitcnt vmcnt(0)" ::: "memory");
    SWRITE(1, SO); __syncthreads();
    for (int j = 1; j + 1 < NT; j += 2) {
        SBAR(); QKT(pB0, pB1, 1); MASK(pB0, pB1, j);
        finishSM(pA0, pA1, alA, l_reg, pa0, pa1, pa2, pa3); SBAR();
        SLOAD(SO, j + DEPTH); SBAR();
        pv_d0(o, vb0, pa0, pa1, pa2, pa3); partialSM(pB0, pB1, m_reg, mnB, alB, U.C, thr_raw);
        __syncthreads(); SWAIT(); SWRITE(0, SE);
        RESC(alB); __syncthreads();
        SBAR(); QKT(pA0, pA1, 0); MASK(pA0, pA1, j + 1);
        finishSM(pB0, pB1, alB, l_reg, pa0, pa1, pa2, pa3); SBAR();
        if (DEPTH == 1 || j + 3 < NT) SLOAD(SE, j + 1 + DEPTH); SBAR();
        pv_d0(o, vb0 + SHM_V, pa0, pa1, pa2, pa3); partialSM(pA0, pA1, m_reg, mnA, alA, U.C, thr_raw);
        __syncthreads(); if (DEPTH == 1 || j + 3 < NT) SWAIT(); else asm volatile("s_waitcnt vmcnt(0)" ::: "memory");
        SWRITE(1, SO);
        RESC(alA); __syncthreads();
    }
    SBAR(); QKT(pB0, pB1, 1); MASK(pB0, pB1, NT - 1);
    finishSM(pA0, pA1, alA, l_reg, pa0, pa1, pa2, pa3); SBAR();
    pv_d0(o, vb0, pa0, pa1, pa2, pa3); partialSM(pB0, pB1, m_reg, mnB, alB, U.C, thr_raw);
    __syncthreads(); RESC(alB);
    finishSM(pB0, pB1, alB, l_reg, pa0, pa1, pa2, pa3); SBAR();
    pv_d0(o, vb0 + SHM_V, pa0, pa1, pa2, pa3);
    } else {
    SLOAD(SE, 0); asm volatile("s_waitcnt vmcnt(0)" ::: "memory"); SWRITE(0, SE);
    SLOAD(SO, 1); if (DEPTH == 2) { if (2 < NT) SLOAD(SE, 2); }
    __syncthreads();
    QKT(pA0, pA1, 0); MASK(pA0, pA1, 0); partialSM(pA0, pA1, m_reg, mnA, alA, U.C, thr_raw);
    if (DEPTH == 2 && 2 < NT) SWAIT(); else asm volatile("s_waitcnt vmcnt(0)" ::: "memory");
    SWRITE(1, SO); __syncthreads();
    int bm = 0, bc = 1, bn = 2;
    for (int j = 1; j + 1 < NT; j += 2) {
        SBAR(); QKT(pB0, pB1, bc); MASK(pB0, pB1, j);
        finishSM(pA0, pA1, alA, l_reg, pa0, pa1, pa2, pa3); SBAR();
        SLOAD(SO, j + DEPTH); SBAR();
        pv_d0(o, vb0 + bm * SHM_V, pa0, pa1, pa2, pa3); partialSM(pB0, pB1, m_reg, mnB, alB, U.C, thr_raw);
        SWAIT(); SWRITE(bn, SE);
        RESC(alB); __syncthreads();
        { const int t_ = bm; bm = bc; bc = bn; bn = t_; }
        SBAR(); QKT(pA0, pA1, bc); MASK(pA0, pA1, j + 1);
        finishSM(pB0, pB1, alB, l_reg, pa0, pa1, pa2, pa3); SBAR();
        if (DEPTH == 1 || j + 3 < NT) SLOAD(SE, j + 1 + DEPTH); SBAR();
        pv_d0(o, vb0 + bm * SHM_V, pa0, pa1, pa2, pa3); partialSM(pA0, pA1, m_reg, mnA, alA, U.C, thr_raw);
        if (DEPTH == 1 || j + 3 < NT) SWAIT(); else asm volatile("s_waitcnt vmcnt(0)" ::: "memory");
        SWRITE(bn, SO);
        RESC(alA); __syncthreads();
        { const int t_ = bm; bm = bc; bc = bn; bn = t_; }
    }
    SBAR(); QKT(pB0, pB1, bc); MASK(pB0, pB1, NT - 1);
    finishSM(pA0, pA1, alA, l_reg, pa0, pa1, pa2, pa3); SBAR();
    pv_d0(o, vb0 + bm * SHM_V, pa0, pa1, pa2, pa3); partialSM(pB0, pB1, m_reg, mnB, alB, U.C, thr_raw);
    RESC(alB);
    finishSM(pB0, pB1, alB, l_reg, pa0, pa1, pa2, pa3); SBAR();
    pv_d0(o, vb0 + bc * SHM_V, pa0, pa1, pa2, pa3);
    }
    if (MODE == 2) l_reg += __builtin_amdgcn_exp2f(U.sink_l2 - m_reg * U.C);
    if (hi == 0) li_l[r32] = l_reg; asm volatile("s_waitcnt lgkmcnt(0)" ::: "memory");
    float rli[16];
#pragma unroll
    for (int r = 0; r < 16; ++r) rli[r] = __builtin_amdgcn_rcpf(li_l[crow(r, hi)]);
    int hio = hi, r32o = r32; asm volatile("" : "+v"(hio), "+v"(r32o));
    bf16_t* Ow = U.O + (size_t)(wid * QBLK + 4 * hio) * U.ldo + r32o;
#pragma unroll
    for (int r = 0; r < 16; ++r) { const int orow = (r & 3) + 8 * (r >> 2);
#pragma unroll
        for (int d0 = 0; d0 < 4; ++d0) Ow[(size_t)orow * U.ldo + d0 * 32] = (bf16_t)f2bf(o[d0][r] * rli[r]); }
    __syncthreads();
#undef SLOAD
#undef SWRITE
#undef SWAIT
#undef RESC
#undef DMA_TILE
#undef DMA_TILE1
#undef VMW
#undef QKT
#undef MASK
}
}

struct Args { const float* in[31]; float* out; unsigned char* ws; int ph_lo, ph_hi; };
enum { I_X = 0, I_C, I_CTX, I_CCTX, I_MODW, I_MODB, I_NMPRE, I_NMPOST, I_NFPRE, I_NFPOST, I_ABIN, I_ABOUT, I_DLAM, I_DNORM, I_MGB, I_MNORM, I_CDIN, I_CDOUT,
       I_QNORM, I_WUQ, I_KVNORM, I_WUKV, I_SINK, I_RW, I_RB, I_EG, I_EU, I_ED, I_SG, I_SU, I_SD };
struct Frame {
    LAS unsigned char* lds; char* ldsg;
    unsigned char* ws; const float* const* in; float* out;
    int tid, lane, wave, G, bid, gw, NGW;
};
__device__ __forceinline__ int row_batch(int r) { return r >= TPB ? 1 : 0; }
__device__ __forceinline__ const float* src_row(const Frame& F, int r) {
    const int b = row_batch(r), pos = r - b * TPB;
    return pos < CTXL ? F.in[I_CTX] + ((size_t)b * CTXL + pos) * DM : F.in[I_X] + ((size_t)b * SEQ + (pos - CTXL)) * DM;
}
__device__ __forceinline__ int row_variant(int r) { const int b = row_batch(r), pos = r - b * TPB; return pos < CTXL ? 2 : b; }

__device__ __forceinline__ void tr_item(const float* __restrict__ src, size_t ldsrc, bf16_t* __restrict__ dst, size_t ldd, LAS float* scr, int lane) {
    const int kk = lane >> 3, n4 = (lane & 7) * 4;
    f32x4 v[8];
#pragma unroll
    for (int i = 0; i < 8; ++i) v[i] = __builtin_nontemporal_load((const f32x4*)(src + (size_t)(8 * i + kk) * ldsrc + n4));
#pragma unroll
    for (int i = 0; i < 8; ++i) { LAS float* s = scr + (8 * i + kk) * 33 + n4; s[0] = v[i].x; s[1] = v[i].y; s[2] = v[i].z; s[3] = v[i].w; }
    LDS_WAIT(); asm volatile("" ::: "memory");
    const int c = lane & 7;
#pragma unroll
    for (int j = 0; j < 4; ++j) { const int n = (lane >> 3) + 8 * j; const LAS float* s = scr + (8 * c) * 33 + n;
        u32x4 o; o.x = cvt_pk_bf16(s[0 * 33], s[1 * 33]); o.y = cvt_pk_bf16(s[2 * 33], s[3 * 33]); o.z = cvt_pk_bf16(s[4 * 33], s[5 * 33]); o.w = cvt_pk_bf16(s[6 * 33], s[7 * 33]);
        __builtin_nontemporal_store(o, (u32x4*)(dst + (size_t)n * ldd + 8 * c)); }
    LDS_WAIT(); asm volatile("" ::: "memory");
}
__device__ __forceinline__ void tr_item8(const float* __restrict__ src, size_t ldsrc, unsigned char* __restrict__ dst, size_t ldd, float scale, LAS float* scr, int lane) {
    const int kk = lane >> 3, n4 = (lane & 7) * 4;
    f32x4 v[8];
#pragma unroll
    for (int i = 0; i < 8; ++i) v[i] = __builtin_nontemporal_load((const f32x4*)(src + (size_t)(8 * i + kk) * ldsrc + n4));
#pragma unroll
    for (int i = 0; i < 8; ++i) { LAS float* s = scr + (8 * i + kk) * 33 + n4; s[0] = v[i].x; s[1] = v[i].y; s[2] = v[i].z; s[3] = v[i].w; }
    LDS_WAIT(); asm volatile("" ::: "memory");
    const int c = lane & 7;
#pragma unroll
    for (int j = 0; j < 4; ++j) { const int n = (lane >> 3) + 8 * j; const LAS float* s = scr + (8 * c) * 33 + n;
        int w0 = __builtin_amdgcn_cvt_pk_fp8_f32(s[0 * 33] * scale, s[1 * 33] * scale, 0, false); w0 = __builtin_amdgcn_cvt_pk_fp8_f32(s[2 * 33] * scale, s[3 * 33] * scale, w0, true);
        int w1 = __builtin_amdgcn_cvt_pk_fp8_f32(s[4 * 33] * scale, s[5 * 33] * scale, 0, false); w1 = __builtin_amdgcn_cvt_pk_fp8_f32(s[6 * 33] * scale, s[7 * 33] * scale, w1, true);
        __builtin_nontemporal_store((u32x2){(unsigned)w0, (unsigned)w1}, (u32x2*)(dst + (size_t)n * ldd + 8 * c)); }
    LDS_WAIT(); asm volatile("" ::: "memory");
}
struct TrDesc { const float* src; size_t ldsrc; unsigned char* dst; size_t ldd; float scale; int fp8; int valid; };
constexpr int P0_J1 = 8 * 193, P0_J2 = 8 * 64, P0_J3 = 8 * 80, P0_J4 = 8 * 64, P0_J5 = 2 * 48, P0_J6 = 2 * 64, P0_JE = 2 * 64 * 128, P0_JS = 2 * 128;
constexpr int P0_NITEMS = P0_J1 + P0_J2 + P0_J3 + P0_J4 + P0_J5 + P0_J6 + 3 * P0_JE + 3 * P0_JS;
__device__ __forceinline__ TrDesc p0_decode(const Frame& F, int r, int sub) {
    unsigned char* ws = F.ws; TrDesc d; d.scale = 1.f; d.fp8 = 0; d.valid = 1;
    if (r < P0_J1) { const int kb = 4 * (r / 193) + sub, nb = r % 193; d.src = F.in[I_ABIN] + (size_t)kb * 64 * AB_IN + nb * 32; d.ldsrc = AB_IN; d.dst = ws + WS_WABIN + ((size_t)nb * 32 * DM + kb * 64) * 2; d.ldd = DM; return d; } r -= P0_J1;
    if (r < P0_J2) { const int kb = 4 * (r / 64) + sub, nb = r % 64; d.src = F.in[I_ABOUT] + (size_t)kb * 64 * DM + nb * 32; d.ldsrc = DM; d.dst = ws + WS_WABOUT + ((size_t)nb * 32 * DM + kb * 64) * 2; d.ldd = DM; return d; } r -= P0_J2;
    if (r < P0_J3) { const int kb = 4 * (r / 80) + sub, nb = r % 80; d.src = F.in[I_CDIN] + (size_t)kb * 64 * CD_IN + nb * 32; d.ldsrc = CD_IN; d.dst = ws + WS_WCDIN + ((size_t)nb * 32 * DM + kb * 64) * 2; d.ldd = DM; return d; } r -= P0_J3;
    if (r < P0_J4) { const int kb = 4 * (r / 64) + sub, nb = r % 64; d.src = F.in[I_CDOUT] + (size_t)kb * 64 * DM + nb * 32; d.ldsrc = DM; d.dst = ws + WS_WCDOUT + ((size_t)nb * 32 * DM + kb * 64) * 2; d.ldd = DM; return d; } r -= P0_J4;
    if (r < P0_J5) { const int kb = 4 * (r / 48) + sub, nb = r % 48; d.valid = kb < 7; const int kbc = kb < 7 ? kb : 6; d.src = F.in[I_WUQ] + (size_t)kbc * 64 * 1536 + nb * 32; d.ldsrc = 1536; d.dst = ws + WS_WUQ + ((size_t)nb * 32 * 512 + kbc * 64) * 2; d.ldd = 512; return d; } r -= P0_J5;
    if (r < P0_J6) { const int kb = 4 * (r / 64) + sub, nb = r % 64; d.src = F.in[I_WUKV] + (size_t)kb * 64 * 2048 + nb * 32; d.ldsrc = 2048; d.dst = ws + WS_WUKV + ((size_t)nb * 32 * 512 + kb * 64) * 2; d.ldd = 512; return d; } r -= P0_J6;
    d.fp8 = 1;
    if (r < 2 * P0_JE) { const int up = r >= P0_JE; if (up) r -= P0_JE; const int le = r / 128, q = r % 128, kb = 4 * (q / 16) + sub, nb = q % 16, l = le >> 6, e = le & 63; const int n0 = nb * 32;
        d.src = (up ? F.in[I_EU] : F.in[I_EG]) + ((size_t)le * DM + kb * 64) * EFF + n0; d.ldsrc = EFF; d.scale = 64.f;
        d.dst = ws + WS_WGU + ((size_t)(l * 65 + e) * 1024 + (n0 >> 7) * 256 + up * 128 + (n0 & 127)) * DM + kb * 64; d.ldd = DM; return d; } r -= 2 * P0_JE;
    if (r < P0_JE) { const int le = r / 128, q = r % 128, kb = 4 * (q / 64) + sub, nb = q % 64, l = le >> 6, e = le & 63;
        d.src = F.in[I_ED] + ((size_t)le * EFF + kb * 64) * DM + nb * 32; d.ldsrc = DM; d.scale = 32.f; d.dst = ws + WS_WDN + ((size_t)(l * 65 + e) * 2048 + nb * 32) * EFF + kb * 64; d.ldd = EFF; return d; } r -= P0_JE;
    if (r < 2 * P0_JS) { const int up = r >= P0_JS; if (up) r -= P0_JS; const int l = r / 128, q = r % 128, kb = 4 * (q / 16) + sub, nb = q % 16; const int n0 = nb * 32;
        d.src = (up ? F.in[I_SU] : F.in[I_SG]) + ((size_t)l * DM + kb * 64) * EFF + n0; d.ldsrc = EFF; d.scale = 64.f;
        d.dst = ws + WS_WGU + ((size_t)(l * 65 + 64) * 1024 + (n0 >> 7) * 256 + up * 128 + (n0 & 127)) * DM + kb * 64; d.ldd = DM; return d; } r -= 2 * P0_JS;
    {   const int l = r / 128, q = r % 128, kb = 4 * (q / 64) + sub, nb = q % 64;
        d.src = F.in[I_SD] + ((size_t)l * EFF + kb * 64) * DM + nb * 32; d.ldsrc = DM; d.scale = 32.f; d.dst = ws + WS_WDN + ((size_t)(l * 65 + 64) * 2048 + nb * 32) * EFF + kb * 64; d.ldd = EFF; return d; }
}
__device__ __forceinline__ void p0_prologue(Frame& F) {
    unsigned char* ws = F.ws;
    LAS float* sil = (LAS float*)(F.lds + LDS_AUX);
#pragma unroll
    for (int ii = 0; ii < 3 * DM / 512; ++ii) { const int i = F.tid + 512 * ii; const int v = i / DM, k = i % DM; const float c = v < 2 ? F.in[I_C][v * DM + k] : F.in[I_CCTX][k]; sil[i] = c / (1.f + __expf(-c)); }
    __syncthreads();
    if (F.gw < 2 * 16 * 48) {
        const int l = F.gw / 768, r = F.gw % 768, ks = r / 48, cg = r % 48;
        const float* W = F.in[I_MODW] + ((size_t)l * DM + ks * 128) * 12288 + cg * 256 + F.lane * 4;
        f32x4 a0 = {0, 0, 0, 0}, a1 = a0, a2 = a0;
#pragma unroll 8
        for (int k = 0; k < 128; ++k) { const f32x4 w = __builtin_nontemporal_load((const f32x4*)(W + (size_t)k * 12288)); const float s0 = sil[ks * 128 + k], s1 = sil[DM + ks * 128 + k], s2 = sil[2 * DM + ks * 128 + k];
            a0 += w * s0; a1 += w * s1; a2 += w * s2; }
        float* o = (float*)(ws + WS_MODP) + ((size_t)(l * 16 + ks) * 3) * 12288 + cg * 256 + F.lane * 4;
        *(f32x4*)(o) = a0; *(f32x4*)(o + 12288) = a1; *(f32x4*)(o + 2 * 12288) = a2;
    }
    if (F.bid == 0) {
        f32x2* t64 = (f32x2*)(ws + WS_ROPE); f32x2* t128 = (f32x2*)(ws + WS_ROPE + 65536);
        for (int i = F.tid; i < 128 * 16; i += 512) { const int pos = i >> 4, j = i & 15; const float inv = exp2f(-(float)j * (13.287712379549449f / 16.f)); const float a = (float)pos * inv * 0.15915494309189535f; t64[i] = (f32x2){__builtin_amdgcn_cosf(a), __builtin_amdgcn_sinf(a)}; }
        for (int i = F.tid; i < 128 * 32; i += 512) { const int pos = i >> 5, j = i & 31; const float inv = exp2f(-(float)j * (13.287712379549449f / 32.f)); const float a = (float)pos * inv * 0.15915494309189535f; t128[i] = (f32x2){__builtin_amdgcn_cosf(a), __builtin_amdgcn_sinf(a)}; }
    }
    for (int i = F.bid * 512 + F.tid; i < 2 * 256 * 512; i += F.G * 512) {
        const int k8 = i & 511, r = (i >> 9) & 255, l = i >> 17; const int k0 = k8 * 8;
        unsigned o[8];
#pragma unroll
        for (int j = 0; j < 8; ++j) { const int k = k0 + j; float val = 0.f;
            if (r < 128 && (r < 64 || k < 2048)) { const float w = F.in[I_RW][((size_t)l * DM + (k & 2047)) * 64 + (r & 63)]; const float h = bf2f(f2bf(w)); val = r < 64 ? h : (w - h); }
            o[j] = f2bf(val); }
        u32x4 w4 = {o[0] | (o[1] << 16), o[2] | (o[3] << 16), o[4] | (o[5] << 16), o[6] | (o[7] << 16)};
        *(u32x4*)((bf16_t*)(ws + WS_WRT) + ((size_t)(l * 256 + r) * 4096 + k0)) = w4;
    }
    for (int i = F.bid * 512 + F.tid; i < 224 * 256; i += F.G * 512) *(u32x4*)((bf16_t*)(ws + WS_WABIN) + (size_t)AB_IN * DM + (size_t)i * 8) = (u32x4){0, 0, 0, 0};
    for (int i = F.bid * 512 + F.tid; i < 1536 * 8; i += F.G * 512) *(u32x4*)((bf16_t*)(ws + WS_WUQ) + (size_t)(i >> 3) * 512 + 448 + (i & 7) * 8) = (u32x4){0, 0, 0, 0};
    LAS float* scr = (LAS float*)(F.lds + LDS_SCR + F.wave * 16384);
    const int kk = F.lane >> 3, n4 = (F.lane & 7) * 4;
    auto load8 = [&](const TrDesc& d, f32x4 (&v)[8]) {
#pragma unroll
        for (int i = 0; i < 8; ++i) v[i] = __builtin_nontemporal_load((const f32x4*)(d.src + (size_t)(8 * i + kk) * d.ldsrc + n4)); };
    auto finish = [&](const TrDesc& d, f32x4 (&v)[8]) {
#pragma unroll
        for (int i = 0; i < 8; ++i) { LAS float* q = scr + (8 * i + kk) * 33 + n4; q[0] = v[i].x; q[1] = v[i].y; q[2] = v[i].z; q[3] = v[i].w; }
        LDS_WAIT(); asm volatile("" ::: "memory");
        const int c = F.lane & 7;
        if (d.fp8) {
#pragma unroll
            for (int j = 0; j < 4; ++j) { const int n = (F.lane >> 3) + 8 * j; const LAS float* q = scr + (8 * c) * 33 + n; const float sc = d.scale;
                int w0 = __builtin_amdgcn_cvt_pk_fp8_f32(q[0 * 33] * sc, q[1 * 33] * sc, 0, false); w0 = __builtin_amdgcn_cvt_pk_fp8_f32(q[2 * 33] * sc, q[3 * 33] * sc, w0, true);
                int w1 = __builtin_amdgcn_cvt_pk_fp8_f32(q[4 * 33] * sc, q[5 * 33] * sc, 0, false); w1 = __builtin_amdgcn_cvt_pk_fp8_f32(q[6 * 33] * sc, q[7 * 33] * sc, w1, true);
                *(u32x2*)(d.dst + (size_t)n * d.ldd + 8 * c) = (u32x2){(unsigned)w0, (unsigned)w1}; }
        } else {
#pragma unroll
            for (int j = 0; j < 4; ++j) { const int n = (F.lane >> 3) + 8 * j; const LAS float* q = scr + (8 * c) * 33 + n;
                u32x4 o; o.x = cvt_pk_bf16(q[0 * 33], q[1 * 33]); o.y = cvt_pk_bf16(q[2 * 33], q[3 * 33]); o.z = cvt_pk_bf16(q[4 * 33], q[5 * 33]); o.w = cvt_pk_bf16(q[6 * 33], q[7 * 33]);
                *(u32x4*)(d.dst + ((size_t)n * d.ldd + 8 * c) * 2) = o; }
        }
        LDS_WAIT(); asm volatile("" ::: "memory"); };
    LAS unsigned char* scr8 = (LAS unsigned char*)scr;
    auto load8k = [&](const TrDesc& d, f32x4 (&v)[8]) {
#pragma unroll
        for (int i = 0; i < 8; ++i) v[i] = __builtin_nontemporal_load((const f32x4*)(d.src + (size_t)(32 * (i >> 2) + 4 * kk + (i & 3)) * d.ldsrc + n4)); };
    auto stage8 = [&](const TrDesc& d, f32x4 (&v)[8], int sblk) { const float sc = d.scale;
#pragma unroll
        for (int h = 0; h < 2; ++h) {
#pragma unroll
            for (int cmp = 0; cmp < 4; ++cmp) {
                int w = __builtin_amdgcn_cvt_pk_fp8_f32(v[4 * h][cmp] * sc, v[4 * h + 1][cmp] * sc, 0, false); w = __builtin_amdgcn_cvt_pk_fp8_f32(v[4 * h + 2][cmp] * sc, v[4 * h + 3][cmp] * sc, w, true);
                *(LAS int*)(scr8 + (n4 + cmp) * 272 + 64 * sblk + 32 * h + 4 * kk) = w; } } };
    f32x4 va[8], vb[8], vc[8], vd[8];
    for (int it = F.gw; it < P0_NITEMS; it += F.NGW) {
        const TrDesc da = p0_decode(F, it, 0), db = p0_decode(F, it, 1), dc = p0_decode(F, it, 2), dd = p0_decode(F, it, 3);
        if (da.fp8) {
            load8k(da, va); load8k(db, vb); load8k(dc, vc); load8k(dd, vd);
            stage8(da, va, 0); stage8(db, vb, 1); stage8(dc, vc, 2); stage8(dd, vd, 3);
            LDS_WAIT(); asm volatile("" ::: "memory");
#pragma unroll
            for (int i = 0; i < 8; ++i) { const int p = F.lane + 64 * i, row = p >> 4, cb = (p & 15) * 16;
                const u32x4 v = *(const LAS u32x4*)(scr8 + row * 272 + cb);
                __builtin_nontemporal_store(v, (u32x4*)(da.dst + (size_t)row * da.ldd + cb)); }
            LDS_WAIT(); asm volatile("" ::: "memory");
        } else {
            load8(da, va); load8(db, vb); load8(dc, vc); load8(dd, vd);
            finish(da, va); finish(db, vb); finish(dc, vc); if (dd.valid) finish(dd, vd);
        }
    }
}

__device__ __forceinline__ void load_row_f32(const float* p, int lane, f32x4 (&v)[8]) {
#pragma unroll
    for (int j = 0; j < 8; ++j) v[j] = __builtin_nontemporal_load((const f32x4*)(p + 4 * lane + 256 * j));
}
__device__ __forceinline__ void load_row_bf16(const bf16_t* p, int lane, f32x4 (&v)[8]) {
#pragma unroll
    for (int j = 0; j < 8; ++j) { const u32x2 w = __builtin_nontemporal_load((const u32x2*)(p + 4 * lane + 256 * j)); v[j] = (f32x4){bflo(w.x), bfhi(w.x), bflo(w.y), bfhi(w.y)}; }
}
__device__ __forceinline__ void load_row_fp8(const unsigned char* p, int lane, f32x4 (&v)[8]) {
#pragma unroll
    for (int j = 0; j < 8; ++j) { const int w = *(const int*)(p + 4 * lane + 256 * j); const f32x2 lo = __builtin_amdgcn_cvt_pk_f32_fp8(w, false), hi = __builtin_amdgcn_cvt_pk_f32_fp8(w, true); v[j] = (f32x4){lo.x, lo.y, hi.x, hi.y}; }
}
__device__ __forceinline__ float row_rstd(const f32x4 (&v)[8]) {
    float s = 0.f;
#pragma unroll
    for (int j = 0; j < 8; ++j) s += (v[j].x * v[j].x + v[j].y * v[j].y) + (v[j].z * v[j].z + v[j].w * v[j].w);
    return rsqrtf(wave_sum(s) * (1.f / DM) + NORM_EPS);
}
__device__ __forceinline__ void store_row_bf16(bf16_t* p, int lane, const f32x4 (&v)[8]) {
#pragma unroll
    for (int j = 0; j < 8; ++j) { u32x2 w; w.x = cvt_pk_bf16(v[j].x, v[j].y); w.y = cvt_pk_bf16(v[j].z, v[j].w); *(u32x2*)(p + 4 * lane + 256 * j) = w; }
}
__device__ __forceinline__ void store_row_bf16_nt(bf16_t* p, int lane, const f32x4 (&v)[8]) {
#pragma unroll
    for (int j = 0; j < 8; ++j) { u32x2 w; w.x = cvt_pk_bf16(v[j].x, v[j].y); w.y = cvt_pk_bf16(v[j].z, v[j].w); __builtin_nontemporal_store(w, (u32x2*)(p + 4 * lane + 256 * j)); }
}
#define LV4(tab, idx) (*(const LAS f32x4*)((tab) + (idx)))
__device__ __forceinline__ void lds_load_vec(Frame& F, LAS float* dst, const float* src) { for (int i = F.tid; i < DM / 4; i += 512) *(LAS f32x4*)(dst + 4 * i) = *(const f32x4*)(src + 4 * i); }

__device__ __forceinline__ void p1_norm0(Frame& F) {
    unsigned char* ws = F.ws;
    const float* modp = (const float*)(ws + WS_MODP); float* modf = (float*)(ws + WS_MODF);
    LAS float* T = (LAS float*)(F.lds + LDS_SCR);
#pragma unroll 6
    for (int i = F.tid; i < 6 * DM; i += 512) { const int t = i / DM, k = i % DM, ch = t / 3, v = t % 3; const int idx = ch * DM + k;
        float s = F.in[I_MODB][idx];
#pragma unroll
        for (int ks = 0; ks < 16; ++ks) s += modp[((size_t)(0 * 16 + ks) * 3 + v) * 12288 + idx];
        T[i] = s; }
    for (int i = F.tid; i < DM; i += 512) T[6 * DM + i] = F.in[I_NMPRE][i];
    if (F.bid < 36) { const int base = F.bid * 2048;
        for (int i = F.tid; i < 2048; i += 512) { const int g = base + i, l = g / 36864, rem = g % 36864, v = rem / 12288, idx = rem % 12288;
            float s = F.in[I_MODB][l * 12288 + idx];
#pragma unroll
            for (int ks = 0; ks < 16; ++ks) s += modp[((size_t)(l * 16 + ks) * 3 + v) * 12288 + idx];
            modf[g] = s; } }
    __syncthreads();
    bf16_t* HN = (bf16_t*)(ws + WS_HN);
    for (int r = F.gw; r < MROWS; r += F.NGW) {
        f32x4 v[8]; load_row_f32(src_row(F, r), F.lane, v); const float rs = row_rstd(v); const int var = row_variant(r);
#pragma unroll
        for (int j = 0; j < 8; ++j) { const int c = 4 * F.lane + 256 * j; const f32x4 g = LV4(T + 6 * DM, c), sh = LV4(T + var * DM, c), sc = LV4(T + (3 + var) * DM, c);
            v[j] = v[j] * rs * g * (sc + 1.f) + sh; }
        store_row_bf16(HN + (size_t)r * DM, F.lane, v);
    }
}

constexpr float YS_SCALE = 16.f, YS_INV = 1.f / 16.f;
constexpr int STASH_OFF = 2048, STASH_MAX = 21;
struct PolPlain {
    static constexpr bool PERM = true, GATHER = false, FP8 = false, PERM16 = false; static constexpr int scale_w = 0, scale_x = 0;
    const bf16_t* A; const bf16_t* Bt; bf16_t* C; unsigned lda, ldb; size_t ldc; int nt, nM, nN, G, c; bool lat; int pv;
    __device__ __forceinline__ bool next(int i, pg8::Unit& u) const { int pm, pn; if (!pg8::static_order(nM, nN, G, c, i, pm, pn)) return false; u.pm = lat ? pm + 1 + (pm >= 32) : pm; u.pn = pn; u.ex = 0; u.rows = 256; u.idx = 0; return true; }
    __device__ __forceinline__ const char* a_base(const pg8::Unit& u) const { return (const char*)A + (size_t)u.pm * 256 * lda; }
    __device__ __forceinline__ void a_off(const pg8::Unit&, int R0, int R1, int C0, int C1, unsigned (&o)[2][2]) const {
        o[0][0] = (unsigned)R0 * lda + C0 * 2; o[0][1] = (unsigned)R1 * lda + C1 * 2; o[1][0] = (unsigned)(R0 + 128) * lda + C0 * 2; o[1][1] = (unsigned)(R1 + 128) * lda + C1 * 2; }
    __device__ __forceinline__ const char* b_base(const pg8::Unit& u) const { return (const char*)Bt + (size_t)u.pn * 256 * ldb; }
    __device__ __forceinline__ void epi(const f32x4 (&acc)[2][2][4][2], const pg8::Unit& u, int wr, int wc, int fr, int fq) const {
        if (pv != 0) { float sum = 0.f;
#pragma unroll
            for (int ai = 0; ai < 2; ++ai)
#pragma unroll
                for (int m = 0; m < 4; ++m) sum += acc[ai][0][m][0][0] + acc[ai][1][m][1][3];
            if (sum == 12345.678f) C[0] = 0; return; }
        pg8::store_tile_bf16(acc, C + (size_t)u.pm * 256 * ldc + (size_t)u.pn * 256, ldc, wr, wc, fr, fq, 256); }
};
struct PolUqUkv {
    static constexpr bool PERM = true, GATHER = false, FP8 = false, PERM16 = false; static constexpr int scale_w = 0, scale_x = 0;
    const bf16_t *CKVN, *CQN, *Wukv, *Wuq; bf16_t *KV, *QB; unsigned ldb; int nt, G, c;
    __device__ __forceinline__ bool next(int i, pg8::Unit& u) const { const long L = (long)i * G + c; if (L >= 528 + 384) return false;
        if (L < 528) { u.ex = 0; u.pm = (int)L / 8; u.pn = (int)L % 8; } else { const int q = (int)L - 528; u.ex = 1; const int pm = q / 6; u.pm = pm + 1 + (pm >= 32); u.pn = q % 6; } u.rows = 256; u.idx = 0; return true; }
    __device__ __forceinline__ const char* a_base(const pg8::Unit& u) const { return (const char*)(u.ex ? CQN : CKVN) + (size_t)u.pm * 256 * 1024; }
    __device__ __forceinline__ void a_off(const pg8::Unit&, int R0, int R1, int C0, int C1, unsigned (&o)[2][2]) const {
        o[0][0] = (unsigned)R0 * 1024u + C0 * 2; o[0][1] = (unsigned)R1 * 1024u + C1 * 2; o[1][0] = (unsigned)(R0 + 128) * 1024u + C0 * 2; o[1][1] = (unsigned)(R1 + 128) * 1024u + C1 * 2; }
    __device__ __forceinline__ const char* b_base(const pg8::Unit& u) const { return (const char*)(u.ex ? Wuq : Wukv) + (size_t)u.pn * 256 * 1024; }
    __device__ __forceinline__ void epi(const f32x4 (&acc)[2][2][4][2], const pg8::Unit& u, int wr, int wc, int fr, int fq) const {
        const size_t ldc = u.ex ? 1536 : 2048; bf16_t* base = (u.ex ? QB : KV) + (size_t)u.pm * 256 * ldc + (size_t)u.pn * 256;
        pg8::store_tile_bf16(acc, base, ldc, wr, wc, fr, fq, 256); }
};
struct PolCtxSplit {
    static constexpr bool PERM = false, GATHER = false, FP8 = false, PERM16 = false; static constexpr int scale_w = 0, scale_x = 0;
    const bf16_t* A; const bf16_t* Bt; float* C; unsigned lda, ldb; int nt, G, c;
    __device__ __forceinline__ bool next(int i, pg8::Unit& u) const { if (i != 0 || c >= 128) return false; const int un = c >> 3; u.ex = c & 7; u.pn = un & 7; u.idx = un >> 3; u.pm = (un >> 3) * 33; u.rows = 256; return true; }
    __device__ __forceinline__ const char* a_base(const pg8::Unit& u) const { return (const char*)A + (size_t)u.pm * 256 * lda + (size_t)u.ex * 512; }
    __device__ __forceinline__ void a_off(const pg8::Unit&, int R0, int R1, int C0, int C1, unsigned (&o)[2][2]) const {
        o[0][0] = (unsigned)R0 * lda + C0 * 2; o[0][1] = (unsigned)R1 * lda + C1 * 2; o[1][0] = (unsigned)(R0 + 128) * lda + C0 * 2; o[1][1] = (unsigned)(R1 + 128) * lda + C1 * 2; }
    __device__ __forceinline__ const char* b_base(const pg8::Unit& u) const { return (const char*)Bt + (size_t)u.pn * 256 * ldb + (size_t)u.ex * 512; }
    __device__ __forceinline__ void epi(const f32x4 (&acc)[2][2][4][2], const pg8::Unit& u, int wr, int wc, int fr, int fq) const {
        float* base = C + ((size_t)u.ex * 512 + (size_t)u.idx * 256) * DM + (size_t)u.pn * 256;
#pragma unroll
        for (int ai = 0; ai < 2; ++ai)
#pragma unroll
            for (int m = 0; m < 4; ++m) { float* rowp = base + (size_t)(ai * 128 + wr * 64 + m * 16 + fr) * DM + wc * 32 + 4 * fq;
#pragma unroll
                for (int bj = 0; bj < 2; ++bj)
#pragma unroll
                    for (int n = 0; n < 2; ++n) *(f32x4*)(rowp + bj * 128 + n * 16) = acc[ai][bj][m][n]; }
    }
};
struct PolRouter {
    static constexpr bool PERM = false, GATHER = false, FP8 = false, PERM16 = false; static constexpr int scale_w = 0, scale_x = 0;
    const bf16_t* A; const bf16_t* Bt; float* C; unsigned ldb; int nt, nM, G, c; bool lat;
    __device__ __forceinline__ bool next(int i, pg8::Unit& u) const { int pm, pn; if (!pg8::static_order(nM, 4, G, c, i, pm, pn)) return false; u.pm = lat ? pm + 1 + (pm >= 32) : pm; u.pn = 0; u.ex = pn; u.rows = 256; u.idx = 0; return true; }
    __device__ __forceinline__ const char* a_base(const pg8::Unit& u) const { return (const char*)A + (size_t)u.pm * 256 * 8192 + (size_t)u.ex * 1024; }
    __device__ __forceinline__ void a_off(const pg8::Unit&, int R0, int R1, int C0, int C1, unsigned (&o)[2][2]) const {
        o[0][0] = (unsigned)R0 * 8192u + C0 * 2; o[0][1] = (unsigned)R1 * 8192u + C1 * 2; o[1][0] = (unsigned)(R0 + 128) * 8192u + C0 * 2; o[1][1] = (unsigned)(R1 + 128) * 8192u + C1 * 2; }
    __device__ __forceinline__ const char* b_base(const pg8::Unit& u) const { return (const char*)Bt + (size_t)u.ex * 1024; }
    __device__ __forceinline__ void epi(const f32x4 (&acc)[2][2][4][2], const pg8::Unit& u, int wr, int wc, int fr, int fq) const {
        float* base = C + ((size_t)u.ex * MROWS + (size_t)u.pm * 256) * 256;
#pragma unroll
        for (int ai = 0; ai < 2; ++ai)
#pragma unroll
            for (int m = 0; m < 4; ++m) { float* rowp = base + (size_t)(ai * 128 + wr * 64 + m * 16 + fr) * 256 + wc * 32 + 4 * fq;
#pragma unroll
                for (int n = 0; n < 2; ++n) *(f32x4*)(rowp + n * 16) = acc[ai][0][m][n]; }
    }
};
template <int NT_N>
__device__ __forceinline__ bool grouped_next(const LAS int* tab, int G, int c, int i, pg8::Unit& u) {
    const int nb = tab[48]; const long L = (long)i * nb + (c >> 3); const int total = tab[9] * NT_N; if (L >= total) return false;
    const int tile = (int)L / NT_N; u.pn = (int)L % NT_N;
    int it = 0;
#pragma unroll
    for (int k = 1; k < 9; ++k) it += (tab[k] <= tile) ? 1 : 0;
    u.ex = tab[16 + it]; u.pm = tile - tab[it] + tab[32 + it]; const int rem = tab[128 + u.ex] - u.pm * 256; u.rows = rem < 256 ? rem : 256; u.idx = i; return true;
}
__device__ __forceinline__ int slot_token(int slot) { return slot < NSLOT ? slot / TOPK : slot - NSLOT; }
struct PolGU {
    static constexpr bool PERM = true, GATHER = true, FP8 = true, PERM16 = false; static constexpr int scale_w = 0x79797979, scale_x = 0x7c7c7c7c;
    const unsigned char* FN2; const unsigned char* W; unsigned char* H; const LAS int* st; const LAS int* tab; unsigned ldb; int nt, G, c, ibase, pv;
    __device__ __forceinline__ bool next(int i, pg8::Unit& u) const { if (i >= STASH_MAX || !grouped_next<4>(tab, G, c, i + ibase, u)) return false; u.idx = i; return true; }
    __device__ __forceinline__ const char* a_base(const pg8::Unit&) const { return (const char*)FN2; }
    __device__ __forceinline__ void a_off(const pg8::Unit& u, int R0, int R1, int C0, int C1, unsigned (&o)[2][2]) const {
        if (pv == 2) { const unsigned b0 = (unsigned)((u.ex * 200 + u.pm * 256) % 16000); o[0][0] = (b0 + R0) * 2048u + C0 * 2; o[0][1] = (b0 + R1) * 2048u + C1 * 2; o[1][0] = (b0 + R0 + 128) * 2048u + C0 * 2; o[1][1] = (b0 + R1 + 128) * 2048u + C1 * 2; return; }
        const LAS int* lp = st + u.idx * 256; const int s00 = lp[R0], s01 = lp[R1], s10 = lp[R0 + 128], s11 = lp[R1 + 128];
        o[0][0] = (unsigned)slot_token(s00) * 2048u + C0 * 2; o[0][1] = (unsigned)slot_token(s01) * 2048u + C1 * 2; o[1][0] = (unsigned)slot_token(s10) * 2048u + C0 * 2; o[1][1] = (unsigned)slot_token(s11) * 2048u + C1 * 2; }
    __device__ __forceinline__ const char* b_base(const pg8::Unit& u) const { return (const char*)W + ((size_t)(pv == 1 ? 0 : u.ex) * 1024 + (size_t)u.pn * 256) * 2048; }
    __device__ __forceinline__ void epi(const f32x4 (&acc)[2][2][4][2], const pg8::Unit& u, int wr, int wc, int fr, int fq) const {
#pragma unroll
        for (int ai = 0; ai < 2; ++ai) { int slots[4];
#pragma unroll
            for (int m = 0; m < 4; ++m) slots[m] = st[u.idx * 256 + ai * 128 + wr * 64 + m * 16 + fr];
#pragma unroll
            for (int m = 0; m < 4; ++m) { const int r = ai * 128 + wr * 64 + m * 16 + fr; if (r < u.rows) { const int slot = slots[m];
                const f32x4 g0 = acc[ai][0][m][0], g1 = acc[ai][0][m][1], u0 = acc[ai][1][m][0], u1 = acc[ai][1][m][1]; float h[8];
#pragma unroll
                for (int j = 0; j < 4; ++j) { h[j] = g0[j] * u0[j] * __builtin_amdgcn_rcpf(1.f + __expf(-g0[j])); h[4 + j] = g1[j] * u1[j] * __builtin_amdgcn_rcpf(1.f + __expf(-g1[j])); }
#pragma unroll
                for (int j = 0; j < 8; ++j) h[j] = clamp8(h[j] * 4.f);
                int w0 = __builtin_amdgcn_cvt_pk_fp8_f32(h[0], h[1], 0, false); w0 = __builtin_amdgcn_cvt_pk_fp8_f32(h[2], h[3], w0, true);
                int w1 = __builtin_amdgcn_cvt_pk_fp8_f32(h[4], h[5], 0, false); w1 = __builtin_amdgcn_cvt_pk_fp8_f32(h[6], h[7], w1, true);
                *(u32x2*)(H + (size_t)slot * EFF + u.pn * 128 + wc * 32 + 8 * fq) = (u32x2){(unsigned)w0, (unsigned)w1}; } } }
    }
};
struct PolDN {
    static constexpr bool PERM = true, GATHER = true, FP8 = true, PERM16 = true; static constexpr int scale_w = 0x7a7a7a7a, scale_x = 0x7d7d7d7d;
    const unsigned char* H; const unsigned char* W; unsigned char* YS; const LAS int* st; const LAS int* tab; unsigned ldb; int nt, G, c, ibase; int pv;
    __device__ __forceinline__ bool next(int i, pg8::Unit& u) const { if (i >= STASH_MAX || !grouped_next<8>(tab, G, c, i + ibase, u)) return false; u.idx = i; return true; }
    __device__ __forceinline__ const char* a_base(const pg8::Unit&) const { return (const char*)H; }
    __device__ __forceinline__ void a_off(const pg8::Unit& u, int R0, int R1, int C0, int C1, unsigned (&o)[2][2]) const {
        const int r00 = R0, r01 = R1, r10 = R0 + 128, r11 = R1 + 128;
        if (pv == 2) { const unsigned b0 = (unsigned)(u.ex * 256 + u.pm * 256); o[0][0] = (b0 + r00) * 512u + C0 * 2; o[0][1] = (b0 + r01) * 512u + C1 * 2; o[1][0] = (b0 + r10) * 512u + C0 * 2; o[1][1] = (b0 + r11) * 512u + C1 * 2; return; }
        const LAS int* lp = st + u.idx * 256; o[0][0] = (unsigned)lp[r00] * 512u + C0 * 2; o[0][1] = (unsigned)lp[r01] * 512u + C1 * 2; o[1][0] = (unsigned)lp[r10] * 512u + C0 * 2; o[1][1] = (unsigned)lp[r11] * 512u + C1 * 2; }
    __device__ __forceinline__ const char* b_base(const pg8::Unit& u) const { return (const char*)W + ((size_t)u.ex * 2048 + (size_t)u.pn * 256) * 512; }
    __device__ __forceinline__ void epi(const f32x4 (&acc)[2][2][4][2], const pg8::Unit& u, int wr, int wc, int fr, int fq) const {
        if (pv != 0 && pv != 4) { float sum = 0.f;
#pragma unroll
            for (int ai = 0; ai < 2; ++ai)
#pragma unroll
                for (int m = 0; m < 4; ++m) sum += acc[ai][0][m][0][0] + acc[ai][1][m][1][3];
            if (sum == 12345.678f) YS[0] = 0; return; }
#pragma unroll
        for (int ai = 0; ai < 2; ++ai) { int slots[4];
#pragma unroll
            for (int m = 0; m < 4; ++m) slots[m] = st[u.idx * 256 + ai * 128 + wr * 64 + m * 16 + fr];
#pragma unroll
            for (int m = 0; m < 4; ++m) { const int r = ai * 128 + wr * 64 + m * 16 + fr; if (r < u.rows) { const int slot = (pv == 4) ? (122880 + (slots[m] & 1023)) : slots[m];     unsigned char* rowp = (unsigned char*)YS + (size_t)slot * DM + u.pn * 256 + wc * 64 + 16 * fq;
                unsigned w[4];
#pragma unroll
                for (int bj = 0; bj < 2; ++bj) { const f32x4 v0 = acc[ai][bj][m][0] * YS_SCALE, v1 = acc[ai][bj][m][1] * YS_SCALE;
                    int w0 = __builtin_amdgcn_cvt_pk_fp8_f32(clamp8(v0[0]), clamp8(v0[1]), 0, false); w0 = __builtin_amdgcn_cvt_pk_fp8_f32(clamp8(v0[2]), clamp8(v0[3]), w0, true);
                    int w1 = __builtin_amdgcn_cvt_pk_fp8_f32(clamp8(v1[0]), clamp8(v1[1]), 0, false); w1 = __builtin_amdgcn_cvt_pk_fp8_f32(clamp8(v1[2]), clamp8(v1[3]), w1, true);
                    w[2 * bj] = (unsigned)w0; w[2 * bj + 1] = (unsigned)w1; }
                *(u32x4*)rowp = (u32x4){w[0], w[1], w[2], w[3]}; } } }
    }
};
__device__ __forceinline__ void build_group_table(Frame& F, const unsigned* cnt) {
    LAS int* tab = (LAS int*)(F.lds + LDS_AUX);
    const int x = F.bid & 7;
    if (F.tid < 64) {
        const int c = (int)cnt[F.tid]; tab[128 + F.tid] = c; int v = (c + 255) >> 8; const int tiles = v;
        v += __shfl_xor(v, 8); v += __shfl_xor(v, 16); v += __shfl_xor(v, 32);
        if (F.tid < 8) tab[64 + F.tid] = v;
        tab[200 + F.tid] = tiles;
        if (F.tid == 0) tab[128 + 64] = (int)cnt[64];
    }
    __syncthreads();
    if (F.tid == 0) {
        const int S = (tab[128 + 64] + 255) >> 8; int tot = S; for (int y = 0; y < 8; ++y) tot += tab[64 + y];
        const int target = (tot + 7) >> 3; int rem = S, start = 0, mys = 0, mystart = 0;
        for (int y = 0; y < 8; ++y) { int sy = target - tab[64 + y]; sy = sy < 0 ? 0 : sy; sy = sy > rem ? rem : sy; if (y == 7) sy = rem; if (y == x) { mys = sy; mystart = start; } start += sy; rem -= sy; }
        int acc = 0;
        for (int k = 0; k < 8; ++k) { const int e = x + 8 * k; tab[k] = acc; tab[16 + k] = e; tab[32 + k] = 0; acc += tab[200 + e]; }
        tab[8] = acc; tab[16 + 8] = 64; tab[32 + 8] = mystart; acc += mys; tab[9] = acc;
        tab[48] = (F.G - x + 7) >> 3;
    }
    __syncthreads();
}

template <int NT_N> __device__ __forceinline__ int group_units(Frame& F) { const LAS int* tab = (const LAS int*)(F.lds + LDS_AUX); const int nb = tab[48], total = tab[9] * NT_N, rank = F.bid >> 3; return total > rank ? (total - rank + nb - 1) / nb : 0; }
template <int NT_N>
__device__ __forceinline__ void stash_lists(Frame& F, const int* list, int ibase) {
    const LAS int* tab = (const LAS int*)(F.lds + LDS_AUX); LAS int* st = (LAS int*)(F.lds + LDS_AUX + STASH_OFF);
    const int t = F.tid & 255, par = F.tid >> 8;
    __syncthreads();
#pragma unroll 1
    for (int i0 = par; i0 < STASH_MAX; i0 += 8) { int vals[4]; bool ok[4];
#pragma unroll
        for (int q = 0; q < 4; ++q) { const int i = i0 + 2 * q; pg8::Unit u; u.ex = 0; u.pm = 0; u.rows = 1;
            ok[q] = (i < STASH_MAX) && grouped_next<NT_N>(tab, F.G, F.bid, i + ibase, u);
            vals[q] = list[ok[q] ? ((size_t)u.ex * MROWS + u.pm * 256 + (t < u.rows ? t : u.rows - 1)) : (size_t)0]; }
#pragma unroll
        for (int q = 0; q < 4; ++q) { const int i = i0 + 2 * q; if (ok[q]) st[i * 256 + t] = vals[q]; }
        if (!ok[3]) break; }
    __syncthreads();
}

__device__ __forceinline__ f32x16 mma32(f32x16 acc, const LAS unsigned char* A, int pa, const LAS unsigned char* B, int pb, int ksteps, int r32, int hi) {
    const LAS unsigned char* ap = A + r32 * pa + hi * 16; const LAS unsigned char* bp = B + r32 * pb + hi * 16;
    for (int ks = 0; ks < ksteps; ++ks) { const bf16x8 a = *(const LAS bf16x8*)(ap + ks * 32), b = *(const LAS bf16x8*)(bp + ks * 32);
        acc = __builtin_amdgcn_mfma_f32_32x32x16_bf16(a, b, acc, 0, 0, 0); }
    return acc;
}
constexpr int ML_VT = 0, ML_QS = 34816, ML_KS = 53248, ML_PM = 71680, ML_QD = 106496, ML_HS = 53248;
constexpr int P64 = 144, P128 = 272;
constexpr int AX_IF = 0, AX_LF = 128, AX_IB = 256, AX_LB = 384, AX_WF = 512, AX_WB = 640, AX_AF = 768, AX_MF = 896, AX_WIF = 1024, AX_EMF = 1152, AX_AB = 1280, AX_MB = 1408, AX_WIB = 1536, AX_EMB = 1664,
              AX_DEN = 1792, AX_NST = 1920  , AX_SC = 2048  ;

__device__ __forceinline__ void ml_load_gates(Frame& F, const bf16_t* Prow0, int h, LAS float* ax) {
    const int t = F.tid & 127, ty = F.tid >> 7;
    const float v = bf2f(Prow0[(size_t)t * AB_INP + C_GT + ty * 8 + h]) + F.in[I_MGB][ty * 8 + h];
    ax[ty * 128 + t] = (ty & 1) ? logsigmoidf_(v) : v;
}
__device__ __forceinline__ void ml_load_vt(Frame& F, const bf16_t* Prow0, int h) {
    const int t = F.tid >> 2, vq = F.tid & 3; const bf16_t* src = Prow0 + (size_t)t * AB_INP + C_MV + h * 128 + vq * 32;
    LAS bf16_t* VT = (LAS bf16_t*)(F.lds + ML_VT);
    bf16x8 x[4];
#pragma unroll
    for (int i = 0; i < 4; ++i) x[i] = *(const bf16x8*)(src + i * 8);
    __builtin_amdgcn_sched_barrier(0);
#pragma unroll
    for (int i = 0; i < 4; ++i) {
#pragma unroll
        for (int j = 0; j < 8; ++j) VT[(vq * 32 + i * 8 + j) * (P128 / 2) + t] = (bf16_t)x[i][j]; }
}
__device__ __forceinline__ float scan_psum(float v, int lane) {
#pragma unroll
    for (int d = 1; d < 64; d <<= 1) { const float t = __shfl_up(v, d); if (lane >= d) v += t; } return v; }
__device__ __forceinline__ float scan_ssum(float v, int lane) {
#pragma unroll
    for (int d = 1; d < 64; d <<= 1) { const float t = __shfl_down(v, d); if (lane + d < 64) v += t; } return v; }
__device__ __forceinline__ float scan_pmax(float v, int lane) {
#pragma unroll
    for (int d = 1; d < 64; d <<= 1) { const float t = __shfl_up(v, d); if (lane >= d) v = fmaxf(v, t); } return v; }
__device__ __forceinline__ float scan_smax(float v, int lane) {
#pragma unroll
    for (int d = 1; d < 64; d <<= 1) { const float t = __shfl_down(v, d); if (lane + d < 64) v = fmaxf(v, t); } return v; }
__device__ __forceinline__ void mlstm_a_item(Frame& F, int b, int h, int g) {
    unsigned char* ws = F.ws; const bf16_t* Prow0 = (const bf16_t*)(ws + WS_P) + (size_t)(b * TPB + g * 128) * AB_INP;
    LAS float* ax = (LAS float*)(F.lds + LDS_AUX);
    const int r32 = F.lane & 31, hi = F.lane >> 5;
    ml_load_gates(F, Prow0, h, ax);
    ml_load_vt(F, Prow0, h);
    __syncthreads();
    if (F.wave == 0) {
        const int l = F.lane; const float x0 = ax[AX_LF + 2 * l], x1 = ax[AX_LF + 2 * l + 1], i0 = ax[AX_IF + 2 * l], i1 = ax[AX_IF + 2 * l + 1];
        const float inc = scan_ssum(x0 + x1, l), exc = inc - (x0 + x1); const float w1 = exc + i1, w0 = exc + x1 + i0;
        const float mx = wave_max(fmaxf(w0, w1)); ax[AX_WF + 2 * l] = __expf(w0 - mx); ax[AX_WF + 2 * l + 1] = __expf(w1 - mx);
        if (l == 0) { ax[AX_SC + 0] = inc; ax[AX_SC + 1] = mx; } }
    if (F.wave == 1) {
        const int l = F.lane; const float x0 = ax[AX_LB + 2 * l], x1 = ax[AX_LB + 2 * l + 1], i0 = ax[AX_IB + 2 * l], i1 = ax[AX_IB + 2 * l + 1];
        const float inc = scan_psum(x0 + x1, l), exc = inc - (x0 + x1); const float w0 = exc + i0, w1 = exc + x0 + i1;
        const float mx = wave_max(fmaxf(w0, w1)); ax[AX_WB + 2 * l] = __expf(w0 - mx); ax[AX_WB + 2 * l + 1] = __expf(w1 - mx);
        if (l == 63) ax[AX_SC + 2] = inc; if (l == 0) ax[AX_SC + 3] = mx; }
    __syncthreads();
    {
        const int t = F.tid >> 2, dq = F.tid & 3; const bf16_t* src = Prow0 + (size_t)t * AB_INP + C_MK + h * 64 + dq * 16;
        LAS bf16_t* KTf = (LAS bf16_t*)(F.lds + ML_QS); LAS bf16_t* KTb = (LAS bf16_t*)(F.lds + ML_KS);
        const float wf = ax[AX_WF + t] * 0.125f, wb = ax[AX_WB + t] * 0.125f;
        bf16x8 x[2];
#pragma unroll
        for (int i = 0; i < 2; ++i) x[i] = *(const bf16x8*)(src + i * 8);
        __builtin_amdgcn_sched_barrier(0);
#pragma unroll
        for (int i = 0; i < 2; ++i) {
#pragma unroll
            for (int j = 0; j < 8; ++j) { const float k = bf2f((unsigned short)x[i][j]); const int d = dq * 16 + i * 8 + j;
                KTf[d * (P128 / 2) + t] = (bf16_t)f2bf(k * wf); KTb[d * (P128 / 2) + t] = (bf16_t)f2bf(k * wb); } }
    }
    __syncthreads();
    const int vb = F.wave >> 1, db = F.wave & 1;
    f32x16 cf = {}, cb = {};
    cf = mma32(cf, F.lds + ML_VT + vb * 32 * P128, P128, F.lds + ML_QS + db * 32 * P128, P128, 8, r32, hi);
    cb = mma32(cb, F.lds + ML_VT + vb * 32 * P128, P128, F.lds + ML_KS + db * 32 * P128, P128, 8, r32, hi);
    const int chf = (b * 8 + h) * 2, chb = chf + 1;
    float* dCf = (float*)(ws + WS_MDC) + ((size_t)chf * 66 + g) * 8192; float* dCb = (float*)(ws + WS_MDC) + ((size_t)chb * 66 + g) * 8192;
#pragma unroll
    for (int r = 0; r < 16; ++r) { const int v = vb * 32 + att::crow(r, hi), d = db * 32 + r32; dCf[v * 64 + d] = cf[r]; dCb[v * 64 + d] = cb[r]; }
    if (F.tid < 128) { const int dir = F.tid >> 6, d = F.tid & 63; const LAS bf16_t* kt = (const LAS bf16_t*)(F.lds + (dir ? ML_KS : ML_QS)) + d * (P128 / 2);
        float s = 0.f; for (int t = 0; t < 128; ++t) s += bf2f(kt[t]);
        ((float*)(ws + WS_MSM + MSM_DN))[((size_t)(chf + dir) * 66 + g) * 64 + d] = s; }
    if (F.tid < 2) { ((float*)(ws + WS_MSM + MSM_BTOT))[(chf + F.tid) * 66 + g] = ax[AX_SC + 2 * F.tid]; ((float*)(ws + WS_MSM + MSM_MLOC))[(chf + F.tid) * 66 + g] = ax[AX_SC + 2 * F.tid + 1]; }
    __syncthreads();
}
__device__ __forceinline__ int chain_chunk(int dir, int j) { return dir == 0 ? j : (j == 0 ? 1 : (j == 1 ? 0 : 67 - j)); }
__device__ __forceinline__ void mlstm_scan_item(Frame& F, int chain, int slice) {
    unsigned char* ws = F.ws; const int dir = chain & 1;
    const float* dC = (const float*)(ws + WS_MDC) + (size_t)chain * 66 * 8192 + slice * 1024 + F.tid * 2;
    bf16_t* cst = (bf16_t*)(ws + WS_MCST) + (size_t)chain * 66 * 8192 + slice * 1024 + F.tid * 2;
    const float* btot = (const float*)(ws + WS_MSM + MSM_BTOT) + chain * 66; const float* mloc = (const float*)(ws + WS_MSM + MSM_MLOC) + chain * 66;
    const float* dn = (const float*)(ws + WS_MSM + MSM_DN) + (size_t)chain * 66 * 64; float* nst = (float*)(ws + WS_MSM + MSM_NST) + (size_t)chain * 66 * 64; float* mst = (float*)(ws + WS_MSM + MSM_MST) + chain * 66;
    float c0 = 0.f, c1 = 0.f, n = 0.f, m = 0.f; const bool don = (slice == 0 && F.tid < 64);
    f32x2 dv[66];
#pragma unroll
    for (int j = 0; j < 66; ++j) dv[j] = __builtin_nontemporal_load((const f32x2*)(dC + (size_t)j * 8192));
    LAS float* sb = (LAS float*)(F.lds + LDS_SCR);
    {   const int tc = F.tid < 66 ? F.tid : 65; const float b_ = btot[tc], m_ = mloc[tc]; float dnv[9];
#pragma unroll
        for (int k = 0; k < 9; ++k) { const int i = F.tid + 512 * k; dnv[k] = dn[i < 66 * 64 ? i : 66 * 64 - 1]; }
        if (F.tid < 66) { sb[F.tid] = b_; sb[128 + F.tid] = m_; }
#pragma unroll
        for (int k = 0; k < 9; ++k) { const int i = F.tid + 512 * k; if (i < 66 * 64) sb[256 + i] = dnv[k]; } }
    __syncthreads();
#pragma unroll
    for (int j = 0; j < 66; ++j) { const int g = chain_chunk(dir, j);
        const f32x2 d = dir == 0 ? dv[j] : dv[j == 0 ? 1 : (j == 1 ? 0 : 67 - j)]; const float bt = sb[g], ml = sb[128 + g];
        *(unsigned*)(cst + (size_t)g * 8192) = cvt_pk_bf16(c0, c1);
        if (don) { nst[g * 64 + F.tid] = n; if (F.tid == 0) mst[g] = m; }
        const float mn = fmaxf(bt + m, ml), dec = __expf(bt + m - mn), sc = __expf(ml - mn);
        c0 = dec * c0 + sc * d.x; c1 = dec * c1 + sc * d.y;
        if (don) n = dec * n + sc * sb[256 + g * 64 + F.tid];
        m = mn; }
    __syncthreads();
}
__device__ __forceinline__ void mlstm_c_item(Frame& F, int b, int h, int g) {
    unsigned char* ws = F.ws; const int row0 = b * TPB + g * 128; const bf16_t* Prow0 = (const bf16_t*)(ws + WS_P) + (size_t)row0 * AB_INP;
    LAS float* ax = (LAS float*)(F.lds + LDS_AUX);
    const int r32 = F.lane & 31, hi = F.lane >> 5; const int chf = (b * 8 + h) * 2;
    ml_load_gates(F, Prow0, h, ax);
    ml_load_vt(F, Prow0, h);
    {
        const int t = F.tid >> 2, dq = F.tid & 3;
        const bf16_t* qs = Prow0 + (size_t)t * AB_INP + C_MQ + h * 64 + dq * 16; const bf16_t* ks = Prow0 + (size_t)t * AB_INP + C_MK + h * 64 + dq * 16;
        bf16x8 qv[2], kv[2];
#pragma unroll
        for (int i = 0; i < 2; ++i) { qv[i] = *(const bf16x8*)(qs + i * 8); kv[i] = *(const bf16x8*)(ks + i * 8); }
        __builtin_amdgcn_sched_barrier(0);
#pragma unroll
        for (int i = 0; i < 2; ++i) { *(LAS bf16x8*)(F.lds + ML_QS + t * P64 + (dq * 16 + i * 8) * 2) = qv[i];
            const bf16x8 x = kv[i]; u32x4 o;
#pragma unroll
            for (int j = 0; j < 4; ++j) o[j] = cvt_pk_bf16(bf2f((unsigned short)x[2 * j]) * 0.125f, bf2f((unsigned short)x[2 * j + 1]) * 0.125f);
            *(LAS u32x4*)(F.lds + ML_KS + t * P64 + (dq * 16 + i * 8) * 2) = o; }
    }
    if (F.tid < 128) ax[AX_NST + F.tid] = ((const float*)(ws + WS_MSM + MSM_NST))[((size_t)(chf + (F.tid >> 6)) * 66 + g) * 64 + (F.tid & 63)];
    __syncthreads();
    if (F.wave == 0) {
        const int l = F.lane; const float mst = ((const float*)(ws + WS_MSM + MSM_MST))[chf * 66 + g];
        const float x0 = ax[AX_LF + 2 * l], x1 = ax[AX_LF + 2 * l + 1], i0 = ax[AX_IF + 2 * l], i1 = ax[AX_IF + 2 * l + 1];
        const float exc = scan_psum(x0 + x1, l) - (x0 + x1); const float c0 = exc + x0, c1 = c0 + x1, a0 = i0 - c0, a1 = i1 - c1;
        const float pin = scan_pmax(fmaxf(a0, a1), l); float pex = __shfl_up(pin, 1); if (l == 0) pex = -1e30f;
        const float M0 = fmaxf(mst, fmaxf(pex, a0)), M1 = fmaxf(mst, fmaxf(pex, fmaxf(a0, a1)));
        ax[AX_AF + 2 * l] = a0; ax[AX_AF + 2 * l + 1] = a1; ax[AX_MF + 2 * l] = M0; ax[AX_MF + 2 * l + 1] = M1;
        ax[AX_WIF + 2 * l] = __expf(mst - M0); ax[AX_WIF + 2 * l + 1] = __expf(mst - M1); ax[AX_EMF + 2 * l] = __expf(-(c0 + M0)); ax[AX_EMF + 2 * l + 1] = __expf(-(c1 + M1)); }
    if (F.wave == 1) {
        const int l = F.lane; const float mst = ((const float*)(ws + WS_MSM + MSM_MST))[(chf + 1) * 66 + g];
        const float x0 = ax[AX_LB + 2 * l], x1 = ax[AX_LB + 2 * l + 1], i0 = ax[AX_IB + 2 * l], i1 = ax[AX_IB + 2 * l + 1];
        const float exc = scan_ssum(x0 + x1, l) - (x0 + x1); const float c1 = exc + x1, c0 = c1 + x0, a0 = i0 - c0, a1 = i1 - c1;
        const float sin_ = scan_smax(fmaxf(a0, a1), l); float sex = __shfl_down(sin_, 1); if (l == 63) sex = -1e30f;
        const float M1 = fmaxf(mst, fmaxf(sex, a1)), M0 = fmaxf(mst, fmaxf(sex, fmaxf(a0, a1)));
        ax[AX_AB + 2 * l] = a0; ax[AX_AB + 2 * l + 1] = a1; ax[AX_MB + 2 * l] = M0; ax[AX_MB + 2 * l + 1] = M1;
        ax[AX_WIB + 2 * l] = __expf(mst - M0); ax[AX_WIB + 2 * l + 1] = __expf(mst - M1); ax[AX_EMB + 2 * l] = __expf(-(c0 + M0)); ax[AX_EMB + 2 * l + 1] = __expf(-(c1 + M1)); }
    const int qb = F.wave >> 1, sb0 = (F.wave & 1) * 2;
    f32x16 S0 = {}, S1 = {};
    S0 = mma32(S0, F.lds + ML_KS + (sb0 * 32) * P64, P64, F.lds + ML_QS + qb * 32 * P64, P64, 4, r32, hi);
    S1 = mma32(S1, F.lds + ML_KS + (sb0 * 32 + 32) * P64, P64, F.lds + ML_QS + qb * 32 * P64, P64, 4, r32, hi);
    __syncthreads();
    f32x16 H0 = {}, H1 = {};
    const int qb2 = F.wave >> 1, vb0 = (F.wave & 1) * 2;
#pragma unroll 1
    for (int dir = 0; dir < 2; ++dir) {
        const LAS float* A_ = ax + (dir ? AX_AB : AX_AF); const LAS float* M_ = ax + (dir ? AX_MB : AX_MF); const LAS float* WI_ = ax + (dir ? AX_WIB : AX_WIF); const LAS float* EM_ = ax + (dir ? AX_EMB : AX_EMF);
        {
            const int q = qb * 32 + r32; const float Mq = M_[q];
#pragma unroll
            for (int i = 0; i < 2; ++i) { const f32x16& S = i ? S1 : S0; const int sbase = (sb0 + i) * 32;
#pragma unroll
                for (int gq = 0; gq < 4; ++gq) { float p[4];
#pragma unroll
                    for (int j = 0; j < 4; ++j) { const int s = sbase + 8 * gq + 4 * hi + j; const bool keep = dir ? (s >= q) : (s <= q); p[j] = keep ? S[gq * 4 + j] * __expf(A_[s] - Mq) : 0.f; }
                    u32x2 w; w.x = cvt_pk_bf16(p[0], p[1]); w.y = cvt_pk_bf16(p[2], p[3]);
                    *(LAS u32x2*)(F.lds + ML_PM + q * P128 + (sbase + 8 * gq + 4 * hi) * 2) = w; } }
        }
        {
            const int t = F.tid >> 2, dq = F.tid & 3; const float wi = WI_[t];
            const bf16_t* cs = (const bf16_t*)(ws + WS_MCST) + ((size_t)(chf + dir) * 66 + g) * 8192 + t * 64 + dq * 16;
            bf16x8 cv[2];
#pragma unroll
            for (int i = 0; i < 2; ++i) cv[i] = *(const bf16x8*)(cs + i * 8);
            __builtin_amdgcn_sched_barrier(0);
#pragma unroll
            for (int i = 0; i < 2; ++i) { const bf16x8 x = *(const LAS bf16x8*)(F.lds + ML_QS + t * P64 + (dq * 16 + i * 8) * 2); u32x4 o;
#pragma unroll
                for (int j = 0; j < 4; ++j) o[j] = cvt_pk_bf16(bf2f((unsigned short)x[2 * j]) * wi, bf2f((unsigned short)x[2 * j + 1]) * wi);
                *(LAS u32x4*)(F.lds + ML_QD + t * P64 + (dq * 16 + i * 8) * 2) = o;
                *(LAS bf16x8*)(F.lds + ML_KS + t * P64 + (dq * 16 + i * 8) * 2) = cv[i]; }
        }
        __syncthreads();
        {
            const int q = F.tid >> 2, part = F.tid & 3; float s = 0.f;
            const LAS bf16_t* pr = (const LAS bf16_t*)(F.lds + ML_PM + q * P128) + part * 32;
#pragma unroll
            for (int j = 0; j < 32; ++j) s += bf2f(pr[j]);
            const LAS bf16_t* qd = (const LAS bf16_t*)(F.lds + ML_QD + q * P64) + part * 16; const LAS float* nn = ax + AX_NST + dir * 64 + part * 16;
#pragma unroll
            for (int j = 0; j < 16; ++j) s += bf2f(qd[j]) * nn[j];
            s += __shfl_xor(s, 1); s += __shfl_xor(s, 2);
            if (part == 0) ax[AX_DEN + q] = fmaxf(fabsf(s), EM_[q]);
        }
        f32x16 N0 = {}, N1 = {};
        N0 = mma32(N0, F.lds + ML_PM + qb2 * 32 * P128, P128, F.lds + ML_VT + (vb0 * 32) * P128, P128, 8, r32, hi);
        N0 = mma32(N0, F.lds + ML_QD + qb2 * 32 * P64, P64, F.lds + ML_KS + (vb0 * 32) * P64, P64, 4, r32, hi);
        N1 = mma32(N1, F.lds + ML_PM + qb2 * 32 * P128, P128, F.lds + ML_VT + (vb0 * 32 + 32) * P128, P128, 8, r32, hi);
        N1 = mma32(N1, F.lds + ML_QD + qb2 * 32 * P64, P64, F.lds + ML_KS + (vb0 * 32 + 32) * P64, P64, 4, r32, hi);
        __syncthreads();
#pragma unroll
        for (int r = 0; r < 16; ++r) { const float inv = 1.f / ax[AX_DEN + qb2 * 32 + att::crow(r, hi)]; H0[r] += N0[r] * inv; H1[r] += N1[r] * inv; }
        __syncthreads();
    }
    {   LAS float* HS = (LAS float*)(F.lds + ML_HS);
#pragma unroll
        for (int r = 0; r < 16; ++r) { const int q = qb2 * 32 + att::crow(r, hi); HS[q * 128 + vb0 * 32 + r32] = H0[r]; HS[q * 128 + vb0 * 32 + 32 + r32] = H1[r]; } }
    __syncthreads();
    {   const LAS float* HS = (const LAS float*)(F.lds + ML_HS); bf16_t* CC = (bf16_t*)(ws + WS_CC);
        const float g0 = F.in[I_MNORM][2 * F.lane], g1 = F.in[I_MNORM][2 * F.lane + 1];
        for (int i = 0; i < 16; ++i) { const int q = F.wave * 16 + i; const float x0 = HS[q * 128 + 2 * F.lane], x1 = HS[q * 128 + 2 * F.lane + 1];
            const float rs = rsqrtf(wave_sum(x0 * x0 + x1 * x1) * (1.f / 128.f) + NORM_EPS);
            const unsigned mo = *(const unsigned*)(Prow0 + (size_t)q * AB_INP + C_MO + h * 128 + 2 * F.lane);
            *(unsigned*)(CC + (size_t)(row0 + q) * DM + 1024 + h * 128 + 2 * F.lane) = cvt_pk_bf16(x0 * rs * g0 * sigmoidf_(bflo(mo)), x1 * rs * g1 * sigmoidf_(bfhi(mo))); }
    }
    __syncthreads();
}
__device__ __forceinline__ void diff_combine_row(Frame& F, int r, float lam, float oml, const float (&dnw)[16]) {
    const bf16_t* AO = (const bf16_t*)(F.ws + WS_AO) + (size_t)r * DM; bf16_t* CC = (bf16_t*)(F.ws + WS_CC) + (size_t)r * DM;
    const int h = F.lane >> 3, v0 = (F.lane & 7) * 16; float a[16]; float ss = 0.f;
#pragma unroll
    for (int i = 0; i < 2; ++i) { const u32x4 x1 = *(const u32x4*)(AO + (2 * h) * 128 + v0 + i * 8), x2 = *(const u32x4*)(AO + (2 * h + 1) * 128 + v0 + i * 8);
#pragma unroll
        for (int j = 0; j < 4; ++j) { a[i * 8 + 2 * j] = bflo(x1[j]) - lam * bflo(x2[j]); a[i * 8 + 2 * j + 1] = bfhi(x1[j]) - lam * bfhi(x2[j]); } }
#pragma unroll
    for (int j = 0; j < 16; ++j) ss += a[j] * a[j];
    ss += __shfl_xor(ss, 1); ss += __shfl_xor(ss, 2); ss += __shfl_xor(ss, 4);
    const float rs = rsqrtf(ss * (1.f / 128.f) + NORM_EPS) * oml;
#pragma unroll
    for (int i = 0; i < 2; ++i) { u32x4 o;
#pragma unroll
        for (int j = 0; j < 4; ++j) o[j] = cvt_pk_bf16(a[i * 8 + 2 * j] * rs * dnw[i * 8 + 2 * j], a[i * 8 + 2 * j + 1] * rs * dnw[i * 8 + 2 * j + 1]);
        *(u32x4*)(CC + h * 128 + v0 + i * 8) = o; }
}

template <int Q> __device__ __forceinline__ u32x4 rope_w4(u32x4 w, const f32x2* __restrict__ tab, int prow, int pcol, int i0) {
    u32x4 o;
#pragma unroll
    for (int q = 0; q < 4; ++q) { const int i = i0 + q; const f32x2 cs = (i < Q) ? tab[prow * Q + i] : tab[pcol * Q + (i - Q)];
        const float x1 = bflo(w[q]), x2 = bfhi(w[q]); o[q] = cvt_pk_bf16(x1 * cs.x - x2 * cs.y, x1 * cs.y + x2 * cs.x); }
    return o;
}
__device__ __forceinline__ void rope_dk_row(Frame& F, int r) {
    const int b = row_batch(r), pos = r - b * TPB; if (pos < CTXL) return; const int tok = pos - CTXL, prow = tok >> 6, pcol = tok & 63;
    bf16_t* p = (bf16_t*)(F.ws + WS_P) + (size_t)r * AB_INP + C_DK; const f32x2* tab = (const f32x2*)(F.ws + WS_ROPE);
    u32x4 w[2]; f32x2 cs[2][4];
#pragma unroll
    for (int j = 0; j < 2; ++j) { const int e = (F.lane + 64 * j) * 8, i0 = (e & 63) >> 1; w[j] = *(const u32x4*)(p + e);
#pragma unroll
        for (int q = 0; q < 4; ++q) { const int i = i0 + q; cs[j][q] = (i < 16) ? tab[prow * 16 + i] : tab[pcol * 16 + (i - 16)]; } }
    __builtin_amdgcn_sched_barrier(0);
#pragma unroll
    for (int j = 0; j < 2; ++j) { const int e = (F.lane + 64 * j) * 8; u32x4 o;
#pragma unroll
        for (int q = 0; q < 4; ++q) { const float x1 = bflo(w[j][q]), x2 = bfhi(w[j][q]); o[q] = cvt_pk_bf16(x1 * cs[j][q].x - x2 * cs[j][q].y, x1 * cs[j][q].y + x2 * cs[j][q].x); }
        *(u32x4*)(p + e) = o; }
}
__device__ __forceinline__ void post1_row(Frame& F, int r, const float (&qn)[8], const float (&kvn)[8]) {
    unsigned char* ws = F.ws; const bf16_t* p = (const bf16_t*)(ws + WS_P) + (size_t)r * CD_IN;
    const int b = row_batch(r), pos = r - b * TPB; const bool lat = pos >= CTXL; const int tok = pos - CTXL, prow = tok >> 6, pcol = tok & 63;
    const u32x4 wq_ = *(const u32x4*)(p + C_CQ + (F.lane < 56 ? F.lane : 55) * 8), wkv_ = *(const u32x4*)(p + C_CKV + F.lane * 8), wkr_ = *(const u32x4*)(p + C_KR + (F.lane & 7) * 8), wsk_ = *(const u32x4*)(p + C_SK + (F.lane & 31) * 8);
    __builtin_amdgcn_sched_barrier(0);
    {   float x[8]; float ss = 0.f; const bool act = F.lane < 56;
        if (act) { const u32x4 w = wq_;
#pragma unroll
            for (int j = 0; j < 4; ++j) { x[2 * j] = bflo(w[j]); x[2 * j + 1] = bfhi(w[j]); ss += x[2 * j] * x[2 * j] + x[2 * j + 1] * x[2 * j + 1]; } }
        const float rs = rsqrtf(wave_sum(ss) * (1.f / 448.f) + NORM_EPS); u32x4 o = {0, 0, 0, 0};
        if (act) {
#pragma unroll
            for (int j = 0; j < 4; ++j) o[j] = cvt_pk_bf16(x[2 * j] * rs * qn[2 * j], x[2 * j + 1] * rs * qn[2 * j + 1]); }
        *(u32x4*)((bf16_t*)(ws + WS_CQN) + (size_t)r * 512 + F.lane * 8) = o;
    }
    {   float x[8]; float ss = 0.f; const u32x4 w = wkv_;
#pragma unroll
        for (int j = 0; j < 4; ++j) { x[2 * j] = bflo(w[j]); x[2 * j + 1] = bfhi(w[j]); ss += x[2 * j] * x[2 * j] + x[2 * j + 1] * x[2 * j + 1]; }
        const float rs = rsqrtf(wave_sum(ss) * (1.f / 512.f) + NORM_EPS); u32x4 o;
#pragma unroll
        for (int j = 0; j < 4; ++j) o[j] = cvt_pk_bf16(x[2 * j] * rs * kvn[2 * j], x[2 * j + 1] * rs * kvn[2 * j + 1]);
        *(u32x4*)((bf16_t*)(ws + WS_CKVN) + (size_t)r * 512 + F.lane * 8) = o;
    }
    if (F.lane < 8) { u32x4 w = wkr_; if (lat) w = rope_w4<16>(w, (const f32x2*)(ws + WS_ROPE), prow, pcol, F.lane * 4);
        *(u32x4*)((bf16_t*)(ws + WS_KR) + (size_t)r * 64 + F.lane * 8) = w; }
    if (lat && F.lane >= 32) { const int l2 = F.lane - 32; bf16_t* sk = (bf16_t*)(ws + WS_P) + (size_t)r * CD_IN + C_SK + l2 * 8;
        u32x4 w = wsk_; w = rope_w4<32>(w, (const f32x2*)(ws + WS_ROPE + 65536), prow, pcol, ((l2 * 8) & 127) >> 1); *(u32x4*)sk = w; }
}
constexpr int TB = DM;
__device__ __forceinline__ const float* modf_vec(const Frame& F, int l, int v, int ch) { return (const float*)(F.ws + WS_MODF) + ((size_t)l * 3 + v) * 12288 + ch * DM; }
__device__ __forceinline__ void row_phase(Frame& F, int l) {
    LAS float* T = (LAS float*)(F.lds + LDS_SCR);
    {
        f32x4 tv[11]; const int o4 = 4 * F.tid;
        tv[0] = *(const f32x4*)(F.in[I_NMPOST] + l * DM + o4); tv[1] = *(const f32x4*)(F.in[I_NFPRE] + l * DM + o4);
#pragma unroll
        for (int v = 0; v < 3; ++v) { tv[2 + v] = *(const f32x4*)(modf_vec(F, l, v, 2) + o4); tv[5 + v] = *(const f32x4*)(modf_vec(F, l, v, 3) + o4); tv[8 + v] = *(const f32x4*)(modf_vec(F, l, v, 4) + o4); }
        __builtin_amdgcn_sched_barrier(0);
#pragma unroll
        for (int k = 0; k < 11; ++k) *(LAS f32x4*)(T + k * TB + o4) = tv[k]; }
    __syncthreads();
    const bf16_t* Y2 = (const bf16_t*)(F.ws + WS_Y2); bf16_t* XR = (bf16_t*)(F.ws + WS_XR); bf16_t* FN2 = (bf16_t*)(F.ws + WS_FN2);
    auto finish_row = [&](int r, int var, f32x4 (&y)[8]) {
        f32x4 x[8]; if (l == 0) load_row_f32(src_row(F, r), F.lane, x); else load_row_bf16(XR + (size_t)r * DM, F.lane, x);
        const float rs = row_rstd(y);
#pragma unroll
        for (int j = 0; j < 8; ++j) { const int c = 4 * F.lane + 256 * j; x[j] = x[j] + LV4(T + (2 + var) * TB, c) * (y[j] * rs * LV4(T, c)); }
        store_row_bf16_nt(XR + (size_t)r * DM, F.lane, x);
        const float rs2 = row_rstd(x);
#pragma unroll
        for (int j = 0; j < 8; ++j) { const int c = 4 * F.lane + 256 * j; const f32x4 f = x[j] * rs2 * LV4(T + TB, c) * (LV4(T + (8 + var) * TB, c) + 1.f) + LV4(T + (5 + var) * TB, c);
            u32x2 hw; hw.x = cvt_pk_bf16(f.x, f.y); hw.y = cvt_pk_bf16(f.z, f.w);
            *(u32x2*)(FN2 + (size_t)r * 4096 + c) = hw;
            int q = __builtin_amdgcn_cvt_pk_fp8_f32(clamp8(f.x * 8.f), clamp8(f.y * 8.f), 0, false); q = __builtin_amdgcn_cvt_pk_fp8_f32(clamp8(f.z * 8.f), clamp8(f.w * 8.f), q, true);
            *(int*)((unsigned char*)(F.ws + WS_FN8) + (size_t)r * DM + c) = q; } };
    for (int r = F.gw; r < MROWS; r += F.NGW) {
        const int var = row_variant(r); if (var == 2) continue;
        f32x4 y[8]; load_row_bf16(Y2 + (size_t)r * DM, F.lane, y); finish_row(r, var, y);
    }
    if (l == 0) {
        for (int i = F.gw; i < 4 * NB * CTXL; i += F.NGW) { if (i & 3) continue;
            const int ci = i >> 2, b = ci / CTXL, pos = ci % CTXL, r = b * TPB + pos; const float* pp = (const float*)(F.ws + WS_PART) + (size_t)ci * DM;
            f32x4 y[8];
#pragma unroll
            for (int j = 0; j < 8; ++j) y[j] = (f32x4){0.f, 0.f, 0.f, 0.f};
#pragma unroll 1
            for (int kb = 0; kb < 8; kb += 4) { f32x4 t[4][8];
#pragma unroll
                for (int q = 0; q < 4; ++q) load_row_f32(pp + (size_t)(kb + q) * (NB * CTXL) * DM, F.lane, t[q]);
#pragma unroll
                for (int j = 0; j < 8; ++j) y[j] += (t[0][j] + t[1][j]) + (t[2][j] + t[3][j]); }
            finish_row(r, 2, y);
        }
    }
}
__device__ __forceinline__ void routing_phase(Frame& F, int l) {
    unsigned char* ws = F.ws; const float* LOG4 = (const float*)(ws + WS_LOG4); int* list = (int*)(ws + WS_LIST); float* GATE = (float*)(ws + WS_GATE);
    unsigned* cnt = (unsigned*)(ws + WS_CTL) + CW_CNT + l * 128;
    LAS int* L = (LAS int*)(F.lds + LDS_SCR);
    const int chunk = (MROWS + F.G - 1) / F.G; const int r0 = F.bid * chunk, r1 = (r0 + chunk < MROWS) ? r0 + chunk : MROWS;
    LAS int* sel_e = L + 128; LAS int* sel_r = L + 128 + chunk * 6;
    if (F.tid < 128) L[F.tid] = 0;
    __syncthreads();
    const float rb = F.in[I_RB][l * 64 + F.lane];
    LAS float* lgs = (LAS float*)(L + 128 + chunk * 12) + F.wave * (9 * 64);
    for (int rb0 = r0; rb0 < r1; rb0 += 72) {
#pragma unroll
    for (int i = 0; i < 9; ++i) { const int r = rb0 + F.wave + 8 * i, rc = r < MROWS ? r : MROWS - 1; float lg = 0.f;
#pragma unroll
        for (int s = 0; s < 4; ++s) { const float* p = LOG4 + ((size_t)s * MROWS + rc) * 256; lg += p[F.lane] + p[64 + F.lane]; }
        lgs[i * 64 + F.lane] = lg; }
    LDS_WAIT(); asm volatile("" ::: "memory");
#pragma unroll 1
    for (int i = 0; i < 9; ++i) { const int r = rb0 + F.wave + 8 * i; if (r >= r1) break;
        const int var = row_variant(r); const int tl = r - r0;
        if (l == 1 && var == 2) { if (F.lane < 6) sel_e[tl * 6 + F.lane] = -1; continue; }
        const float lg = lgs[i * 64 + F.lane];
        const float score = 1.f / (1.f + __expf(-lg)); const float choice = score + rb;
        float m1 = choice; m1 = fmaxf(m1, __shfl_xor(m1, 1)); m1 = fmaxf(m1, __shfl_xor(m1, 2)); m1 = fmaxf(m1, __shfl_xor(m1, 4));
        const unsigned long long bm = __ballot(choice == m1); const int grp = F.lane >> 3; const unsigned gb = (unsigned)(bm >> (grp * 8)) & 0xffu; const int first = __builtin_ctz(gb);
        float c2 = ((F.lane & 7) == first) ? -1e30f : choice; c2 = fmaxf(c2, __shfl_xor(c2, 1)); c2 = fmaxf(c2, __shfl_xor(c2, 2)); c2 = fmaxf(c2, __shfl_xor(c2, 4));
        const float gs = m1 + c2; int rank = 0;
#pragma unroll
        for (int j = 0; j < 8; ++j) { const float gj = __shfl(gs, j * 8); rank += (gj > gs || (gj == gs && j < grp)) ? 1 : 0; }
        float masked = rank < 4 ? choice : -1e30f;
        int myk = -1; float ssum = 0.f; float sk_[6]; int ek_[6];
#pragma unroll
        for (int k = 0; k < 6; ++k) { const float mx = wave_max(masked); const unsigned long long bb = __ballot(masked == mx); const int e = __builtin_ctzll(bb);
            if (F.lane == e) masked = -1e30f; const float sc = __shfl(score, e); sk_[k] = sc; ek_[k] = e; ssum += sc; }
        (void)myk;
        if (F.lane < 6) { float gsel = 0.f; int esel = 0;
#pragma unroll
            for (int k = 0; k < 6; ++k) if (F.lane == k) { gsel = sk_[k]; esel = ek_[k]; }
            GATE[(size_t)r * 6 + F.lane] = gsel / ssum * 2.5f;
            const int rk = atomicAdd((int*)&L[esel], 1); sel_e[tl * 6 + F.lane] = esel; sel_r[tl * 6 + F.lane] = rk; }
    }
    LDS_WAIT(); asm volatile("" ::: "memory");
    }
    __syncthreads();
    if (F.tid < 64) L[64 + F.tid] = (int)atomicAdd(&cnt[F.tid], (unsigned)L[F.tid]);
    if (F.bid == 0 && F.tid == 64) cnt[64] = (l == 0) ? MROWS : NB * SEQ;
    __syncthreads();
    for (int i = F.tid; i < (r1 - r0) * 6; i += 512) { const int e = sel_e[i]; if (e >= 0) list[(size_t)e * MROWS + L[64 + e] + sel_r[i]] = (r0 + i / 6) * 6 + (i % 6); }
    for (int r = r0 + F.tid; r < r1; r += 512) { const int b = row_batch(r), pos = r - b * TPB;
        if (l == 0) list[(size_t)64 * MROWS + r] = NSLOT + r; else if (pos >= CTXL) list[(size_t)64 * MROWS + b * SEQ + (pos - CTXL)] = NSLOT + r; }
}
__device__ __forceinline__ void combine_phase(Frame& F, int l) {
    LAS float* T = (LAS float*)(F.lds + LDS_SCR);
    lds_load_vec(F, T, F.in[I_NFPOST] + l * DM);
    for (int v = 0; v < 3; ++v) lds_load_vec(F, T + (1 + v) * TB, modf_vec(F, l, v, 5));
    if (l == 0) { lds_load_vec(F, T + 4 * TB, F.in[I_NMPRE] + DM); for (int v = 0; v < 3; ++v) { lds_load_vec(F, T + (5 + v) * TB, modf_vec(F, 1, v, 0)); lds_load_vec(F, T + (8 + v) * TB, modf_vec(F, 1, v, 1)); } }
    __syncthreads();
    const unsigned char* YS = (const unsigned char*)(F.ws + WS_YS); const float* GATE = (const float*)(F.ws + WS_GATE); bf16_t* XR = (bf16_t*)(F.ws + WS_XR); bf16_t* HN = (bf16_t*)(F.ws + WS_HN);
    for (int r = F.gw; r < MROWS; r += F.NGW) {
        const int var = row_variant(r); if (l == 1 && var == 2) continue;
        f32x4 f[8], t[8];
#pragma unroll
        for (int j = 0; j < 8; ++j) f[j] = (f32x4){0.f, 0.f, 0.f, 0.f};
#pragma unroll
        for (int kb = 0; kb < 8; kb += 4) { int yw[4][8]; float gk[4];
#pragma unroll
            for (int kk = 0; kk < 4; ++kk) { const int k = kb + kk; if (k < 7) { const unsigned char* p = YS + (k < 6 ? ((size_t)r * 6 + k) : (size_t)(NSLOT + r)) * DM + 4 * F.lane;
#pragma unroll
                for (int j = 0; j < 8; ++j) yw[kk][j] = __builtin_nontemporal_load((const int*)(p + 256 * j));
                gk[kk] = (k < 6 ? GATE[(size_t)r * 6 + (k < 6 ? k : 0)] : 1.f) * YS_INV; } }
            if (kb == 0) load_row_bf16(XR + (size_t)r * DM, F.lane, t);
#pragma unroll
            for (int kk = 0; kk < 4; ++kk) { if (kb + kk < 7) {
#pragma unroll
                for (int j = 0; j < 8; ++j) { const f32x2 lo = __builtin_amdgcn_cvt_pk_f32_fp8(yw[kk][j], false), hi = __builtin_amdgcn_cvt_pk_f32_fp8(yw[kk][j], true); f[j] += (f32x4){lo.x, lo.y, hi.x, hi.y} * gk[kk]; } } }
        }
        const float rs = row_rstd(f);
#pragma unroll
        for (int j = 0; j < 8; ++j) { const int c = 4 * F.lane + 256 * j; t[j] = t[j] + LV4(T + (1 + var) * TB, c) * (f[j] * rs * LV4(T, c)); }
        if (l == 0) {
#pragma unroll
            for (int j = 0; j < 8; ++j) { u32x2 w; w.x = cvt_pk_bf16(t[j].x, t[j].y); w.y = cvt_pk_bf16(t[j].z, t[j].w); __builtin_nontemporal_store(w, (u32x2*)(XR + (size_t)r * DM + 4 * F.lane + 256 * j)); }
            const float rs2 = row_rstd(t);
#pragma unroll
            for (int j = 0; j < 8; ++j) { const int c = 4 * F.lane + 256 * j; t[j] = t[j] * rs2 * LV4(T + 4 * TB, c) * (LV4(T + (8 + var) * TB, c) + 1.f) + LV4(T + (5 + var) * TB, c); }
            store_row_bf16(HN + (size_t)r * DM, F.lane, t);
        } else {
            const int b = row_batch(r), pos = r - b * TPB; float* o = F.out + ((size_t)b * SEQ + (pos - CTXL)) * DM;
#pragma unroll
            for (int j = 0; j < 8; ++j) __builtin_nontemporal_store(t[j], (f32x4*)(o + 4 * F.lane + 256 * j));
        }
    }
}

__device__ __attribute__((noinline)) void combine_outlined(unsigned char* ws, const float* const* in, float* out, int G, int bid, int l) {
    extern __shared__ __attribute__((aligned(16))) unsigned char lds_raw2[];
    Frame F; F.lds = (LAS unsigned char*)lds_raw2; F.ldsg = (char*)lds_raw2; F.ws = ws; F.in = in; F.out = out; F.G = G; F.bid = bid; F.NGW = G * 8;
    int t_ = threadIdx.x; asm volatile("" : "+v"(t_)); F.tid = t_; F.lane = t_ & 63; F.wave = __builtin_amdgcn_readfirstlane(t_ >> 6); F.gw = bid * 8 + F.wave;
    combine_phase(F, l);
}

constexpr float LOG2E = 1.4426950408889634f;
__device__ __forceinline__ void diff_attn_units(Frame& F) {
    const bf16_t* P = (const bf16_t*)(F.ws + WS_P); bf16_t* AO = (bf16_t*)(F.ws + WS_AO); const f32x2* tab = (const f32x2*)(F.ws + WS_ROPE);
    for (long L = F.bid; L < 1024 + 32; L += F.G) {
        att::UnitDesc U{}; int hh, u; const bool ctxq = L >= 1024;
        if (!ctxq) { hh = (int)(L / 256) * 8 + (int)(L % 8); u = (int)(L % 256) / 8; } else { hh = (int)L - 1024; u = 0; }
        const int b = hh >> 4, vh = hh & 15; const size_t krow0 = (size_t)b * TPB, qrow0 = ctxq ? krow0 : krow0 + CTXL + 256 * u;
        U.Q = P + qrow0 * AB_INP + C_DQ + vh * 64; U.ldq = AB_INP; U.K = P + krow0 * AB_INP + C_DK + vh * 64; U.ldk = AB_INP; U.K2 = nullptr; U.ldk2 = 0;
        U.V = P + krow0 * AB_INP + C_DV + (vh >> 1) * 128; U.ldv = AB_INP; U.O = AO + qrow0 * DM + vh * 128; U.ldo = DM;
        U.NT = ctxq ? 4 : 132; U.C = 0.125f * LOG2E; U.rope = ctxq ? nullptr : tab; U.qtok0 = 256 * u; U.seg_tiles = 0; U.seg2_row0 = 0; U.ktok0 = 0; U.sink_l2 = 0.f;
        att::attn_unit<0>(U, F.ldsg + LDS_SCR);
    }
}
__device__ __forceinline__ void mla_units(Frame& F) {
    const bf16_t* QB = (const bf16_t*)(F.ws + WS_QB); const bf16_t* KV = (const bf16_t*)(F.ws + WS_KV); const bf16_t* KR = (const bf16_t*)(F.ws + WS_KR); bf16_t* CC = (bf16_t*)(F.ws + WS_CC);
    const f32x2* tab = (const f32x2*)(F.ws + WS_ROPE);
    for (long L = F.bid; L < 512; L += F.G) {
        att::UnitDesc U{}; const int hh = (int)(L / 256) * 8 + (int)(L % 8), u = (int)(L % 256) / 8; const int b = hh >> 3, h = hh & 7;
        const size_t krow0 = (size_t)b * TPB, qrow0 = krow0 + CTXL + 256 * u;
        U.Q = QB + qrow0 * 1536 + h * 192; U.ldq = 1536; U.K = KV + krow0 * 2048 + h * 256; U.ldk = 2048; U.K2 = KR + krow0 * 64; U.ldk2 = 64;
        U.V = KV + krow0 * 2048 + h * 256 + 128; U.ldv = 2048; U.O = CC + qrow0 * DM + h * 128; U.ldo = DM;
        U.NT = 132; U.C = 0.07216878364870322f * LOG2E; U.rope = tab; U.qtok0 = 256 * u; U.seg_tiles = 0; U.seg2_row0 = 0; U.ktok0 = 0; U.sink_l2 = 0.f;
        att::attn_unit<1>(U, F.ldsg + LDS_SCR);
    }
}
__device__ __forceinline__ void swa_units(Frame& F) {
    const bf16_t* P1 = (const bf16_t*)(F.ws + WS_P); bf16_t* CC = (bf16_t*)(F.ws + WS_CC); const f32x2* tab = (const f32x2*)(F.ws + WS_ROPE + 65536);
    for (long L = F.bid; L < 512; L += F.G) {
        att::UnitDesc U{}; const int hh = (int)(L / 256) * 8 + (int)(L % 8), u = (int)(L % 256) / 8; const int b = hh >> 3, h = hh & 7, g = h >> 2;
        const size_t krow0 = (size_t)b * TPB, qrow0 = krow0 + CTXL + 256 * u;
        const int tok0 = (256 * u - 128) > 0 ? (256 * u - 128) : 0, tok1 = (256 * u + 384) < SEQ ? (256 * u + 384) : SEQ;
        U.Q = P1 + qrow0 * CD_IN + C_SQ + h * 128; U.ldq = CD_IN; U.K = P1 + krow0 * CD_IN + C_SK + g * 128; U.ldk = CD_IN; U.K2 = nullptr; U.ldk2 = 0;
        U.V = P1 + krow0 * CD_IN + C_SV + g * 128; U.ldv = CD_IN; U.O = CC + qrow0 * DM + 1024 + h * 128; U.ldo = DM;
        U.NT = 4 + (tok1 - tok0) / 64; U.C = 0.08838834764831845f * LOG2E; U.rope = tab; U.qtok0 = 256 * u; U.seg_tiles = 4; U.seg2_row0 = CTXL + tok0; U.ktok0 = tok0; U.sink_l2 = F.in[I_SINK][h] * LOG2E;
        att::attn_unit<2>(U, F.ldsg + LDS_SCR);
    }
}

constexpr int N_PHASES = 24;
__global__ void __launch_bounds__(512, 2) mk_fwd(Args args) {
    extern __shared__ __attribute__((aligned(16))) unsigned char lds_raw[];
    Frame F;
    F.lds = (LAS unsigned char*)lds_raw; F.ldsg = (char*)lds_raw; F.ws = args.ws; F.in = (const float* const*)__builtin_amdgcn_kernarg_segment_ptr()  ; F.out = args.out;
    F.tid = threadIdx.x; F.lane = F.tid & 63; F.wave = __builtin_amdgcn_readfirstlane(F.tid >> 6); F.G = gridDim.x; F.bid = blockIdx.x; F.gw = F.bid * 8 + F.wave; F.NGW = F.G * 8;
    unsigned* ctl = (unsigned*)(F.ws + WS_CTL);
    for (int u = F.tid; u < (LDS_BYTES - LDS_CTL) / 4; u += 512) ((LAS unsigned*)(F.lds + LDS_CTL))[u] = 0u;
    __syncthreads();
    XcdBarrier bar; bar.bar = ctl + CW_BAR; bar.x = 0; bar.st = nullptr;
    const bool one = (args.ph_hi - args.ph_lo) > 1;
    if (one) bar = xcd_barrier_post(ctl + CW_BAR, (volatile LAS unsigned*)(F.lds + LDS_CTL));
    const int lo = args.ph_lo, hi = args.ph_hi;
#ifndef ONLY
#define ONLY -1
#endif
#ifndef PROBE_PH
#define PROBE_PH -1
#endif
#ifndef PROBE_VAR
#define PROBE_VAR 0
#endif
#define REP(k) for (int rep_ = 0; rep_ < ((PROBE_PH == (k)) ? 2 : 1); ++rep_)
#define IN(k) ((ONLY < 0 || ONLY == (k)) && lo <= (k) && (k) < hi)
#define INM(j) ((ONLY < 0 || ONLY == 7 + (j)) && lo <= (pb + (j)) && (pb + (j)) < hi)
#define FREF() do { int t_ = threadIdx.x; asm volatile("" : "+v"(t_)); F.tid = t_; F.lane = t_ & 63; F.wave = __builtin_amdgcn_readfirstlane(t_ >> 6); F.gw = F.bid * 8 + F.wave; } while (0)
#define SEAM(k) do { if (lo <= (k) && (k) + 1 < hi) xcd_barrier(bar); } while (0)
    unsigned char* ws = F.ws;
    if (IN(0)) REP(0) { asm volatile("; PHASE_MARK 0"); FREF(); p0_prologue(F); } SEAM(0);
    if (IN(1)) REP(1) { asm volatile("; PHASE_MARK 1"); FREF(); p1_norm0(F); } SEAM(1);
#define MOE_LAYER(l, pb) do { \
        if (INM(0)) REP(100 + (l) * 10 + 0) { asm volatile("; PHASE_MARK M0"); FREF(); row_phase(F, l); } SEAM(pb); \
        if (INM(1)) REP(100 + (l) * 10 + 1) { asm volatile("; PHASE_MARK M1"); FREF(); PolRouter p{(const bf16_t*)(ws + WS_FN2), (const bf16_t*)(ws + WS_WRT) + (size_t)(l) * 256 * 4096, (float*)(ws + WS_LOG4), 8192, 8, (l) == 0 ? NTILE_M : 64, F.G, F.bid, (l) == 1}; \
            pg8::gemm_phase(F.lds + LDS_SCR, p); } SEAM(pb + 1); \
        if (INM(2)) REP(100 + (l) * 10 + 2) { asm volatile("; PHASE_MARK M2"); FREF(); routing_phase(F, l); } SEAM(pb + 2); \
        if (INM(3)) REP(100 + (l) * 10 + 3) { asm volatile("; PHASE_MARK M3"); FREF(); build_group_table(F, ctl + CW_CNT + (l) * 128); \
            for (int ib = 0; ib == 0 || ib < group_units<4>(F); ib += STASH_MAX) { stash_lists<4>(F, (const int*)(ws + WS_LIST), ib); \
            PolGU p{(const unsigned char*)(ws + WS_FN8), (const unsigned char*)(ws + WS_WGU) + (size_t)(l) * 65 * 1024 * 2048, (unsigned char*)(ws + WS_H), (const LAS int*)(F.lds + LDS_AUX + STASH_OFF), (const LAS int*)(F.lds + LDS_AUX), 2048, 16, F.G, F.bid, ib, (PROBE_PH == 100 + (l) * 10 + 3 && rep_ == 0) ? PROBE_VAR : 0}; \
            pg8::gemm_phase(F.lds + LDS_SCR, p); } } SEAM(pb + 3); \
        if (INM(4)) REP(100 + (l) * 10 + 4) { asm volatile("; PHASE_MARK M4"); FREF(); build_group_table(F, ctl + CW_CNT + (l) * 128); \
            for (int ib = 0; ib == 0 || ib < group_units<8>(F); ib += STASH_MAX) { stash_lists<8>(F, (const int*)(ws + WS_LIST), ib); \
            PolDN p{(const unsigned char*)(ws + WS_H), (const unsigned char*)(ws + WS_WDN) + (size_t)(l) * 65 * 2048 * 512, (unsigned char*)(ws + WS_YS), (const LAS int*)(F.lds + LDS_AUX + STASH_OFF), (const LAS int*)(F.lds + LDS_AUX), 512, 4, F.G, F.bid, ib, (rep_ > 0) ? PROBE_VAR : 0}; \
            pg8::gemm_phase(F.lds + LDS_SCR, p); } } SEAM(pb + 4); \
        if (INM(5)) REP(100 + (l) * 10 + 5) { asm volatile("; PHASE_MARK M5"); combine_outlined(F.ws, F.in, F.out, F.G, F.bid, l); } } while (0)
    if (IN(2)) REP(2) { asm volatile("; PHASE_MARK 2"); FREF(); PolPlain p{(const bf16_t*)(ws + WS_HN), (const bf16_t*)(ws + WS_WABIN), (bf16_t*)(ws + WS_P), DM * 2, DM * 2, AB_INP, DM / 64, NTILE_M, AB_INP / 256, F.G, F.bid, false, (rep_ > 0) ? PROBE_VAR : 0};
        pg8::gemm_phase(F.lds + LDS_SCR, p); } SEAM(2);
    if (IN(3)) { asm volatile("; PHASE_MARK 3"); FREF(); for (int r = F.gw; r < MROWS; r += F.NGW) rope_dk_row(F, r);
        REP(3) for (int it = F.bid; it < NB * 8 * 66; it += F.G) { const int g = it % 66, bh = it / 66; mlstm_a_item(F, bh >> 3, bh & 7, g); } } SEAM(3);
    if (IN(4)) REP(4) { asm volatile("; PHASE_MARK 4"); FREF(); for (int it = F.bid; it < 32 * 8; it += F.G) mlstm_scan_item(F, it >> 3, it & 7);
        diff_attn_units(F); } SEAM(4);
    if (IN(5)) REP(5) { asm volatile("; PHASE_MARK 5"); FREF(); const float* lv = F.in[I_DLAM]; float s01 = 0.f, s23 = 0.f; for (int i = 0; i < 64; ++i) { s01 += lv[i] * lv[64 + i]; s23 += lv[128 + i] * lv[192 + i]; }
        const float lam_init = 0.2f, lam = __expf(s01) - __expf(s23) + lam_init;
        {
            const int nit = NB * 8 * 66, extra = nit % F.G, nbusy = (extra > 0 && extra < F.G) ? extra : 0, nhelp = F.G - nbusy;
            if (F.bid >= nbusy) { float dnw[16];
#pragma unroll
                for (int j = 0; j < 16; ++j) dnw[j] = F.in[I_DNORM][(F.lane & 7) * 16 + j];
                for (int r = (F.bid - nbusy) * 8 + F.wave; r < MROWS; r += nhelp * 8) diff_combine_row(F, r, lam, 1.f - lam_init, dnw); } }
        for (int it = F.bid; it < NB * 8 * 66; it += F.G) { const int g = it % 66, bh = it / 66; mlstm_c_item(F, bh >> 3, bh & 7, g); } } SEAM(5);
    if (IN(6)) REP(6) { asm volatile("; PHASE_MARK 6"); FREF(); PolPlain p{(const bf16_t*)(ws + WS_CC), (const bf16_t*)(ws + WS_WABOUT), (bf16_t*)(ws + WS_Y2), DM * 2, DM * 2, DM, DM / 64, 64, DM / 256, F.G, F.bid, true, 0};
        pg8::gemm_phase(F.lds + LDS_SCR, p);
        PolCtxSplit q{(const bf16_t*)(ws + WS_CC), (const bf16_t*)(ws + WS_WABOUT), (float*)(ws + WS_PART), DM * 2, DM * 2, 4, F.G, F.bid};
        pg8::gemm_phase(F.lds + LDS_SCR, q); } SEAM(6);
    { constexpr int pb = 7; MOE_LAYER(0, pb); } SEAM(12);
    if (IN(13)) REP(13) { asm volatile("; PHASE_MARK 13"); FREF(); PolPlain p{(const bf16_t*)(ws + WS_HN), (const bf16_t*)(ws + WS_WCDIN), (bf16_t*)(ws + WS_P), DM * 2, DM * 2, CD_IN, DM / 64, NTILE_M, CD_IN / 256, F.G, F.bid, false, 0};
        pg8::gemm_phase(F.lds + LDS_SCR, p); } SEAM(13);
    if (IN(14)) REP(14) { asm volatile("; PHASE_MARK 14"); FREF(); { float qn[8], kvn[8];
#pragma unroll
            for (int j = 0; j < 8; ++j) { qn[j] = F.in[I_QNORM][(F.lane < 56 ? F.lane : 55) * 8 + j]; kvn[j] = F.in[I_KVNORM][F.lane * 8 + j]; }
            for (int r = F.gw; r < MROWS; r += F.NGW) post1_row(F, r, qn, kvn); } } SEAM(14);
    if (IN(15)) REP(15) { asm volatile("; PHASE_MARK 15"); FREF(); PolUqUkv p{(const bf16_t*)(ws + WS_CKVN), (const bf16_t*)(ws + WS_CQN), (const bf16_t*)(ws + WS_WUKV), (const bf16_t*)(ws + WS_WUQ), (bf16_t*)(ws + WS_KV), (bf16_t*)(ws + WS_QB), 1024, 8, F.G, F.bid};
        pg8::gemm_phase(F.lds + LDS_SCR, p); } SEAM(15);
    if (IN(16)) REP(16) { asm volatile("; PHASE_MARK 16"); FREF();
#ifndef NO_MLA
        mla_units(F);
#endif
#ifndef NO_SWA
        swa_units(F);
#endif
    } SEAM(16);
    if (IN(17)) REP(17) { asm volatile("; PHASE_MARK 17"); FREF(); PolPlain p{(const bf16_t*)(ws + WS_CC), (const bf16_t*)(ws + WS_WCDOUT), (bf16_t*)(ws + WS_Y2), DM * 2, DM * 2, DM, DM / 64, 64, DM / 256, F.G, F.bid, true, 0};
        pg8::gemm_phase(F.lds + LDS_SCR, p); } SEAM(17);
    { constexpr int pb = 18; MOE_LAYER(1, pb); }
#undef IN
#undef INM
#undef SEAM
#undef MOE_LAYER
#undef FREF
}

extern "C" void kernel_launch(void* const* d_in, const int* in_sizes, int n_in, void* d_out, int out_size, void* d_ws, size_t ws_size, hipStream_t stream) {
    static int grid = 0;
    if (grid == 0) {
        if (n_in != 31 || ws_size < WS_END) { fprintf(stderr, "kernel_launch: unexpected n_in %d or ws_size %zu (< %zu)\n", n_in, ws_size, (size_t)WS_END); grid = -1; return; }
        int dev = 0, cus = 0, per_cu = 0;
        if (hipGetDevice(&dev) != hipSuccess || hipDeviceGetAttribute(&cus, hipDeviceAttributeMultiprocessorCount, dev) != hipSuccess) { grid = -1; return; }
        if (hipFuncSetAttribute((const void*)mk_fwd, hipFuncAttributeMaxDynamicSharedMemorySize, LDS_BYTES) != hipSuccess) { fprintf(stderr, "kernel_launch: hipFuncSetAttribute failed\n"); grid = -1; return; }
        if (hipOccupancyMaxActiveBlocksPerMultiprocessor(&per_cu, (const void*)mk_fwd, 512, LDS_BYTES) != hipSuccess || per_cu < 1) { fprintf(stderr, "kernel_launch: occupancy query says %d\n", per_cu); }
        (void)hipGetLastError();
        grid = cus;
    }
    if (grid < 0) return;
    (void)hipMemsetAsync((char*)d_ws + WS_CTL, 0, CTL_ZERO_BYTES, stream);
    Args a{};
    for (int i = 0; i < 31; ++i) a.in[i] = (const float*)d_in[i];
    a.out = (float*)d_out; a.ws = (unsigned char*)d_ws;
#if MK_N_LAUNCHES == 1
    a.ph_lo = 0; a.ph_hi = N_PHASES;
    hipLaunchKernelGGL(mk_fwd, dim3(grid), dim3(512), LDS_BYTES, stream, a);
#else
    for (int k = 0; k < N_PHASES; ++k) { a.ph_lo = k; a.ph_hi = k + 1; hipLaunchKernelGGL(mk_fwd, dim3(grid), dim3(512), LDS_BYTES, stream, a); }
#endif
    const hipError_t le = hipPeekAtLastError();
    if (le != hipSuccess) fprintf(stderr, "kernel_launch: launch failed: %s\n", hipGetErrorName(le));
}
```
